# Optimizing an MI355X kernel written in HIP

```python
import math
import jax, jax.numpy as jnp
from jax import lax
import numpy as np

D_MODEL = 1024
BATCH = 1
SEQ = 16384
DEPTH = 1

HEAD_DIM = 64
A_Q_HEADS = 8
A_KV_HEADS = 2
A_GROUP = A_Q_HEADS // A_KV_HEADS
B_HEADS = 4
B_V_DIM = 2 * HEAD_DIM
Q_BLOCK = 128
GRID_W = 64
AXIAL_THETA = 10000.0
AXIAL_HALF = HEAD_DIM // 2
ROPE_THETA = 500000.0
ROPE_DIMS = HEAD_DIM // 4
NORM_EPS = 1e-6
SUBLN_EPS = 1e-5

A_Q_W = A_Q_HEADS * HEAD_DIM
A_KV_W = A_KV_HEADS * HEAD_DIM
B_QK_W = 2 * B_HEADS * HEAD_DIM
B_V_W = B_HEADS * B_V_DIM
IN_SPLITS = [A_Q_W, A_KV_W, A_KV_W, B_QK_W, B_QK_W, B_V_W]
IN_COLS = sum(IN_SPLITS)
MIX_WIDTH = A_Q_W + B_V_W

PEER_HEADS = 8
PEER_KEYS = 128
PEER_EXPERTS = PEER_KEYS * PEER_KEYS
PEER_QUERY_DIM = 256
PEER_HALF = PEER_QUERY_DIM // 2
PEER_TOPK = 16
TOKEN_CHUNK = 128

kernel_name = "hybrid_gqa_diffattn_peer_encoder"


def _rms_norm(x, g, eps=NORM_EPS):
    xf = x.astype(jnp.float32)
    y = xf * lax.rsqrt(jnp.mean(xf * xf, axis=-1, keepdims=True) + eps)
    return (y * g.astype(jnp.float32)).astype(x.dtype)


def _rotate(x, ang):
    xf = x.astype(jnp.float32)
    x1, x2 = jnp.split(xf, 2, axis=-1)
    c, s = jnp.cos(ang), jnp.sin(ang)
    return jnp.concatenate([x1 * c - x2 * s, x2 * c + x1 * s], axis=-1).astype(x.dtype)


def _axial_rope(x, row_ang, col_ang):
    return jnp.concatenate([_rotate(x[..., :AXIAL_HALF], row_ang),
                            _rotate(x[..., AXIAL_HALF:], col_ang)], axis=-1)


def _partial_rope(x, ang):
    return jnp.concatenate([_rotate(x[..., :ROPE_DIMS], ang), x[..., ROPE_DIMS:]], axis=-1)


def _gqa_attention(q, k, v):
    B, Hk, G, S, d = q.shape
    nb = S // Q_BLOCK
    scale = d ** -0.5
    qb = jnp.moveaxis(q.reshape(B, Hk, G, nb, Q_BLOCK, d), 3, 0)

    def one(qi):
        s = jnp.einsum('bhgqd,bhkd->bhgqk', qi, k).astype(jnp.float32) * scale
        p = jax.nn.softmax(s, axis=-1)
        return jnp.einsum('bhgqk,bhkv->bhgqv', p.astype(v.dtype), v)

    o = lax.map(one, qb)
    return jnp.moveaxis(o, 0, 3).reshape(B, Hk, G, S, v.shape[-1])


def _diff_attention(q, k, v, lam):
    B, H, _, S, d = q.shape
    nb = S // Q_BLOCK
    scale = d ** -0.5
    qb = jnp.moveaxis(q.reshape(B, H, 2, nb, Q_BLOCK, d), 3, 0)

    def one(qi):
        s = jnp.einsum('bhcqd,bhckd->bhcqk', qi, k).astype(jnp.float32) * scale
        p = jax.nn.softmax(s, axis=-1)
        w = p[:, :, 0] - lam * p[:, :, 1]
        return jnp.einsum('bhqk,bhkv->bhqv', w.astype(v.dtype), v)

    o = lax.map(one, qb)
    return jnp.moveaxis(o, 0, 2).reshape(B, H, S, v.shape[-1])


def _peer(xn, w_query, sub_keys, expert_u, expert_v):
    B, S, D = xn.shape
    xc_all = xn.reshape(B * S // TOKEN_CHUNK, TOKEN_CHUNK, D)

    def one(xc):
        C = xc.shape[0]
        q = (xc @ w_query).reshape(C, PEER_HEADS, 2, PEER_HALF)
        sc = jnp.einsum('chpd,hpnd->chpn', q, sub_keys).astype(jnp.float32)
        v1, i1 = lax.top_k(sc[:, :, 0], PEER_TOPK)
        v2, i2 = lax.top_k(sc[:, :, 1], PEER_TOPK)
        cand = (v1[..., :, None] + v2[..., None, :]).reshape(C, PEER_HEADS, PEER_TOPK * PEER_TOPK)
        cand_idx = (i1[..., :, None] * PEER_KEYS + i2[..., None, :]).reshape(C, PEER_HEADS, PEER_TOPK * PEER_TOPK)
        top, pos = lax.top_k(cand, PEER_TOPK)
        idx = jnp.take_along_axis(cand_idx, pos, axis=-1)
        g = jax.nn.softmax(top, axis=-1)
        u = expert_u[idx]
        v = expert_v[idx]
        a = jax.nn.gelu(jnp.einsum('cd,chkd->chk', xc, u), approximate=False)
        return jnp.einsum('chk,chkd->cd', (g * a.astype(jnp.float32)).astype(v.dtype), v)

    return lax.map(one, xc_all).reshape(B, S, D)


def setup_inputs(seed: int = 0) -> dict:
    key = jax.random.key(seed)
    ks = jax.random.split(key, 20)
    f32 = jnp.float32
    L = DEPTH

    def nrm(k, shape, scale):
        return jax.random.normal(k, shape, f32) * scale

    def gain(k, shape):
        return 1.0 + 0.02 * jax.random.normal(k, shape, f32)

    return {
        "x": jax.random.normal(ks[0], (BATCH, SEQ, D_MODEL), f32),
        "norm_attn_g": gain(ks[1], (L, D_MODEL)),
        "w_in": nrm(ks[2], (L, D_MODEL, IN_COLS), D_MODEL ** -0.5),
        "q_norm_g": gain(ks[3], (L, HEAD_DIM)),
        "k_norm_g": gain(ks[4], (L, HEAD_DIM)),
        "lambda_q1": nrm(ks[5], (L, HEAD_DIM), 0.1),
        "lambda_k1": nrm(ks[6], (L, HEAD_DIM), 0.1),
        "lambda_q2": nrm(ks[7], (L, HEAD_DIM), 0.1),
        "lambda_k2": nrm(ks[8], (L, HEAD_DIM), 0.1),
        "subln_g": gain(ks[9], (L, B_V_DIM)),
        "w_out": nrm(ks[10], (L, MIX_WIDTH, D_MODEL), MIX_WIDTH ** -0.5),
        "norm_ffn_g": gain(ks[11], (L, D_MODEL)),
        "w_query": nrm(ks[12], (L, D_MODEL, PEER_HEADS * PEER_QUERY_DIM), D_MODEL ** -0.5),
        "sub_keys": nrm(ks[13], (L, PEER_HEADS, 2, PEER_KEYS, PEER_HALF), PEER_HALF ** -0.5),
        "expert_u": nrm(ks[14], (L, PEER_EXPERTS, D_MODEL), D_MODEL ** -0.5),
        "expert_v": nrm(ks[15], (L, PEER_EXPERTS, D_MODEL), 0.25),
        "norm_final_g": gain(ks[16], (D_MODEL,)),
    }


def reference(x, norm_attn_g, w_in, q_norm_g, k_norm_g, lambda_q1, lambda_k1,
              lambda_q2, lambda_k2, subln_g, w_out, norm_ffn_g, w_query, sub_keys,
              expert_u, expert_v, norm_final_g):
    B, S, _ = x.shape
    rows = S // GRID_W
    row = jnp.repeat(jnp.arange(rows, dtype=jnp.float32), GRID_W)
    col = jnp.tile(jnp.arange(GRID_W, dtype=jnp.float32), rows)
    pos = jnp.arange(S, dtype=jnp.float32)
    inv_ax = AXIAL_THETA ** (-jnp.arange(0, AXIAL_HALF, 2, dtype=jnp.float32) / AXIAL_HALF)
    inv_p = ROPE_THETA ** (-jnp.arange(0, ROPE_DIMS, 2, dtype=jnp.float32) / ROPE_DIMS)
    row_ang = row[:, None] * inv_ax[None, :]
    col_ang = col[:, None] * inv_ax[None, :]
    pos_ang = pos[:, None] * inv_p[None, :]
    split_pts = [int(v) for v in np.cumsum(IN_SPLITS)[:-1]]

    h = x
    for l in range(DEPTH):
        lambda_init = 0.8 - 0.6 * math.exp(-0.3 * l)
        xn = _rms_norm(h, norm_attn_g[l])
        proj = xn @ w_in[l]
        qa, ka, va, qb, kb, vb = jnp.split(proj, split_pts, axis=-1)

        qa = qa.reshape(B, S, A_Q_HEADS, HEAD_DIM).transpose(0, 2, 1, 3)
        ka = ka.reshape(B, S, A_KV_HEADS, HEAD_DIM).transpose(0, 2, 1, 3)
        va = va.reshape(B, S, A_KV_HEADS, HEAD_DIM).transpose(0, 2, 1, 3)
        qa = _axial_rope(_rms_norm(qa, q_norm_g[l]), row_ang, col_ang)
        ka = _axial_rope(_rms_norm(ka, k_norm_g[l]), row_ang, col_ang)
        qa = qa.reshape(B, A_KV_HEADS, A_GROUP, S, HEAD_DIM)
        oa = _gqa_attention(qa, ka, va).reshape(B, A_Q_HEADS, S, HEAD_DIM)
        oa = oa.transpose(0, 2, 1, 3).reshape(B, S, A_Q_W)

        qb = qb.reshape(B, S, B_HEADS, 2, HEAD_DIM).transpose(0, 2, 3, 1, 4)
        kb = kb.reshape(B, S, B_HEADS, 2, HEAD_DIM).transpose(0, 2, 3, 1, 4)
        vb = vb.reshape(B, S, B_HEADS, B_V_DIM).transpose(0, 2, 1, 3)
        qb = _partial_rope(qb, pos_ang)
        kb = _partial_rope(kb, pos_ang)
        lam = (jnp.exp(jnp.sum(lambda_q1[l].astype(jnp.float32) * lambda_k1[l].astype(jnp.float32)))
               - jnp.exp(jnp.sum(lambda_q2[l].astype(jnp.float32) * lambda_k2[l].astype(jnp.float32)))
               + lambda_init)
        ob = _diff_attention(qb, kb, vb, lam)
        ob = _rms_norm(ob, subln_g[l], SUBLN_EPS) * (1.0 - lambda_init)
        ob = ob.transpose(0, 2, 1, 3).reshape(B, S, B_V_W)

        h = h + jnp.concatenate([oa, ob], axis=-1) @ w_out[l]

        h = h + _peer(_rms_norm(h, norm_ffn_g[l]), w_query[l], sub_keys[l],
                      expert_u[l], expert_v[l])

    return _rms_norm(h, norm_final_g)
```

```cpp
#include <hip/hip_runtime.h>
#include <hip/hip_bf16.h>
#include <cstdio>
#include <cstdint>
#include <cmath>
namespace pg8 {
#define PG8_LAS __attribute__((address_space(3)))
typedef unsigned short bf16_t;
typedef short bf16x8 __attribute__((ext_vector_type(8)));
typedef float f32x4 __attribute__((ext_vector_type(4)));
typedef unsigned u32x4 __attribute__((ext_vector_type(4)));
constexpr int BM = 256, BK = 64, HALF = 128, HTB = HALF * BK * 2  , STAGE_BYTES = 8 * HTB, NXCD = 8, WGM = 8;

__host__ __device__ __forceinline__ int lds_byte(int r, int c) { const int st = (r >> 4) * 2 + (c >> 5), rr = r & 15, cc = c & 31, ob = rr * 64 + cc * 2; return st * 1024 + (ob ^ (((ob >> 9) & 1) << 5)); }
__host__ __device__ __forceinline__ void stage_rc(int b, int& R, int& C) { const int st = b / 1024, sb = b % 1024, swz = sb ^ (((sb >> 9) & 1) << 5); R = (st >> 1) * 16 + swz / 64; C = (st & 1) * 32 + (swz % 64) / 2; }
__host__ __device__ __forceinline__ int perm32(int rho) { const int n = rho >> 4, i = rho & 15; return 8 * (i >> 2) + 4 * n + (i & 3); }

struct Unit { int pm, pn; };
struct Gemm { const bf16_t* A; const bf16_t* Bt; int M, N, K; };

struct StaticOrder {
    int nM, nN, nwg, G, c;
    __host__ __device__ void init(int M, int N, int G_, int c_) { nM = M / BM; nN = N / BM; nwg = nM * nN; G = G_; c = c_; }
    __host__ __device__ bool next(int i, Unit& u) const {
        const long L = (long)i * G + c; if (L >= nwg) return false;
        int wgid = (int)L; { const int q = nwg / NXCD, r = nwg % NXCD, xcd = wgid % NXCD, off = wgid / NXCD; wgid = (xcd < r ? xcd * (q + 1) : r * (q + 1) + (xcd - r) * q) + off; }
        const int nig = WGM * nN, gid = wgid / nig, fm = gid * WGM, gsz = (nM - fm) < WGM ? (nM - fm) : WGM;
        u.pm = fm + ((wgid % nig) % gsz); u.pn = (wgid % nig) / gsz; return true;
    }
    __device__ __forceinline__ void a_ready(const Unit&) const {}
    __device__ __forceinline__ void done(const Unit&) const {}
};

__device__ __forceinline__ unsigned cvt_pk_bf16(float lo, float hi) { unsigned r; asm volatile("v_cvt_pk_bf16_f32 %0, %1, %2" : "=v"(r) : "v"(lo), "v"(hi)); return r; }
typedef float f32x2 __attribute__((ext_vector_type(2)));
typedef unsigned u32x2 __attribute__((ext_vector_type(2)));

struct EpiBf16 {
    static constexpr bool PERM = true, AFTER_DRAIN = false;
    bf16_t* O; int ldc;
    __device__ __forceinline__ void operator()(const f32x4 (&acc)[2][2][4][2], const Unit& u, int wr, int wc, int fr, int fq) const {
        const int row0 = u.pm * BM + wr * 64 + fr; const int col0 = u.pn * BM + wc * 32 + 8 * fq;
#pragma unroll
        for (int ai = 0; ai < 2; ++ai)
#pragma unroll
            for (int m = 0; m < 4; ++m) { bf16_t* rowp = O + (size_t)(row0 + ai * HALF + m * 16) * ldc + col0;
#pragma unroll
                for (int bj = 0; bj < 2; ++bj) { const f32x4 v0 = acc[ai][bj][m][0], v1 = acc[ai][bj][m][1];
                    u32x4 w; w.x = cvt_pk_bf16(v0[0], v0[1]); w.y = cvt_pk_bf16(v0[2], v0[3]); w.z = cvt_pk_bf16(v1[0], v1[1]); w.w = cvt_pk_bf16(v1[2], v1[3]);
                    *(u32x4*)(rowp + bj * HALF) = w; } }
    }
};

struct EpiInProj {
    static constexpr bool PERM = true, AFTER_DRAIN = false;
    bf16_t* planes; const float* qg; const float* kg; const float* trow; const float* tcol; const float* tpos; float c2; unsigned* nmax;
    __device__ __forceinline__ void operator()(const f32x4 (&acc)[2][2][4][2], const Unit& u, int wr, int wc, int fr, int fq) const {
        const int slot = u.pn * 4 + wc;
        bf16_t* plane = planes + (size_t)slot * (16384 * 64);
        const int rowb = u.pm * BM + wr * 64 + fr;
        if (slot < 10) {
            const float* g = slot < 8 ? qg : kg; const float sc = slot < 8 ? c2 : 1.f;
            f32x4 gv[2][2];
#pragma unroll
            for (int bj = 0; bj < 2; ++bj)
#pragma unroll
                for (int n = 0; n < 2; ++n) gv[bj][n] = *(const f32x4*)(g + 32 * bj + 16 * n + 4 * fq);
#pragma unroll
            for (int ai = 0; ai < 2; ++ai)
#pragma unroll
                for (int m = 0; m < 4; ++m) { const int row = rowb + ai * HALF + m * 16;
                    float ss = 0.f;
#pragma unroll
                    for (int bj = 0; bj < 2; ++bj)
#pragma unroll
                        for (int n = 0; n < 2; ++n) { const f32x4 x = acc[ai][bj][m][n]; ss += (x[0] * x[0] + x[1] * x[1]) + (x[2] * x[2] + x[3] * x[3]); }
                    ss += __shfl_xor(ss, 16); ss += __shfl_xor(ss, 32);
                    const float rn = __builtin_amdgcn_rsqf(ss * (1.0f / 64.0f) + 1e-6f);
                    const float* tr = trow + (row >> 6) * 32 + 4 * fq; const float* tc = tcol + (row & 63) * 32 + 4 * fq;
#pragma unroll
                    for (int bj = 0; bj < 2; ++bj) { const float* tb = bj ? tc : tr; const f32x4 c = *(const f32x4*)tb, s = *(const f32x4*)(tb + 16);
                        const f32x4 y0 = acc[ai][bj][m][0] * rn * gv[bj][0], y1 = acc[ai][bj][m][1] * rn * gv[bj][1];
                        const f32x4 o0 = (y0 * c - y1 * s) * sc, o1 = (y1 * c + y0 * s) * sc;
                        u32x4 w; w.x = cvt_pk_bf16(o0[0], o0[1]); w.y = cvt_pk_bf16(o0[2], o0[3]); w.z = cvt_pk_bf16(o1[0], o1[1]); w.w = cvt_pk_bf16(o1[2], o1[3]);
                        *(u32x4*)(plane + (size_t)row * 64 + 32 * bj + 8 * fq) = w; } }
        } else if (slot >= 12 && slot < 28) {
            const float sc = slot < 20 ? c2 : 1.f; const bool rot = fq < 2; float nm = 0.f;
#pragma unroll
            for (int ai = 0; ai < 2; ++ai)
#pragma unroll
                for (int m = 0; m < 4; ++m) { const int row = rowb + ai * HALF + m * 16;
                    const float* tp = tpos + (size_t)row * 16 + 4 * (fq & 1);
                    f32x4 c = *(const f32x4*)tp, s = *(const f32x4*)(tp + 8);
                    if (!rot) { c = (f32x4){1.f, 1.f, 1.f, 1.f}; s = (f32x4){0.f, 0.f, 0.f, 0.f}; }
                    const f32x4 y0 = acc[ai][0][m][0], y1 = acc[ai][0][m][1];
                    const f32x4 o0 = (y0 * c - y1 * s) * sc, o1 = (y1 * c + y0 * s) * sc;
                    u32x4 w; w.x = cvt_pk_bf16(o0[0], o0[1]); w.y = cvt_pk_bf16(o0[2], o0[3]); w.z = cvt_pk_bf16(o1[0], o1[1]); w.w = cvt_pk_bf16(o1[2], o1[3]);
                    *(u32x4*)(plane + (size_t)row * 64 + 8 * fq) = w;
                    const f32x4 z0 = acc[ai][1][m][0] * sc, z1 = acc[ai][1][m][1] * sc;
                    u32x4 w2; w2.x = cvt_pk_bf16(z0[0], z0[1]); w2.y = cvt_pk_bf16(z0[2], z0[3]); w2.z = cvt_pk_bf16(z1[0], z1[1]); w2.w = cvt_pk_bf16(z1[2], z1[3]);
                    *(u32x4*)(plane + (size_t)row * 64 + 32 + 8 * fq) = w2;
                    float ss = (o0[0] * o0[0] + o0[1] * o0[1]) + (o0[2] * o0[2] + o0[3] * o0[3]) + (o1[0] * o1[0] + o1[1] * o1[1]) + (o1[2] * o1[2] + o1[3] * o1[3])
                             + (z0[0] * z0[0] + z0[1] * z0[1]) + (z0[2] * z0[2] + z0[3] * z0[3]) + (z1[0] * z1[0] + z1[1] * z1[1]) + (z1[2] * z1[2] + z1[3] * z1[3]);
                    ss += __shfl_xor(ss, 16); ss += __shfl_xor(ss, 32); nm = __builtin_fmaxf(nm, ss); }
#pragma unroll
            for (int o = 1; o < 16; o <<= 1) nm = __builtin_fmaxf(nm, __shfl_xor(nm, o));
            if ((fr | fq) == 0) atomicMax(nmax + slot, __float_as_uint(nm));
        } else {
#pragma unroll
            for (int ai = 0; ai < 2; ++ai)
#pragma unroll
                for (int m = 0; m < 4; ++m) { const int row = rowb + ai * HALF + m * 16;
#pragma unroll
                    for (int bj = 0; bj < 2; ++bj) { const f32x4 v0 = acc[ai][bj][m][0], v1 = acc[ai][bj][m][1];
                        u32x4 w; w.x = cvt_pk_bf16(v0[0], v0[1]); w.y = cvt_pk_bf16(v0[2], v0[3]); w.z = cvt_pk_bf16(v1[0], v1[1]); w.w = cvt_pk_bf16(v1[2], v1[3]);
                        *(u32x4*)(plane + (size_t)row * 64 + 32 * bj + 8 * fq) = w; } }
        }
    }
};

struct EpiOutProj {
    static constexpr bool PERM = false, AFTER_DRAIN = false;
    const float* x; float* h1; bf16_t* h1b; float* ssq;
    __device__ __forceinline__ void operator()(const f32x4 (&acc)[2][2][4][2], const Unit& u, int wr, int wc, int fr, int fq) const {
        const int col0 = u.pn * BM + wc * 32 + 4 * fq;
#pragma unroll
        for (int ai = 0; ai < 2; ++ai)
#pragma unroll
            for (int m = 0; m < 4; ++m) { const int row = u.pm * BM + ai * HALF + wr * 64 + m * 16 + fr; const size_t off = (size_t)row * 1024 + col0; float ss = 0.f;
#pragma unroll
                for (int bj = 0; bj < 2; ++bj)
#pragma unroll
                    for (int n = 0; n < 2; ++n) { const size_t o = off + bj * HALF + n * 16; const f32x4 h = *(const f32x4*)(x + o) + acc[ai][bj][m][n];
                        u32x2 w; w.x = cvt_pk_bf16(h[0], h[1]); w.y = cvt_pk_bf16(h[2], h[3]); *(u32x2*)(h1b + o) = w;
                        ss += (h[0] * h[0] + h[1] * h[1]) + (h[2] * h[2] + h[3] * h[3]); }
                ss += __shfl_xor(ss, 16); ss += __shfl_xor(ss, 32);
                if (fq == 0) ssq[(size_t)(u.pn * 4 + wc) * 16384 + row] = ss; }
    }
};

template <class Epi, class Sched, bool ALIGN_EPI = false, bool SP2 = false>
__device__ __forceinline__ void gemm_phase(PG8_LAS unsigned char* lds, const Gemm g, const Sched& S, const Epi& E) {
    const int tid = threadIdx.x, wid = __builtin_amdgcn_readfirstlane(tid >> 6), lane = tid & 63, wr = wid >> 2, wc = wid & 3, fr = lane & 15, fq = lane >> 4;
    const int K = g.K, nt = K / BK;
    unsigned voffA[2], voffB[2];
#pragma unroll
    for (int i = 0; i < 2; ++i) { int R, C; stage_rc(tid * 16 + i * 8192, R, C); const int Rb = Epi::PERM ? ((R & ~31) + perm32(R & 31)) : R;
        voffA[i] = (unsigned)(R * K + C) * 2u; voffB[i] = (unsigned)(Rb * K + C) * 2u; }
    const size_t kstep = (size_t)(BK * 2);
    const size_t hstep = (size_t)HALF * K * 2;
    const size_t tstep = 2 * hstep;
    const unsigned ldsw = (unsigned)wid * 1024u;
    const int aoff = lds_byte(wr * 64 + fr, fq * 8), boff = lds_byte(wc * 32 + fr, fq * 8);
#define PG8_SA(b, h) (((b) * 2 + (h)) * HTB)
#define PG8_SB(b, h) ((4 + (b) * 2 + (h)) * HTB)
#define PG8_STAGE(bufoff, gbase, voff) do { _Pragma("unroll") for (int _i = 0; _i < 2; ++_i) \
        __builtin_amdgcn_global_load_lds((const unsigned*)((const char*)(gbase) + (voff)[_i]), (PG8_LAS unsigned*)(lds + (bufoff) + ldsw + _i * 8192), 16, 0, 0); } while (0)
#define PG8_LDA(dst, b, h) do { _Pragma("unroll") for (int m = 0; m < 4; ++m) _Pragma("unroll") for (int k = 0; k < 2; ++k) dst[m][k] = *(const PG8_LAS bf16x8*)(lds + PG8_SA(b, h) + aoff + m * 2048 + k * 1024); } while (0)
#define PG8_LDB(dst, b, h) do { _Pragma("unroll") for (int n = 0; n < 2; ++n) _Pragma("unroll") for (int k = 0; k < 2; ++k) dst[n][k] = *(const PG8_LAS bf16x8*)(lds + PG8_SB(b, h) + boff + n * 2048 + k * 1024); } while (0)
#define PG8_MMA(ai, bj, At, Bt) do { __builtin_amdgcn_s_setprio(1); _Pragma("unroll") for (int m = 0; m < 4; ++m) _Pragma("unroll") for (int n = 0; n < 2; ++n) _Pragma("unroll") for (int k = 0; k < 2; ++k) \
        acc[ai][bj][m][n] = __builtin_amdgcn_mfma_f32_16x16x32_bf16(Bt[n][k], At[m][k], acc[ai][bj][m][n], 0, 0, 0); __builtin_amdgcn_s_setprio(0); } while (0)
#define PG8_WAIT_V(n) asm volatile("s_waitcnt vmcnt(" #n ")" ::: "memory")
#define PG8_WAIT_L(n) asm volatile("s_waitcnt lgkmcnt(" #n ")" ::: "memory")
#define PG8_BAR __builtin_amdgcn_s_barrier()
#define PG8_SCHED __builtin_amdgcn_sched_barrier(0)
    Unit cur, nxt; int ui = 0;
    if (!S.next(0, cur)) return;
    f32x4 acc[2][2][4][2];
#pragma unroll
    for (int a = 0; a < 2; ++a)
#pragma unroll
        for (int b = 0; b < 2; ++b)
#pragma unroll
            for (int m = 0; m < 4; ++m)
#pragma unroll
                for (int n = 0; n < 2; ++n) acc[a][b][m][n] = (f32x4){0.f, 0.f, 0.f, 0.f};
    bf16x8 At[4][2], B0[2][2], B1[2][2];
    const char* cA = (const char*)g.A + (size_t)cur.pm * tstep; const char* cB = (const char*)g.Bt + (size_t)cur.pn * tstep;
    S.a_ready(cur);
    if constexpr (SP2) {
        PG8_STAGE(PG8_SB(0, 0), cB, voffB); PG8_STAGE(PG8_SB(0, 1), cB + hstep, voffB); PG8_STAGE(PG8_SA(0, 0), cA, voffA); PG8_STAGE(PG8_SA(0, 1), cA + hstep, voffA);
        if (wr == 1) PG8_BAR;
        PG8_WAIT_V(2); PG8_BAR;
        PG8_STAGE(PG8_SB(1, 0), cB + kstep, voffB); PG8_STAGE(PG8_SA(1, 0), cA + kstep, voffA); PG8_STAGE(PG8_SB(1, 1), cB + hstep + kstep, voffB);
        PG8_WAIT_V(6); PG8_BAR;
    } else {
        PG8_STAGE(PG8_SB(0, 0), cB, voffB); PG8_STAGE(PG8_SA(0, 0), cA, voffA); PG8_STAGE(PG8_SB(0, 1), cB + hstep, voffB); PG8_STAGE(PG8_SA(0, 1), cA + hstep, voffA);
        if (wr == 1) PG8_BAR;
        PG8_WAIT_V(4); PG8_BAR;
        PG8_STAGE(PG8_SB(1, 0), cB + kstep, voffB); PG8_STAGE(PG8_SA(1, 0), cA + kstep, voffA); PG8_STAGE(PG8_SB(1, 1), cB + hstep + kstep, voffB);
        PG8_WAIT_V(6); PG8_BAR;
    }
    for (;;) {
        const bool has_next = S.next(ui + 1, nxt);
        const char* nA = has_next ? (const char*)g.A + (size_t)nxt.pm * tstep : cA; const char* nB = has_next ? (const char*)g.Bt + (size_t)nxt.pn * tstep : cB;
        for (int t = 0; t < nt; t += 2) {
            const bool last = (t == nt - 2);
            const char* a1 = cA + (size_t)(t + 1) * kstep;
            const char* a2 = last ? nA : cA + (size_t)(t + 2) * kstep; const char* b2 = last ? nB : cB + (size_t)(t + 2) * kstep;
            const char* a3 = a2 + kstep; const char* b3 = b2 + kstep;
            if (last && has_next) S.a_ready(nxt);
            if constexpr (SP2) {
            PG8_LDB(B0, 0, 0); PG8_LDB(B1, 0, 1); PG8_SCHED; PG8_LDA(At, 0, 0); PG8_STAGE(PG8_SA(1, 1), a1 + hstep, voffA);
            PG8_WAIT_V(8); PG8_WAIT_L(0); PG8_BAR; PG8_MMA(0, 0, At, B0); PG8_MMA(0, 1, At, B1); PG8_BAR; PG8_SCHED;
            PG8_LDA(At, 0, 1); PG8_STAGE(PG8_SB(0, 0), b2, voffB); PG8_STAGE(PG8_SB(0, 1), b2 + hstep, voffB); PG8_STAGE(PG8_SA(0, 0), a2, voffA);
            PG8_WAIT_V(8); PG8_WAIT_L(0); PG8_BAR; PG8_MMA(1, 0, At, B0); PG8_MMA(1, 1, At, B1); PG8_BAR; PG8_SCHED;
            PG8_LDB(B0, 1, 0); PG8_LDB(B1, 1, 1); PG8_SCHED; PG8_LDA(At, 1, 0); PG8_STAGE(PG8_SA(0, 1), a2 + hstep, voffA);
            PG8_WAIT_V(8); PG8_WAIT_L(0); PG8_BAR; PG8_MMA(0, 0, At, B0); PG8_MMA(0, 1, At, B1); PG8_BAR; PG8_SCHED;
            PG8_LDA(At, 1, 1); PG8_STAGE(PG8_SB(1, 0), b3, voffB); PG8_STAGE(PG8_SB(1, 1), b3 + hstep, voffB); PG8_STAGE(PG8_SA(1, 0), a3, voffA);
            PG8_WAIT_V(8); PG8_WAIT_L(0); PG8_BAR; PG8_MMA(1, 0, At, B0); PG8_MMA(1, 1, At, B1); PG8_BAR; PG8_SCHED;
            } else {
            PG8_LDB(B0, 0, 0); PG8_SCHED; PG8_LDA(At, 0, 0); PG8_STAGE(PG8_SA(1, 1), a1 + hstep, voffA);
            PG8_WAIT_L(8); PG8_BAR; PG8_WAIT_L(0); PG8_MMA(0, 0, At, B0); PG8_BAR; PG8_SCHED;
            PG8_LDB(B1, 0, 1); PG8_STAGE(PG8_SB(0, 0), b2, voffB);
            PG8_BAR; PG8_WAIT_L(0); PG8_MMA(0, 1, At, B1); PG8_BAR;
            PG8_LDA(At, 0, 1); PG8_STAGE(PG8_SA(0, 0), a2, voffA);
            PG8_BAR; PG8_WAIT_L(0); PG8_MMA(1, 0, At, B0); PG8_BAR; PG8_SCHED;
            PG8_STAGE(PG8_SB(0, 1), b2 + hstep, voffB);
            PG8_WAIT_V(6); PG8_BAR; PG8_MMA(1, 1, At, B1); PG8_BAR;
            PG8_LDB(B0, 1, 0); PG8_SCHED; PG8_LDA(At, 1, 0); PG8_STAGE(PG8_SA(0, 1), a2 + hstep, voffA);
            PG8_WAIT_L(8); PG8_BAR; PG8_WAIT_L(0); PG8_MMA(0, 0, At, B0); PG8_BAR; PG8_SCHED;
            PG8_LDB(B1, 1, 1); PG8_STAGE(PG8_SB(1, 0), b3, voffB);
            PG8_BAR; PG8_WAIT_L(0); PG8_MMA(0, 1, At, B1); PG8_BAR;
            PG8_LDA(At, 1, 1); PG8_STAGE(PG8_SA(1, 0), a3, voffA);
            PG8_BAR; PG8_WAIT_L(0); PG8_MMA(1, 0, At, B0); PG8_BAR; PG8_SCHED;
            PG8_STAGE(PG8_SB(1, 1), b3 + hstep, voffB);
            PG8_WAIT_V(6); PG8_BAR; PG8_MMA(1, 1, At, B1); PG8_BAR;
            }
        }
        if constexpr (ALIGN_EPI) { if (wr == 0) PG8_BAR; }
        if constexpr (!Epi::AFTER_DRAIN) { E(acc, cur, wr, wc, fr, fq); S.done(cur); }
        if (!has_next) break;
#pragma unroll
        for (int a = 0; a < 2; ++a)
#pragma unroll
            for (int b = 0; b < 2; ++b)
#pragma unroll
                for (int m = 0; m < 4; ++m)
#pragma unroll
                    for (int n = 0; n < 2; ++n) acc[a][b][m][n] = (f32x4){0.f, 0.f, 0.f, 0.f};
        cur = nxt; cA = nA; cB = nB; ++ui;
        if constexpr (ALIGN_EPI) { if (wr == 1) PG8_BAR; }
    }
    PG8_WAIT_V(0);
    if constexpr (!ALIGN_EPI) { if (wr == 0) PG8_BAR; }
    PG8_BAR;
    if constexpr (Epi::AFTER_DRAIN) { E.fused(acc, cur, wr, wc, fr, fq, lds, wid, lane); S.done(cur); }
#undef PG8_SA
#undef PG8_SB
#undef PG8_STAGE
#undef PG8_LDA
#undef PG8_LDB
#undef PG8_MMA
#undef PG8_WAIT_V
#undef PG8_WAIT_L
#undef PG8_BAR
#undef PG8_SCHED
}
}
namespace attn_body {
using bf16=__hip_bfloat16;
using bf16x8=__attribute__((ext_vector_type(8)))short;
using s16x4=__attribute__((ext_vector_type(4)))short;
using f32x16=__attribute__((ext_vector_type(16)))float;
using u32x4=__attribute__((ext_vector_type(4)))unsigned;
constexpr int SEQ=16384,D=64,PP=64;
constexpr int NW=8,QBLK=32,QB=QBLK*NW,KVBLK=64,NQB=SEQ/QB,NT=SEQ/KVBLK;
constexpr int OPITCH=1024;
__device__ __forceinline__ int crow(int r,int hi){return (r&3)+8*(r>>2)+4*hi;}
#define SBAR() __builtin_amdgcn_sched_barrier(0)
constexpr int NSLOT=3, SLOTB=8192;
constexpr int LDS_K=0, LDS_V=NSLOT*SLOTB, LDS_WS=LDS_V+NSLOT*2*SLOTB, LDS_OST=LDS_WS+NW*64*4, LDS_BYTES=LDS_OST+NW*8192;
__device__ __forceinline__ void glds16(const void*gsrc,unsigned lds_dst){unsigned keep;
  asm volatile("s_mov_b32 %0, m0\n\ts_mov_b32 m0, %2\n\ts_nop 0\n\tglobal_load_lds_dwordx4 %1, off\n\ts_mov_b32 m0, %0":"=&s"(keep):"v"(gsrc),"s"(lds_dst):"memory");}
__device__ __forceinline__ void glds16b(__amdgpu_buffer_rsrc_t srd,unsigned voff,unsigned soff,unsigned lds_dst){unsigned keep;
  asm volatile("s_nop 4\n\ts_mov_b32 %0, m0\n\ts_mov_b32 m0, %4\n\ts_nop 0\n\tbuffer_load_dwordx4 %1, %2, %3 offen lds\n\ts_mov_b32 m0, %0":"=&s"(keep):"v"(voff),"s"(srd),"s"(soff),"s"(lds_dst):"memory");}
__device__ __forceinline__ float max3f(float a,float b,float c){float r;asm("v_max3_f32 %0, %1, %2, %3":"=v"(r):"v"(a),"v"(b),"v"(c));return r;}
__device__ __forceinline__ float max2f(float a,float b){float r;asm("v_max_f32_e32 %0, %1, %2":"=v"(r):"v"(a),"v"(b));return r;}
__device__ __forceinline__ float fadd_s(float a,float b){float r;asm("v_add_f32_e32 %0, %1, %2":"=v"(r):"v"(a),"v"(b));return r;}
__device__ __forceinline__ float fsub_s(float a,float b){float r;asm("v_sub_f32_e32 %0, %1, %2":"=v"(r):"v"(a),"v"(b));return r;}
typedef float f32x2_t __attribute__((ext_vector_type(2))); typedef __bf16 bf16x2_t __attribute__((ext_vector_type(2)));
__device__ __forceinline__ unsigned cvtpk_s(float lo,float hi){f32x2_t v={lo,hi};bf16x2_t b=__builtin_convertvector(v,bf16x2_t);return __builtin_bit_cast(unsigned,b);}
#define WAIT_BAR(N) asm volatile("s_waitcnt vmcnt(" #N ") lgkmcnt(0)\n\ts_barrier":::"memory")

__device__ __forceinline__ void zero16(f32x16&x){
  #pragma unroll
  for(int r=0;r<16;++r){float z;asm volatile("v_mov_b32 %0, 0":"=v"(z));x[r]=z;}
}
__device__ __forceinline__ void qkt(f32x16&p0,f32x16&p1,const char*Kslot,const bf16x8*qr,const f32x16&negm,int r32,int hi){
  const char*kb=Kslot+hi*1024+r32*16;
  #pragma unroll
  for(int d0=0;d0<4;++d0){
    const bf16x8 b0=*reinterpret_cast<const bf16x8*>(kb+d0*2048);
    const bf16x8 b1=*reinterpret_cast<const bf16x8*>(kb+d0*2048+512);
    if(d0==0){p0=__builtin_amdgcn_mfma_f32_32x32x16_bf16(b0,qr[0],negm,0,0,0);p1=__builtin_amdgcn_mfma_f32_32x32x16_bf16(b1,qr[0],negm,0,0,0);}
    else{p0=__builtin_amdgcn_mfma_f32_32x32x16_bf16(b0,qr[d0],p0,0,0,0);p1=__builtin_amdgcn_mfma_f32_32x32x16_bf16(b1,qr[d0],p1,0,0,0);}}
}
typedef __attribute__((address_space(3))) const char* lds_cptr;
typedef short v4i16_t __attribute__((ext_vector_type(4)));
__device__ __forceinline__ void kload8(bf16x8*kf,lds_cptr kp){
  kf[0]=*(const __attribute__((address_space(3))) bf16x8*)(kp);      kf[1]=*(const __attribute__((address_space(3))) bf16x8*)(kp+512);
  kf[2]=*(const __attribute__((address_space(3))) bf16x8*)(kp+2048); kf[3]=*(const __attribute__((address_space(3))) bf16x8*)(kp+2560);
  kf[4]=*(const __attribute__((address_space(3))) bf16x8*)(kp+4096); kf[5]=*(const __attribute__((address_space(3))) bf16x8*)(kp+4608);
  kf[6]=*(const __attribute__((address_space(3))) bf16x8*)(kp+6144); kf[7]=*(const __attribute__((address_space(3))) bf16x8*)(kp+6656);
}
__device__ __forceinline__ void kload2(bf16x8*kf,lds_cptr kp,int j){ kf[2*j]=*(const __attribute__((address_space(3))) bf16x8*)(kp+j*2048); kf[2*j+1]=*(const __attribute__((address_space(3))) bf16x8*)(kp+j*2048+512); }
__device__ __forceinline__ s16x4 vtr(lds_cptr p){ return __builtin_bit_cast(s16x4,__builtin_amdgcn_ds_read_tr16_b64_v4i16((__attribute__((address_space(3))) v4i16_t*)p)); }
__device__ __forceinline__ float rowmax(const f32x16&p0,const f32x16&p1){
  float a=max3f(p0[0],p0[1],p1[0]),b=max3f(p0[2],p0[3],p1[1]);a=max3f(a,p1[2],p1[3]);
  #pragma unroll
  for(int r=4;r<16;r+=4){a=max3f(a,p0[r],p0[r+1]);b=max3f(b,p0[r+2],p0[r+3]);a=max3f(a,p1[r],p1[r+1]);b=max3f(b,p1[r+2],p1[r+3]);}
  const float m=max2f(a,b);
  auto rr=__builtin_amdgcn_permlane32_swap(__float_as_uint(m),__float_as_uint(m),false,false);
  return max2f(__uint_as_float(rr[0]),__uint_as_float(rr[1]));
}
template<int NB> __device__ __forceinline__ void pv(f32x16*o,int vb,bf16x8 pa0,bf16x8 pa1,bf16x8 pa2,bf16x8 pa3){
  #pragma unroll
  for(int d0=0;d0<NB;++d0){s16x4 lo[4],hi[4];
    #pragma unroll
    for(int ks=0;ks<4;++ks){
      asm volatile("ds_read_b64_tr_b16 %0,%1 offset:%c2":"=&v"(lo[ks]):"v"(vb),"i"(d0*4096+ks*1024):"memory");
      asm volatile("ds_read_b64_tr_b16 %0,%1 offset:%c2":"=&v"(hi[ks]):"v"(vb),"i"(d0*4096+ks*1024+512):"memory");}
    asm volatile("s_waitcnt lgkmcnt(0)":::"memory");SBAR();
    #define PK(k) (bf16x8){lo[k][0],lo[k][1],lo[k][2],lo[k][3],hi[k][0],hi[k][1],hi[k][2],hi[k][3]}
    o[d0]=__builtin_amdgcn_mfma_f32_32x32x16_bf16(pa0,PK(0),o[d0],0,0,0);
    o[d0]=__builtin_amdgcn_mfma_f32_32x32x16_bf16(pa1,PK(1),o[d0],0,0,0);
    o[d0]=__builtin_amdgcn_mfma_f32_32x32x16_bf16(pa2,PK(2),o[d0],0,0,0);
    o[d0]=__builtin_amdgcn_mfma_f32_32x32x16_bf16(pa3,PK(3),o[d0],0,0,0);
    #undef PK
  }
}
#ifndef ATTN_STORE16
#define ATTN_STORE16(p,v) (*(u32x4*)(p)=(v))
#endif
#define PKW(P,B) cvtpk_s(P[B],P[B+1])
#define PAF(k) __builtin_bit_cast(bf16x8,pw##k)
#define PIN(x) asm volatile("":"+v"(x))
#define MX3(a,b,c) __builtin_fmaxf(__builtin_fmaxf((a),(b)),(c))
#define EX(v) __builtin_amdgcn_exp2f(v)
#define MF32(a,b,c) __builtin_amdgcn_mfma_f32_32x32x16_bf16(a,b,c,0,0,0)
typedef float f32x2s __attribute__((ext_vector_type(2)));
#define GAPA(MF,A0,A1,A2,A3,W0,W1,PW) do{ MF; sacc+=(f32x2s){A0,A1}; sacc+=(f32x2s){A2,A3}; PIN(sacc); W0; W1; PIN(PW); SBAR(); }while(0)
#define GAPA1(MF,A0,A1,W0,W1,PW) do{ MF; sacc+=(f32x2s){A0,A1}; PIN(sacc); W0; W1; PIN(PW); SBAR(); }while(0)
#define ROT() do{sl_prev=sl_cur;sl_cur=sl_next;sl_next=(sl_next==(NSLOT-1)*SLOTB)?0:sl_next+SLOTB;}while(0)
#define DECIDE(C0,C1) do{ float a=MX3(C0[0],C0[1],C1[0]),b=MX3(C0[2],C0[3],C1[1]); a=MX3(a,C1[2],C1[3]); \
      _Pragma("unroll") for(int r=4;r<16;r+=4){a=MX3(a,C0[r],C0[r+1]);b=MX3(b,C0[r+2],C0[r+3]);a=MX3(a,C1[r],C1[r+1]);b=MX3(b,C1[r+2],C1[r+3]);} \
      float rm=__builtin_fmaxf(a,b); { auto rr=__builtin_amdgcn_permlane32_swap(__float_as_uint(rm),__float_as_uint(rm),false,false); rm=__builtin_fmaxf(__uint_as_float(rr[0]),__uint_as_float(rr[1])); } \
      resc=false; \
      if(__builtin_expect(__any(rm>(float)THRL),0)){ const float dl=__builtin_fmaxf(rm,0.f); mhat+=dl; \
        _Pragma("unroll") for(int r=0;r<16;++r){C0[r]-=dl;C1[r]-=dl;} \
        _Pragma("unroll") for(int r=0;r<16;++r)negm[r]=-mhat; asm volatile("":"+v"(negm)); \
        const float f=__builtin_amdgcn_exp2f(-dl); l_reg*=f; if(hi==0)wsf[r32]=f; resc=true; } }while(0)
#define START(P0,P1) do{ const float rm=rowmax(P0,P1); resc=false; \
    { const float dl=rm; mhat=fadd_s(mhat,dl); \
      _Pragma("unroll") for(int r=0;r<16;++r){P0[r]=fsub_s(P0[r],dl);P1[r]=fsub_s(P1[r],dl);} \
      _Pragma("unroll") for(int r=0;r<16;++r)negm[r]=-mhat; asm volatile("":"+v"(negm)); } \
    _Pragma("unroll") for(int r=0;r<16;++r)P0[r]=__builtin_amdgcn_exp2f(P0[r]); }while(0)
#define KRD(G,j) do{ if(G){ kload2(kf,kp0+sl_next,j); SBAR(); } }while(0)

template<int THRL> __device__ __forceinline__ void attn_unit_a(int qb,const bf16*Qp,__amdgpu_buffer_rsrc_t srd,unsigned kbyte,unsigned vbyte,bf16*Ob,char*shm,float mub,bool SB){
  const int tid=threadIdx.x,lane=tid&63,r32=lane&31,hi=lane>>5; const int wid=__builtin_amdgcn_readfirstlane(tid>>6);
  const int q0=qb*QB;
  const bf16*Qw=Qp+(long)(q0+wid*QBLK)*PP;
  const unsigned lds0=(unsigned)(uintptr_t)shm;
  float*wsf=(float*)(shm+LDS_WS)+wid*64;
  const unsigned kvoff=(unsigned)(lane*PP+wid*8)*2u, vvoff=(unsigned)((16*(wid&3)+(lane>>2))*PP+(wid>>2)*32+(lane&3)*8)*2u;
  const unsigned kdst=lds0+LDS_K+wid*1024, vdst=lds0+LDS_V+wid*1024;
  #define DMA_K(t,slot) glds16b(srd,kvoff,(unsigned)__builtin_amdgcn_readfirstlane(kbyte+(unsigned)(t)*(KVBLK*PP*2)),(unsigned)__builtin_amdgcn_readfirstlane(kdst+(slot)))
  #define DMA_V(t,slot) glds16b(srd,vvoff,(unsigned)__builtin_amdgcn_readfirstlane(vbyte+(unsigned)(t)*(KVBLK*PP*2)),(unsigned)__builtin_amdgcn_readfirstlane(vdst+2*(slot)))
  const int vb0=(int)(lds0+LDS_V)+((lane>>4)&1)*32+(lane&3)*8+(4*hi+((lane&15)>>2))*64;
  const char*Kbase=shm+LDS_K; bf16x8 kf[8];
  const lds_cptr shm3=(lds_cptr)shm; const lds_cptr kp0=shm3+LDS_K+hi*1024+r32*16; const lds_cptr vp0=shm3+LDS_V+((lane>>4)&1)*32+(lane&3)*8+(4*hi+((lane&15)>>2))*64;
  DMA_K(0,0);DMA_V(0,0);DMA_K(1,SLOTB);
  bf16x8 qr[4];
  #pragma unroll
  for(int d0=0;d0<4;++d0)qr[d0]=*reinterpret_cast<const bf16x8*>(&Qw[(long)r32*PP+d0*16+hi*8]);
  float mhat=0.f,l_reg=0.f;f32x16 o[2];zero16(o[0]);zero16(o[1]);f32x16 negm;zero16(negm);
  if(SB){ _Pragma("unroll") for(int r=0;r<16;++r)negm[r]=-mub; asm volatile("":"+v"(negm)); }
  bool resc=false;
  #define RESC() do{ if(!SB && resc){ asm volatile("s_waitcnt lgkmcnt(0)":::"memory"); \
      _Pragma("unroll") for(int d_=0;d_<2;++d_) _Pragma("unroll") for(int r=0;r<16;++r)o[d_][r]*=wsf[crow(r,hi)]; } }while(0)
  f32x16 pA0,pA1,pB0,pB1;
  int sl_prev=0,sl_cur=0,sl_next=SLOTB;
  DMA_K(2,2*SLOTB);
  WAIT_BAR(3);
  qkt(pA0,pA1,Kbase,qr,negm,r32,hi);asm volatile("s_nop 15\n\ts_nop 7":"+v"(pA0),"+v"(pA1));
  if(SB){ _Pragma("unroll") for(int r=0;r<16;++r)pA0[r]=__builtin_amdgcn_exp2f(pA0[r]); } else { START(pA0,pA1); }
  _Pragma("unroll") for(int r=0;r<16;++r)pA1[r]=__builtin_amdgcn_exp2f(pA1[r]);
  WAIT_BAR(0);
  DMA_K(3,0);DMA_V(1,SLOTB);
  ROT();
  kload8(kf,kp0+sl_cur);
  WAIT_BAR(2);
  s16x4 vlo[8],vhi[8]; u32x4 pw0,pw1,pw2,pw3;
  #define VFR(i) (bf16x8){vlo[i][0],vlo[i][1],vlo[i][2],vlo[i][3],vhi[i][0],vhi[i][1],vhi[i][2],vhi[i][3]}
  #define GAPB(MF,X,B) do{ MF; X[B]=EX(X[B]); X[B+1]=EX(X[B+1]); X[B+2]=EX(X[B+2]); X[B+3]=EX(X[B+3]); PIN(X); SBAR(); }while(0)
  #define VRD(i) do{ vlo[i]=vtr(vp_+(((i)>>2)*4096+((i)&3)*1024)); vhi[i]=vtr(vp_+(((i)>>2)*4096+((i)&3)*1024+512)); }while(0)
  #define STEP(C0,C1,P0,P1,t,GK,GV,GL) do{ SBAR(); \
    const lds_cptr vp_=vp0+2*sl_prev; \
    VRD(0); SBAR(); f32x2s sacc=(f32x2s){P0[0],P0[1]}; \
    GAPA(C0=MF32(kf[0],qr[0],negm), P0[2],P0[3],P0[4],P0[5],     pw0[0]=PKW(P0,0), pw0[1]=PKW(P0,2), pw0); \
    VRD(4); SBAR(); GAPA(C1=MF32(kf[1],qr[0],negm), P0[6],P0[7],P0[8],P0[9],     pw0[2]=PKW(P0,4), pw0[3]=PKW(P0,6), pw0); \
    VRD(1); SBAR(); GAPA(C0=MF32(kf[2],qr[1],C0),   P0[10],P0[11],P0[12],P0[13], pw1[0]=PKW(P0,8), pw1[1]=PKW(P0,10), pw1); \
    VRD(5); SBAR(); GAPA(C1=MF32(kf[3],qr[1],C1),   P0[14],P0[15],P1[0],P1[1],   pw1[2]=PKW(P0,12),pw1[3]=PKW(P0,14), pw1); \
    VRD(2); SBAR(); GAPA(C0=MF32(kf[4],qr[2],C0),   P1[2],P1[3],P1[4],P1[5],     pw2[0]=PKW(P1,0), pw2[1]=PKW(P1,2), pw2); \
    VRD(6); SBAR(); GAPA(C1=MF32(kf[5],qr[2],C1),   P1[6],P1[7],P1[8],P1[9],     pw2[2]=PKW(P1,4), pw2[3]=PKW(P1,6), pw2); \
    VRD(3); SBAR(); GAPA(C0=MF32(kf[6],qr[3],C0),   P1[10],P1[11],P1[12],P1[13], pw3[0]=PKW(P1,8), pw3[1]=PKW(P1,10), pw3); \
    VRD(7); SBAR(); GAPA1(C1=MF32(kf[7],qr[3],C1),  P1[14],P1[15],               pw3[2]=PKW(P1,12),pw3[3]=PKW(P1,14), pw3); \
    l_reg+=sacc.x+sacc.y; \
    if(GK){DMA_K((t)+3,sl_cur);} if(GV){DMA_V((t)+1,sl_next);} \
    if(!SB){ DECIDE(C0,C1); } \
    SBAR(); __builtin_amdgcn_s_setprio(1); \
    GAPB(o[0]=MF32(PAF(0),VFR(0),o[0]), C0,0); \
    GAPB(o[1]=MF32(PAF(0),VFR(4),o[1]), C0,4); \
    KRD(GL,0); GAPB(o[0]=MF32(PAF(1),VFR(1),o[0]), C0,8); \
    KRD(GL,1); GAPB(o[1]=MF32(PAF(1),VFR(5),o[1]), C0,12); \
    KRD(GL,2); GAPB(o[0]=MF32(PAF(2),VFR(2),o[0]), C1,0); \
    KRD(GL,3); GAPB(o[1]=MF32(PAF(2),VFR(6),o[1]), C1,4); \
    GAPB(o[0]=MF32(PAF(3),VFR(3),o[0]), C1,8); \
    GAPB(o[1]=MF32(PAF(3),VFR(7),o[1]), C1,12); __builtin_amdgcn_s_setprio(0); \
    }while(0)
  int t=1;
  for(;t+5<NT;t+=2){
    STEP(pB0,pB1,pA0,pA1,t,true,true,true);     WAIT_BAR(2); RESC(); ROT();
    STEP(pA0,pA1,pB0,pB1,t+1,true,true,true);   WAIT_BAR(2); RESC(); ROT();
  }
  #define ENDW(tt) do{ if((tt)+3<NT){WAIT_BAR(2);} else if((tt)+2<NT){WAIT_BAR(1);} else {WAIT_BAR(0);} }while(0)
  for(;t+1<NT;t+=2){
    STEP(pB0,pB1,pA0,pA1,t,(t+3<NT),(t+1<NT),(t+1<NT));       ENDW(t);   RESC(); ROT();
    STEP(pA0,pA1,pB0,pB1,t+1,(t+4<NT),(t+2<NT),(t+2<NT));     ENDW(t+1); RESC(); ROT();
  }
  STEP(pB0,pB1,pA0,pA1,NT-1,false,false,false); RESC();
  { float sacc=pB0[0]+pB0[1]; _Pragma("unroll") for(int r=2;r<16;++r)sacc+=pB0[r]; _Pragma("unroll") for(int r=0;r<16;++r)sacc+=pB1[r]; l_reg+=sacc;
    pw0=(u32x4){PKW(pB0,0),PKW(pB0,2),PKW(pB0,4),PKW(pB0,6)};pw1=(u32x4){PKW(pB0,8),PKW(pB0,10),PKW(pB0,12),PKW(pB0,14)};pw2=(u32x4){PKW(pB1,0),PKW(pB1,2),PKW(pB1,4),PKW(pB1,6)};pw3=(u32x4){PKW(pB1,8),PKW(pB1,10),PKW(pB1,12),PKW(pB1,14)};
    SBAR(); pv<2>(o,vb0+2*sl_cur,PAF(0),PAF(1),PAF(2),PAF(3)); }
  #undef VFR
  #undef GAPB
  #undef VRD
  #undef STEP
  #undef ENDW
  {auto rr=__builtin_amdgcn_permlane32_swap(__float_as_uint(l_reg),__float_as_uint(l_reg),false,false);l_reg=__uint_as_float(rr[0])+__uint_as_float(rr[1]);}
  if(hi==0)wsf[32+r32]=l_reg;asm volatile("s_waitcnt lgkmcnt(0)":::"memory");
  float rli[16];
  #pragma unroll
  for(int r=0;r<16;++r)rli[r]=__builtin_amdgcn_rcpf(wsf[32+crow(r,hi)]);
  bf16*Ow=Ob+(long)(q0+wid*QBLK)*OPITCH;
  { bf16*stg=(bf16*)(shm+LDS_OST)+wid*4096;
    #pragma unroll
    for(int r=0;r<16;++r){const int orow=crow(r,hi);
      #pragma unroll
      for(int d0=0;d0<2;++d0)stg[orow*64+d0*32+r32]=__float2bfloat16(o[d0][r]*rli[r]);}
    asm volatile("s_waitcnt lgkmcnt(0)":::"memory");
    #pragma unroll
    for(int i=0;i<4;++i){const int row=i*8+(lane>>3),ch=lane&7; const u32x4 v=*(const u32x4*)(stg+row*64+ch*8); ATTN_STORE16(Ow+(long)row*OPITCH+ch*8,v);} }
  asm volatile("s_waitcnt lgkmcnt(0)\n\ts_barrier":::"memory");
  #undef DMA_K
  #undef DMA_V
  #undef RESC
}
template<int THRL> __device__ __forceinline__ void attn_unit_b(int qb,int comp,const bf16*Qp,__amdgpu_buffer_rsrc_t srd,unsigned kbyte,unsigned vbyte,float*sc,float lam,const float*subg,bf16*Ob,char*shm,float mub,bool SB){
  const int tid=threadIdx.x,lane=tid&63,r32=lane&31,hi=lane>>5; const int wid=__builtin_amdgcn_readfirstlane(tid>>6);
  const int q0=qb*QB;
  const bf16*Qw=Qp+(long)(q0+wid*QBLK)*PP;
  const unsigned lds0=(unsigned)(uintptr_t)shm;
  float*wsf=(float*)(shm+LDS_WS)+wid*64;
  const unsigned kvoff=(unsigned)(lane*PP+wid*8)*2u;
  const unsigned vvoff=(unsigned)((16*(wid&3)+(lane>>2))*PP+(wid>>2)*32+(lane&3)*8)*2u;
  const unsigned kdst=lds0+LDS_K+wid*1024, vdst=lds0+LDS_V+wid*1024;
  #define DMA_K(t,slot) glds16b(srd,kvoff,(unsigned)__builtin_amdgcn_readfirstlane(kbyte+(unsigned)(t)*(KVBLK*PP*2)),(unsigned)__builtin_amdgcn_readfirstlane(kdst+(slot)))
  #define DMA_V(t,slot) do{ const unsigned so_=(unsigned)__builtin_amdgcn_readfirstlane(vbyte+(unsigned)(t)*(KVBLK*PP*2)); glds16b(srd,vvoff,so_,(unsigned)__builtin_amdgcn_readfirstlane(vdst+2*(slot))); glds16b(srd,vvoff,so_+(unsigned)(SEQ*PP*2),(unsigned)__builtin_amdgcn_readfirstlane(vdst+2*(slot)+8192)); }while(0)
  const int vb0=(int)(lds0+LDS_V)+((lane>>4)&1)*32+(lane&3)*8+(4*hi+((lane&15)>>2))*64;
  const char*Kbase=shm+LDS_K; bf16x8 kf[8];
  const lds_cptr shm3=(lds_cptr)shm; const lds_cptr kp0=shm3+LDS_K+hi*1024+r32*16; const lds_cptr vp0=shm3+LDS_V+((lane>>4)&1)*32+(lane&3)*8+(4*hi+((lane&15)>>2))*64;
  DMA_K(0,0);DMA_V(0,0);DMA_K(1,SLOTB);
  bf16x8 qr[4];
  #pragma unroll
  for(int d0=0;d0<4;++d0)qr[d0]=*reinterpret_cast<const bf16x8*>(&Qw[(long)r32*PP+d0*16+hi*8]);
  float mhat=0.f,l_reg=0.f;f32x16 o[4];zero16(o[0]);zero16(o[1]);zero16(o[2]);zero16(o[3]);f32x16 negm;zero16(negm);
  if(SB){ _Pragma("unroll") for(int r=0;r<16;++r)negm[r]=-mub; asm volatile("":"+v"(negm)); }
  bool resc=false;
  #define RESC() do{ if(!SB && resc){ asm volatile("s_waitcnt lgkmcnt(0)":::"memory"); \
      _Pragma("unroll") for(int d_=0;d_<4;++d_) _Pragma("unroll") for(int r=0;r<16;++r)o[d_][r]*=wsf[crow(r,hi)]; } }while(0)
  f32x16 pA0,pA1,pB0,pB1;
  int sl_prev=0,sl_cur=0,sl_next=SLOTB;
  DMA_K(2,2*SLOTB);
  WAIT_BAR(4);
  qkt(pA0,pA1,Kbase,qr,negm,r32,hi);asm volatile("s_nop 15\n\ts_nop 7":"+v"(pA0),"+v"(pA1));
  if(SB){ _Pragma("unroll") for(int r=0;r<16;++r)pA0[r]=__builtin_amdgcn_exp2f(pA0[r]); } else { START(pA0,pA1); }
  _Pragma("unroll") for(int r=0;r<16;++r)pA1[r]=__builtin_amdgcn_exp2f(pA1[r]);
  WAIT_BAR(0);
  DMA_K(3,0);DMA_V(1,SLOTB);
  ROT();
  kload8(kf,kp0+sl_cur);
  WAIT_BAR(3);
  s16x4 vfl[4],vfh[4]; u32x4 pw0,pw1,pw2,pw3;
  #define VFRB(g) (bf16x8){vfl[(g)&3][0],vfl[(g)&3][1],vfl[(g)&3][2],vfl[(g)&3][3],vfh[(g)&3][0],vfh[(g)&3][1],vfh[(g)&3][2],vfh[(g)&3][3]}
  #define VRDB(g) do{ vfl[(g)&3]=vtr(vp_+(((g)&3)*4096+((g)>>2)*1024)); vfh[(g)&3]=vtr(vp_+(((g)&3)*4096+((g)>>2)*1024+512)); }while(0)
  #define GAPB2(g,X,B) do{ o[(g)&3]=MF32(PAF4((g)>>2),VFRB(g),o[(g)&3]); X[B]=EX(X[B]); X[B+1]=EX(X[B+1]); PIN(X); SBAR(); }while(0)
  #define PAF4(k) ((k)==0?PAF(0):(k)==1?PAF(1):(k)==2?PAF(2):PAF(3))
  #define STEPB(C0,C1,P0,P1,t,GK,GV,GL) do{ SBAR(); \
    const lds_cptr vp_=vp0+2*sl_prev; \
    f32x2s sacc=(f32x2s){P0[0],P0[1]}; \
    GAPA(C0=MF32(kf[0],qr[0],negm), P0[2],P0[3],P0[4],P0[5],     pw0[0]=PKW(P0,0), pw0[1]=PKW(P0,2), pw0); \
    GAPA(C1=MF32(kf[1],qr[0],negm), P0[6],P0[7],P0[8],P0[9],     pw0[2]=PKW(P0,4), pw0[3]=PKW(P0,6), pw0); \
    GAPA(C0=MF32(kf[2],qr[1],C0),   P0[10],P0[11],P0[12],P0[13], pw1[0]=PKW(P0,8), pw1[1]=PKW(P0,10), pw1); \
    GAPA(C1=MF32(kf[3],qr[1],C1),   P0[14],P0[15],P1[0],P1[1],   pw1[2]=PKW(P0,12),pw1[3]=PKW(P0,14), pw1); \
    GAPA(C0=MF32(kf[4],qr[2],C0),   P1[2],P1[3],P1[4],P1[5],     pw2[0]=PKW(P1,0), pw2[1]=PKW(P1,2), pw2); \
    GAPA(C1=MF32(kf[5],qr[2],C1),   P1[6],P1[7],P1[8],P1[9],     pw2[2]=PKW(P1,4), pw2[3]=PKW(P1,6), pw2); \
    GAPA(C0=MF32(kf[6],qr[3],C0),   P1[10],P1[11],P1[12],P1[13], pw3[0]=PKW(P1,8), pw3[1]=PKW(P1,10), pw3); \
    GAPA1(C1=MF32(kf[7],qr[3],C1),  P1[14],P1[15],               pw3[2]=PKW(P1,12),pw3[3]=PKW(P1,14), pw3); \
    l_reg+=sacc.x+sacc.y; \
    if(GK){DMA_K((t)+3,sl_cur);} if(GV){DMA_V((t)+1,sl_next);} \
    VRDB(0); VRDB(1); SBAR(); \
    if(!SB){ DECIDE(C0,C1); } \
    SBAR(); __builtin_amdgcn_s_setprio(1); \
    VRDB(2);  SBAR(); GAPB2(0, C0,0); \
    VRDB(3);  SBAR(); GAPB2(1, C0,2); \
    VRDB(4);  SBAR(); GAPB2(2, C0,4); \
    VRDB(5);  SBAR(); GAPB2(3, C0,6); \
    KRD(GL,0); VRDB(6);  SBAR(); GAPB2(4, C0,8); \
    VRDB(7);  SBAR(); GAPB2(5, C0,10); \
    KRD(GL,1); VRDB(8);  SBAR(); GAPB2(6, C0,12); \
    VRDB(9);  SBAR(); GAPB2(7, C0,14); \
    KRD(GL,2); VRDB(10); SBAR(); GAPB2(8, C1,0); \
    VRDB(11); SBAR(); GAPB2(9, C1,2); \
    KRD(GL,3); VRDB(12); SBAR(); GAPB2(10,C1,4); \
    VRDB(13); SBAR(); GAPB2(11,C1,6); \
    VRDB(14); SBAR(); GAPB2(12,C1,8); \
    VRDB(15); SBAR(); GAPB2(13,C1,10); \
    GAPB2(14,C1,12); \
    GAPB2(15,C1,14); __builtin_amdgcn_s_setprio(0); \
    }while(0)
  int t=1;
  for(;t+5<NT;t+=2){
    STEPB(pB0,pB1,pA0,pA1,t,true,true,true);     WAIT_BAR(3); RESC(); ROT();
    STEPB(pA0,pA1,pB0,pB1,t+1,true,true,true);   WAIT_BAR(3); RESC(); ROT();
  }
  #define ENDW(tt) do{ if((tt)+3<NT){WAIT_BAR(3);} else if((tt)+2<NT){WAIT_BAR(2);} else {WAIT_BAR(0);} }while(0)
  for(;t+1<NT;t+=2){
    STEPB(pB0,pB1,pA0,pA1,t,(t+3<NT),(t+1<NT),(t+1<NT));       ENDW(t);   RESC(); ROT();
    STEPB(pA0,pA1,pB0,pB1,t+1,(t+4<NT),(t+2<NT),(t+2<NT));     ENDW(t+1); RESC(); ROT();
  }
  STEPB(pB0,pB1,pA0,pA1,NT-1,false,false,false); RESC();
  { float sacc=pB0[0]+pB0[1]; _Pragma("unroll") for(int r=2;r<16;++r)sacc+=pB0[r]; _Pragma("unroll") for(int r=0;r<16;++r)sacc+=pB1[r]; l_reg+=sacc;
    pw0=(u32x4){PKW(pB0,0),PKW(pB0,2),PKW(pB0,4),PKW(pB0,6)};pw1=(u32x4){PKW(pB0,8),PKW(pB0,10),PKW(pB0,12),PKW(pB0,14)};pw2=(u32x4){PKW(pB1,0),PKW(pB1,2),PKW(pB1,4),PKW(pB1,6)};pw3=(u32x4){PKW(pB1,8),PKW(pB1,10),PKW(pB1,12),PKW(pB1,14)};
    SBAR(); pv<4>(o,vb0+2*sl_cur,PAF(0),PAF(1),PAF(2),PAF(3)); }
  #undef VFRB
  #undef VRDB
  #undef GAPB2
  #undef PAF4
  #undef STEPB
  #undef ENDW
  {auto rr=__builtin_amdgcn_permlane32_swap(__float_as_uint(l_reg),__float_as_uint(l_reg),false,false);l_reg=__uint_as_float(rr[0])+__uint_as_float(rr[1]);}
  if(hi==0)wsf[32+r32]=l_reg;asm volatile("s_waitcnt lgkmcnt(0)":::"memory");
  float rli[16];
  #pragma unroll
  for(int r=0;r<16;++r)rli[r]=__builtin_amdgcn_rcpf(wsf[32+crow(r,hi)]);
  int lane_e=lane; asm volatile("":"+v"(lane_e));
  const int r32e=lane_e&31, hie=lane_e>>5;
  float*scw=sc+(long)wid*4096+lane_e;
  if(comp==0){
    #pragma unroll
    for(int d0=0;d0<4;++d0)
      #pragma unroll
      for(int r=0;r<16;++r)scw[(d0*16+r)*64]=o[d0][r]*rli[r];
  } else {
    float ssq[16];
    #pragma unroll
    for(int r=0;r<16;++r)ssq[r]=0.f;
    #pragma unroll
    for(int d0=0;d0<4;++d0)
      #pragma unroll
      for(int r=0;r<16;++r){ const float dv=scw[(d0*16+r)*64]-lam*(o[d0][r]*rli[r]); o[d0][r]=dv; ssq[r]+=dv*dv; }
    #pragma unroll
    for(int r=0;r<16;++r){ float s=ssq[r]; s+=__shfl_xor(s,1); s+=__shfl_xor(s,2); s+=__shfl_xor(s,4); s+=__shfl_xor(s,8); s+=__shfl_xor(s,16); ssq[r]=__builtin_amdgcn_rsqf(s*(1.0f/128.0f)+1e-5f)*0.8f; }
    float gsub[4];
    #pragma unroll
    for(int d0=0;d0<4;++d0)gsub[d0]=subg[d0*32+r32e];
    bf16*Ow=Ob+(long)(q0+wid*QBLK)*OPITCH;
    bf16*stg=(bf16*)(shm+LDS_OST)+wid*4096;
    #pragma unroll
    for(int r=0;r<16;++r){const int orow=crow(r,hie);
      #pragma unroll
      for(int d0=0;d0<4;++d0)stg[orow*128+d0*32+r32e]=__float2bfloat16(o[d0][r]*ssq[r]*gsub[d0]);}
    asm volatile("s_waitcnt lgkmcnt(0)":::"memory");
    #pragma unroll
    for(int i=0;i<8;++i){const int row=i*4+(lane_e>>4),ch=lane_e&15; const u32x4 v=*(const u32x4*)(stg+row*128+ch*8); ATTN_STORE16(Ow+(long)row*OPITCH+ch*8,v);}
  }
  asm volatile("s_waitcnt vmcnt(0) lgkmcnt(0)\n\ts_barrier":::"memory");
  #undef DMA_K
  #undef DMA_V
  #undef RESC
}
#undef PKW
#undef PAF
#undef PIN
#undef MX3
#undef EX
#undef MF32
#undef GAPA
#undef ROT
#undef DECIDE
#undef START
#undef KRD
#undef SBAR
#undef WAIT_BAR
constexpr int ATTN_LDS_BYTES=LDS_BYTES;
}
constexpr int NWAVES = 8;
#ifndef MK_N_LAUNCHES
#define MK_N_LAUNCHES 1
#endif
constexpr int PER_PHASE = 7;
constexpr int N_LAUNCHES = MK_N_LAUNCHES;
static_assert(N_LAUNCHES == 1 || N_LAUNCHES == PER_PHASE, "MK_N_LAUNCHES is 1 or 7");

constexpr int M = 16384, DM = 1024, NIN = 2304, NQ = 2048, NEXP = 16384;
constexpr float C2 = 0.125f * 1.4426950408889634f;
constexpr float NORM_EPS = 1e-6f;

constexpr size_t MiB = 1u << 20;
constexpr size_t WS_CTL = 0, CTL_ZERO_BYTES = 1 * MiB;
constexpr size_t WS_TROW = 1 * MiB, WS_TCOL = 1 * MiB + 65536, WS_TPOS = 1 * MiB + 524288;
constexpr size_t WS_SK = 3 * MiB;
constexpr size_t WS_SSQ = 4 * MiB;
constexpr size_t WS_INVS = 5 * MiB;
constexpr size_t WS_WIN = 6 * MiB, WS_WOUT = 11 * MiB, WS_WQ = 13 * MiB;
constexpr size_t WS_UV8 = 32 * MiB;
constexpr int EROW = 1024;
constexpr size_t WS_SCL = 5 * MiB + 524288;
constexpr size_t WS_XN = 96 * MiB;
constexpr size_t WS_QKV = 128 * MiB;
constexpr size_t WS_AO = 200 * MiB;
constexpr size_t WS_META = 232 * MiB;
constexpr size_t WS_END = 248 * MiB;
constexpr int CW_TMO = 0, CW_CODE = 1, CW_BAR = 4096;

constexpr int RING_OFF = 0, RING_BYTES = 147456;
constexpr int LDSCTL_OFF = RING_BYTES, MISC_OFF = LDSCTL_OFF + 320;
constexpr int LDS_BYTES = RING_BYTES + 4096;
static_assert(attn_body::ATTN_LDS_BYTES <= RING_BYTES && pg8::STAGE_BYTES <= RING_BYTES, "LDS map");

#define GAS __attribute__((address_space(1)))
#define LAS __attribute__((address_space(3)))
typedef unsigned short bf16;
typedef unsigned v4u __attribute__((ext_vector_type(4)));
typedef unsigned v2u __attribute__((ext_vector_type(2)));
typedef float f32x4 __attribute__((ext_vector_type(4)));
typedef float f32x16 __attribute__((ext_vector_type(16)));
typedef short bf16x8 __attribute__((ext_vector_type(8)));
typedef __bf16 bf16x2_t __attribute__((ext_vector_type(2)));
typedef GAS unsigned gu32;
#define RLX_AGENT __ATOMIC_RELAXED, __HIP_MEMORY_SCOPE_AGENT
#define LDS_WAIT() asm volatile("s_waitcnt lgkmcnt(0)" ::: "memory")
#define VM_WAIT() asm volatile("s_waitcnt vmcnt(0)" ::: "memory")
__device__ __forceinline__ unsigned f2bf(float f) { unsigned u = __builtin_bit_cast(unsigned, f); return (u + 0x7fffu + ((u >> 16) & 1u)) >> 16; }
__device__ __forceinline__ unsigned pk2(float lo, float hi) { return f2bf(lo) | (f2bf(hi) << 16); }
#define XB_TMO      128
#define XB_XCNT(j)  (256  + 64 * (j))
#define XB_XSUB(j)  (1280 + 64 * (j))
#define XB_XGEN(j)  (2304 + 64 * (j))
#define XB_TOP      3328
#define XB_TOPGEN   3392
#define XCD_BAR_WORDS 3456
#define XB_SPIN_CAP (1u << 18)

__device__ __forceinline__ unsigned xb_ld(unsigned* p)              { return __hip_atomic_load(p, __ATOMIC_RELAXED, __HIP_MEMORY_SCOPE_AGENT); }
__device__ __forceinline__ unsigned xb_add(unsigned* p, unsigned v) { return __hip_atomic_fetch_add(p, v, __ATOMIC_RELAXED, __HIP_MEMORY_SCOPE_AGENT); }
__device__ __forceinline__ unsigned xb_xcc_id() { return (unsigned)__builtin_amdgcn_s_getreg((3 << 11) | 20) & 0xFu; }
#define XB_SPIN(cond, bar) do { unsigned _sp = 0; while (cond) { __builtin_amdgcn_s_sleep(1); \
    if ((++_sp & 255u) == 0u) { if (xb_ld(&(bar)[XB_TMO])) break; if (_sp > XB_SPIN_CAP) { atomicAdd(&(bar)[XB_TMO], 1u); break; } } } } while (0)

struct XcdBarrier {
    unsigned* bar; unsigned x;
    volatile LAS unsigned* st;
};

__device__ __forceinline__ XcdBarrier xcd_barrier_post(unsigned* bar, volatile LAS unsigned* st) {
    XcdBarrier b; b.bar = bar; b.x = xb_xcc_id(); b.st = st;
    if (threadIdx.x == 0) (void)xb_add(&bar[XB_XCNT(b.x)], 1u);
    return b;
}
__device__ __forceinline__ void xcd_barrier_complete(unsigned* bar, unsigned x, unsigned& nloc, unsigned& nx) {
    const unsigned G = gridDim.x * gridDim.y * gridDim.z;
    unsigned sum, cnt, mine, sp = 0u;
    for (;;) {
        sum = 0u; cnt = 0u; mine = 0u;
#pragma unroll
        for (unsigned j = 0; j < 16; ++j) { const unsigned c = xb_ld(&bar[XB_XCNT(j)]); sum += c; cnt += (c > 0u) ? 1u : 0u; mine = (j == x) ? c : mine; }
        if (sum == G) break;
        __builtin_amdgcn_s_sleep(1);
        if ((++sp & 255u) == 0u) { if (xb_ld(&bar[XB_TMO])) break; if (sp > XB_SPIN_CAP) { atomicAdd(&bar[XB_TMO], 1u); break; } }
    }
    nloc = mine > 0u ? mine : 1u; nx = cnt > 0u ? cnt : 1u;
}

__device__ __forceinline__ void xcd_barrier(const XcdBarrier& b) {
    asm volatile("s_waitcnt vmcnt(0)" ::: "memory");
    __syncthreads();
    if (threadIdx.x == 0) {
        unsigned* bar = b.bar;
        __builtin_amdgcn_s_waitcnt(0);
        unsigned nloc = b.st[0], nx = b.st[1];
        if (nloc == 0u) { xcd_barrier_complete(bar, b.x, nloc, nx); b.st[0] = nloc; b.st[1] = nx; }
        const unsigned old = xb_add(&bar[XB_XSUB(b.x)], 1u);
        const unsigned gen = old / nloc;
        if (old + 1u == (gen + 1u) * nloc) {
            __builtin_amdgcn_fence(__ATOMIC_RELEASE, "agent");
            asm volatile("s_waitcnt vmcnt(0)" ::: "memory");
            const unsigned og = xb_add(&bar[XB_TOP], 1u);
            const unsigned tg = og / nx;
            if (og + 1u == (tg + 1u) * nx) xb_add(&bar[XB_TOPGEN], 1u);
            else XB_SPIN(xb_ld(&bar[XB_TOPGEN]) == tg, bar);
            __builtin_amdgcn_fence(__ATOMIC_ACQUIRE, "agent");
            xb_add(&bar[XB_XGEN(b.x)], 1u);
            asm volatile("s_waitcnt vmcnt(0)" ::: "memory");
        } else {
            XB_SPIN(xb_ld(&bar[XB_XGEN(b.x)]) == gen, bar);
            __builtin_amdgcn_fence(__ATOMIC_ACQUIRE, "agent");
            asm volatile("s_waitcnt vmcnt(0)" ::: "memory");
        }
    }
    __syncthreads();
}
struct Frame {
    LAS unsigned char* lds;
    volatile LAS unsigned* MISC;
    gu32* ctl;
    int tid, lane, wave;
    int vcu, G;
};
struct Args { const float* in[17]; float* out; unsigned char* ws; double inv_ax[16]; double inv_p[8]; int ph_lo, ph_hi, li, pad; };

__device__ __forceinline__ float wave_sum(float v) {
#pragma unroll
    for (int o = 1; o < 64; o <<= 1) v += __shfl_xor(v, o);
    return v;
}
__host__ __device__ __forceinline__ int inproj_dst_col(int j) {
    const int s = j >> 6, d = j & 63; int bj, p;
    if (s < 10) { bj = d >> 5; p = 8 * ((d >> 2) & 3) + 4 * ((d >> 4) & 1) + (d & 3); }
    else if (s >= 12 && s < 28) { if (d < 32) { bj = 0; p = 8 * (2 * (d >> 4) + ((d >> 2) & 1)) + 4 * ((d >> 3) & 1) + (d & 3); } else { bj = 1; p = d - 32; } }
    else { bj = d >> 5; p = d & 31; }
    return (s >> 2) * 256 + bj * 128 + (s & 3) * 32 + p;
}
template <int MODE> __device__ __forceinline__ void p0_transpose_item(const float* W, int K, int N, bf16* WT, const float* kscale, LAS float* scr, int item, int lane) {
    const int nblk = N / 32, kb = item / nblk, nb = item % nblk, k0 = 64 * kb, n0 = 32 * nb;
    { f32x4 w[8];
#pragma unroll
      for (int i = 0; i < 8; ++i) w[i] = *(const GAS f32x4*)(W + (size_t)(k0 + (lane >> 3) + 8 * i) * N + n0 + 4 * (lane & 7));
#pragma unroll
      for (int i = 0; i < 8; ++i) { const int kk = (lane >> 3) + 8 * i; f32x4 v = w[i]; if (MODE == 2) v = v * kscale[k0 + kk];
          LAS float* d = scr + kk * 33 + 4 * (lane & 7); d[0] = v.x; d[1] = v.y; d[2] = v.z; d[3] = v.w; } }
    LDS_WAIT(); asm volatile("" ::: "memory");
    const int c = lane & 7;
#pragma unroll
    for (int j = 0; j < 4; ++j) { const int n = (lane >> 3) + 8 * j; const LAS float* s = scr + (8 * c) * 33 + n;
        v4u o; o.x = pk2(s[0 * 33], s[1 * 33]); o.y = pk2(s[2 * 33], s[3 * 33]); o.z = pk2(s[4 * 33], s[5 * 33]); o.w = pk2(s[6 * 33], s[7 * 33]);
        const int dr = (MODE == 1) ? inproj_dst_col(n0 + n) : (n0 + n);
        *(GAS v4u*)(WT + (size_t)dr * K + k0 + 8 * c) = o; }
    LDS_WAIT(); asm volatile("" ::: "memory");
}
template <bool NORM> __device__ __forceinline__ void p0_row_to_bf16(const float* src, bf16* dst, const float* cscale, int lane) {
    const GAS f32x4* xr = (const GAS f32x4*)src + lane;
    f32x4 v[4]; float s = 0.f;
#pragma unroll
    for (int j = 0; j < 4; ++j) { v[j] = xr[64 * j]; s += (v[j].x * v[j].x + v[j].y * v[j].y) + (v[j].z * v[j].z + v[j].w * v[j].w); }
    float rstd = 1.f;
    if (NORM) rstd = __builtin_amdgcn_rsqf(wave_sum(s) * (1.f / DM) + NORM_EPS);
    GAS unsigned long long* o8 = (GAS unsigned long long*)dst + lane;
#pragma unroll
    for (int j = 0; j < 4; ++j) { f32x4 w = v[j] * rstd; if (cscale) w = w * ((const GAS f32x4*)cscale)[lane + 64 * j];
        o8[64 * j] = (unsigned long long)pk2(w.x, w.y) | ((unsigned long long)pk2(w.z, w.w) << 32); }
}
__device__ __forceinline__ void sincos_rev(double ang, float& c, float& s) {
    double rev = ang * 0.15915494309189535; rev -= __builtin_rint(rev);
    const float r = (float)rev; c = __builtin_amdgcn_cosf(r); s = __builtin_amdgcn_sinf(r);
}
__device__ __forceinline__ float wave_max(float v) {
#pragma unroll
    for (int o = 1; o < 64; o <<= 1) v = __builtin_fmaxf(v, __shfl_xor(v, o));
    return v;
}
__device__ __forceinline__ float p0_row_to_fp8(const float* src, unsigned char* dst, const float* cscale, int lane) {
    const GAS f32x4* xr = (const GAS f32x4*)src + 4 * lane;
    f32x4 v[4]; float mx = 0.f;
#pragma unroll
    for (int j = 0; j < 4; ++j) { v[j] = xr[j]; if (cscale) v[j] = v[j] * ((const GAS f32x4*)cscale)[4 * lane + j];
        mx = __builtin_fmaxf(mx, __builtin_fmaxf(__builtin_fmaxf(__builtin_fabsf(v[j].x), __builtin_fabsf(v[j].y)), __builtin_fmaxf(__builtin_fabsf(v[j].z), __builtin_fabsf(v[j].w)))); }
    mx = wave_max(mx);
    const int ex = (int)((__float_as_uint(mx) >> 23) & 255u) - 126;
    const bool ok = mx > 1e-30f && mx < 1e30f;
    const float sc = ok ? __uint_as_float((unsigned)(127 + 8 - ex) << 23) : 1.f, isc = ok ? __uint_as_float((unsigned)(127 - 8 + ex) << 23) : 1.f;
    v4u o;
#pragma unroll
    for (int j = 0; j < 4; ++j) { const f32x4 w = v[j] * sc; int pk = __builtin_amdgcn_cvt_pk_fp8_f32(w.x, w.y, 0, false); pk = __builtin_amdgcn_cvt_pk_fp8_f32(w.z, w.w, pk, true); o[j] = (unsigned)pk; }
    *(GAS v4u*)(dst + 16 * lane) = o;
    return isc;
}
__device__ __forceinline__ float p0_row_to_fp4(const float* src, unsigned char* dst, const float* cscale, int lane) {
    const GAS f32x4* xr = (const GAS f32x4*)src + 4 * lane;
    f32x4 v[4]; float mx = 0.f;
#pragma unroll
    for (int j = 0; j < 4; ++j) { v[j] = xr[j]; if (cscale) v[j] = v[j] * ((const GAS f32x4*)cscale)[4 * lane + j];
        mx = __builtin_fmaxf(mx, __builtin_fmaxf(__builtin_fmaxf(__builtin_fabsf(v[j].x), __builtin_fabsf(v[j].y)), __builtin_fmaxf(__builtin_fabsf(v[j].z), __builtin_fabsf(v[j].w)))); }
    mx = wave_max(mx);
    const bool ok = mx > 1e-30f && mx < 1e30f;
    const float sc = ok ? 6.0f / mx : 1.f, isc = ok ? mx * (1.0f / 6.0f) : 1.f;
    unsigned d0 = 0u, d1 = 0u;
    { const f32x4 a = v[0] * sc, b = v[1] * sc, c = v[2] * sc, d = v[3] * sc;
      d0 = __builtin_amdgcn_cvt_scalef32_pk_fp4_f32(d0, a.x, a.y, 1.0f, 0); d0 = __builtin_amdgcn_cvt_scalef32_pk_fp4_f32(d0, a.z, a.w, 1.0f, 1);
      d0 = __builtin_amdgcn_cvt_scalef32_pk_fp4_f32(d0, b.x, b.y, 1.0f, 2); d0 = __builtin_amdgcn_cvt_scalef32_pk_fp4_f32(d0, b.z, b.w, 1.0f, 3);
      d1 = __builtin_amdgcn_cvt_scalef32_pk_fp4_f32(d1, c.x, c.y, 1.0f, 0); d1 = __builtin_amdgcn_cvt_scalef32_pk_fp4_f32(d1, c.z, c.w, 1.0f, 1);
      d1 = __builtin_amdgcn_cvt_scalef32_pk_fp4_f32(d1, d.x, d.y, 1.0f, 2); d1 = __builtin_amdgcn_cvt_scalef32_pk_fp4_f32(d1, d.z, d.w, 1.0f, 3); }
    *(GAS v2u*)(dst + 16 * lane) = (v2u){d0, d1};
    return isc;
}
__device__ __forceinline__ void p0_prologue(Frame& F, const Args& A) {
    unsigned char* ws = A.ws;
    LAS float* scr = (LAS float*)(F.lds + RING_OFF + F.wave * 16384);
    const int gw = F.vcu * NWAVES + F.wave, NGW = F.G * NWAVES;
    { float* tpos = (float*)(ws + WS_TPOS); float* trow = (float*)(ws + WS_TROW); float* tcol = (float*)(ws + WS_TCOL);
      const int gt = F.vcu * (NWAVES * 64) + F.tid, NTH = F.G * NWAVES * 64;
      for (int i = gt; i < M * 8; i += NTH) { const int pos = i >> 3, f = i & 7; float c, s; sincos_rev((double)pos * A.inv_p[f], c, s); tpos[pos * 16 + f] = c; tpos[pos * 16 + 8 + f] = s; }
      for (int i = gt; i < 256 * 16; i += NTH) { const int idx = i >> 4, f = i & 15; float c, s; sincos_rev((double)idx * A.inv_ax[f], c, s); trow[idx * 32 + f] = c; trow[idx * 32 + 16 + f] = s; }
      for (int i = gt; i < 64 * 16; i += NTH) { const int idx = i >> 4, f = i & 15; float c, s; sincos_rev((double)idx * A.inv_ax[f], c, s); tcol[idx * 32 + f] = c; tcol[idx * 32 + 16 + f] = s; }
      const float* sk = A.in[13]; unsigned* skb = (unsigned*)(ws + WS_SK);
      for (int i = gt; i < 8 * 2 * 128 * 128 / 2; i += NTH) skb[i] = pk2(sk[2 * i], sk[2 * i + 1]);
    }
    constexpr int I_IN = (DM / 64) * (NIN / 32);
    for (int it = gw; it < I_IN; it += NGW) p0_transpose_item<1>(A.in[2], DM, NIN, (bf16*)(ws + WS_WIN), nullptr, scr, it, F.lane);
    { f32x4 gsc[4];
#pragma unroll
      for (int j = 0; j < 4; ++j) gsc[j] = ((const GAS f32x4*)A.in[1])[F.lane + 64 * j];
      for (int m0 = gw; m0 < M; m0 += 4 * NGW) {
        f32x4 v[4][4]; float ss[4];
#pragma unroll
        for (int r = 0; r < 4; ++r) { const int m = (m0 + r * NGW < M) ? m0 + r * NGW : m0; const GAS f32x4* xr = (const GAS f32x4*)(A.in[0] + (size_t)m * DM) + F.lane;
#pragma unroll
            for (int j = 0; j < 4; ++j) v[r][j] = xr[64 * j]; }
#pragma unroll
        for (int r = 0; r < 4; ++r) { float s_ = 0.f;
#pragma unroll
            for (int j = 0; j < 4; ++j) s_ += (v[r][j].x * v[r][j].x + v[r][j].y * v[r][j].y) + (v[r][j].z * v[r][j].z + v[r][j].w * v[r][j].w);
            ss[r] = __builtin_amdgcn_rsqf(wave_sum(s_) * (1.f / DM) + NORM_EPS); }
#pragma unroll
        for (int r = 0; r < 4; ++r) { const int m = m0 + r * NGW; if (m < M) { GAS unsigned long long* o8 = (GAS unsigned long long*)((bf16*)(ws + WS_XN) + (size_t)m * DM) + F.lane;
#pragma unroll
            for (int j = 0; j < 4; ++j) { const f32x4 w = v[r][j] * ss[r] * gsc[j]; o8[64 * j] = (unsigned long long)pk2(w.x, w.y) | ((unsigned long long)pk2(w.z, w.w) << 32); } } }
      } }
}
__device__ __forceinline__ void p0_lazy(Frame& F, const Args& A, int gw, int NGW) {
    unsigned char* ws = A.ws;
    LAS float* scr = (LAS float*)(F.lds + RING_OFF + F.wave * 16384);
    constexpr int I_OUT = (DM / 64) * (DM / 32), I_Q = (DM / 64) * (NQ / 32);
    for (int it = gw; it < I_OUT + I_Q; it += NGW) {
        if (it < I_OUT) p0_transpose_item<0>(A.in[10], DM, DM, (bf16*)(ws + WS_WOUT), nullptr, scr, it, F.lane);
        else p0_transpose_item<2>(A.in[12], DM, NQ, (bf16*)(ws + WS_WQ), A.in[11], scr, it - I_OUT, F.lane);
    }
    for (int m = gw; m < NEXP; m += NGW) {
        const float iu = p0_row_to_fp4(A.in[14] + (size_t)m * DM, ws + WS_UV8 + (size_t)m * EROW, A.in[11], F.lane);
        const float iv = p0_row_to_fp4(A.in[15] + (size_t)m * DM, ws + WS_UV8 + (size_t)m * EROW + 8, nullptr, F.lane);
        if (F.lane == 0) { float* sc = (float*)(ws + WS_SCL) + 2 * m; sc[0] = iu; sc[1] = iv; }
    }
}

__device__ __forceinline__ void topk_insert(float (&L)[16], float c) {
#pragma unroll
    for (int j = 15; j >= 1; --j) L[j] = __builtin_amdgcn_fmed3f(L[j - 1], L[j], c);
    L[0] = __builtin_fmaxf(L[0], c);
}
__device__ __forceinline__ void cex(float& a, float& b) { const float hi = __builtin_amdgcn_fmed3f(a, b, INFINITY), lo = __builtin_amdgcn_fmed3f(a, b, -INFINITY); a = hi; b = lo; }
__device__ __forceinline__ void sort16_desc(float (&v)[16]) {
    constexpr unsigned char P[60][2] = {{0,13},{1,12},{2,15},{3,14},{4,8},{5,6},{7,11},{9,10},{0,5},{1,7},{2,9},{3,4},{6,13},{8,14},{10,15},{11,12},{0,1},{2,3},{4,5},{6,8},{7,9},{10,11},{12,13},{14,15},
        {0,2},{1,3},{4,10},{5,11},{6,7},{8,9},{12,14},{13,15},{1,2},{3,12},{4,6},{5,7},{8,10},{9,11},{13,14},{1,4},{2,6},{5,8},{7,10},{9,13},{11,14},{2,4},{3,6},{9,12},{11,13},{3,5},{6,8},{7,9},{10,12},
        {3,4},{5,6},{7,8},{9,10},{11,12},{6,7},{8,9}};
#pragma unroll
    for (int k = 0; k < 60; ++k) cex(v[P[k][0]], v[P[k][1]]);
}
__device__ __forceinline__ void merge_top16(float (&a)[16], const float (&b)[16]) {
#pragma unroll
    for (int i = 0; i < 16; ++i) a[i] = __builtin_amdgcn_fmed3f(a[i], b[15 - i], INFINITY);
#pragma unroll
    for (int st = 8; st >= 1; st >>= 1)
#pragma unroll
        for (int i = 0; i < 16; ++i) if ((i & st) == 0) cex(a[i], a[i + st]);
}
__device__ __forceinline__ void p5_topk(Frame& F, const Args& A) {
    unsigned char* ws = A.ws;
    const bf16* QP = (const bf16*)(ws + WS_QKV); const bf16* SK = (const bf16*)(ws + WS_SK); const float* SSQ = (const float*)(ws + WS_SSQ);
    v2u* META = (v2u*)(ws + WS_META); float* INVS = (float*)(ws + WS_INVS);
    const int lane = F.lane, r32 = lane & 31, hi = lane >> 5;
    const int cpg = F.G / 8, h = F.vcu / cpg, cg = F.vcu % cpg;
    { const v4u* src = (const v4u*)(SK + (size_t)h * 2 * 128 * 128);
      for (int i = F.tid; i < 2 * 128 * 16; i += NWAVES * 64) { const int p = i >> 11, key = (i >> 4) & 127, c = i & 15;
          *(LAS v4u*)(F.lds + RING_OFF + (((p * 8 + (c >> 1)) * 2 + (c & 1)) * 2048 + key * 16)) = src[i]; }
      LDS_WAIT(); __syncthreads(); }
    const LAS unsigned char* ska = F.lds + RING_OFF + hi * 2048 + r32 * 16;
    for (int g = cg * NWAVES + F.wave; g < M / 32; g += cpg * NWAVES) {
        const int t = g * 32 + r32;
        const bf16* qp = QP + (size_t)t * NQ + h * 256 + 8 * hi;
        float ss = 0.f;
#pragma unroll
        for (int i = 0; i < 16; ++i) ss += SSQ[(size_t)i * M + t];
        const float rstd = __builtin_amdgcn_rsqf(ss * (1.f / DM) + NORM_EPS);
        float m0[16], m1[16];
#pragma unroll
        for (int p = 0; p < 2; ++p) {
            f32x16 acc[4];
#pragma unroll
            for (int b = 0; b < 4; ++b) acc[b] = f32x16{};
            bf16x8 bq[8];
#pragma unroll
            for (int s = 0; s < 8; ++s) bq[s] = *(const bf16x8*)(qp + p * 128 + 16 * s);
#pragma unroll
            for (int s = 0; s < 8; ++s) {
#pragma unroll
                for (int b = 0; b < 4; ++b) { const bf16x8 ak = *(const LAS bf16x8*)(ska + (p * 8 + s) * 4096 + b * 512); acc[b] = __builtin_amdgcn_mfma_f32_32x32x16_bf16(ak, bq[s], acc[b], 0, 0, 0); }
                if (s & 1) __builtin_amdgcn_sched_barrier(0); }
            float L[16], G[16];
#pragma unroll
            for (int b = 0; b < 4; ++b) {
#pragma unroll
                for (int r = 0; r < 16; ++r) G[r] = __uint_as_float((__float_as_uint(acc[b][r]) & ~127u) | (unsigned)(b * 32 + (r & 3) + 8 * (r >> 2)));
                sort16_desc(G);
                if (b == 0) {
#pragma unroll
                    for (int r = 0; r < 16; ++r) L[r] = G[r];
                } else merge_top16(L, G);
            }
            { const unsigned hi4 = 4u * hi;
#pragma unroll
              for (int j = 0; j < 16; ++j) L[j] = __uint_as_float(__float_as_uint(L[j]) | hi4); }
            float O[16];
#pragma unroll
            for (int j = 0; j < 16; ++j) O[j] = __shfl_xor(L[j], 32);
            merge_top16(L, O);
#pragma unroll
            for (int j = 0; j < 16; ++j) { if (p == 0) m0[j] = L[j]; else m1[j] = L[j]; }
        }
        float T[16];
#pragma unroll
        for (int j = 0; j < 16; ++j) T[j] = -INFINITY;
#pragma unroll
        for (int a = 0; a < 16; ++a)
#pragma unroll
            for (int b = 0; b < 16; ++b) if ((a + 1) * (b + 1) <= 16) { const float v = m0[a] + m1[b]; const unsigned key = (__float_as_uint(v) & ~255u) | (unsigned)(a * 16 + b); topk_insert(T, __uint_as_float(key)); }
        const float thr = T[15], ref = T[0];
        int cnt = 0; float sum = 0.f; const float kk = rstd * 1.4426950408889634f;
        LAS v2u* mst = (LAS v2u*)(F.lds + RING_OFF + 65536 + F.wave * 4096);
        LAS v2u* meta = mst + r32 * 16;
#pragma unroll
        for (int a = 0; a < 16; ++a)
#pragma unroll
            for (int b = 0; b < 16; ++b) if ((a + 1) * (b + 1) <= 16) { const float v = m0[a] + m1[b]; const unsigned key = (__float_as_uint(v) & ~255u) | (unsigned)(a * 16 + b);
                if (__uint_as_float(key) >= thr) { const unsigned idx = ((__float_as_uint(m0[a]) & 127u) << 7) | (__float_as_uint(m1[b]) & 127u);
                    const float e = __builtin_amdgcn_exp2f((v - ref) * kk); if (hi == 0 && cnt < 16) meta[cnt] = (v2u){idx, __float_as_uint(e)}; sum += e; ++cnt; } }
        if (hi == 0) INVS[(size_t)t * 8 + h] = 1.0f / sum;
        LDS_WAIT(); asm volatile("" ::: "memory");
#pragma unroll
        for (int i = 0; i < 4; ++i) { const int ch = i * 64 + lane, tok = ch >> 3, c8 = ch & 7;
            const v4u val = *(const LAS v4u*)((const LAS unsigned char*)mst + tok * 128 + c8 * 16);
            *(v4u*)((unsigned char*)(META + ((size_t)(g * 32 + tok) * 8 + h) * 16) + c8 * 16) = val; }
        LDS_WAIT(); asm volatile("" ::: "memory");
    }
    __syncthreads();
}

typedef float f32x2v __attribute__((ext_vector_type(2)));
__device__ __forceinline__ float dot16_fp8(const v4u r, const f32x2v (&xp)[8]) {
    f32x2v a = {0.f, 0.f};
    const unsigned w[4] = {r.x, r.y, r.z, r.w};
#pragma unroll
    for (int c = 0; c < 4; ++c) { a = __builtin_amdgcn_cvt_pk_f32_fp8((int)w[c], false) * xp[2 * c] + a; a = __builtin_amdgcn_cvt_pk_f32_fp8((int)w[c], true) * xp[2 * c + 1] + a; }
    return a.x + a.y;
}
__device__ __forceinline__ void axpy16_fp8(f32x2v (&acc)[8], const v4u r, float wj) {
    const f32x2v ww = {wj, wj};
    const unsigned w[4] = {r.x, r.y, r.z, r.w};
#pragma unroll
    for (int c = 0; c < 4; ++c) { acc[2 * c] = __builtin_amdgcn_cvt_pk_f32_fp8((int)w[c], false) * ww + acc[2 * c]; acc[2 * c + 1] = __builtin_amdgcn_cvt_pk_f32_fp8((int)w[c], true) * ww + acc[2 * c + 1]; }
}
__device__ __forceinline__ void axpy16_fp4(f32x2v (&acc)[8], const v2u r, float wj) {
    const f32x2v ww = {wj, wj};
    const unsigned d0 = r.x, d1 = r.y;
    acc[0] = __builtin_amdgcn_cvt_scalef32_pk_f32_fp4(d0, 1.0f, 0) * ww + acc[0]; acc[1] = __builtin_amdgcn_cvt_scalef32_pk_f32_fp4(d0, 1.0f, 1) * ww + acc[1];
    acc[2] = __builtin_amdgcn_cvt_scalef32_pk_f32_fp4(d0, 1.0f, 2) * ww + acc[2]; acc[3] = __builtin_amdgcn_cvt_scalef32_pk_f32_fp4(d0, 1.0f, 3) * ww + acc[3];
    acc[4] = __builtin_amdgcn_cvt_scalef32_pk_f32_fp4(d1, 1.0f, 0) * ww + acc[4]; acc[5] = __builtin_amdgcn_cvt_scalef32_pk_f32_fp4(d1, 1.0f, 1) * ww + acc[5];
    acc[6] = __builtin_amdgcn_cvt_scalef32_pk_f32_fp4(d1, 1.0f, 2) * ww + acc[6]; acc[7] = __builtin_amdgcn_cvt_scalef32_pk_f32_fp4(d1, 1.0f, 3) * ww + acc[7];
}
__device__ __forceinline__ float dot16_fp4(unsigned d0, unsigned d1, const f32x2v (&xp)[8]) {
    f32x2v a = __builtin_amdgcn_cvt_scalef32_pk_f32_fp4(d0, 1.0f, 0) * xp[0];
    a = __builtin_amdgcn_cvt_scalef32_pk_f32_fp4(d0, 1.0f, 1) * xp[1] + a; a = __builtin_amdgcn_cvt_scalef32_pk_f32_fp4(d0, 1.0f, 2) * xp[2] + a; a = __builtin_amdgcn_cvt_scalef32_pk_f32_fp4(d0, 1.0f, 3) * xp[3] + a;
    a = __builtin_amdgcn_cvt_scalef32_pk_f32_fp4(d1, 1.0f, 0) * xp[4] + a; a = __builtin_amdgcn_cvt_scalef32_pk_f32_fp4(d1, 1.0f, 1) * xp[5] + a;
    a = __builtin_amdgcn_cvt_scalef32_pk_f32_fp4(d1, 1.0f, 2) * xp[6] + a; a = __builtin_amdgcn_cvt_scalef32_pk_f32_fp4(d1, 1.0f, 3) * xp[7] + a;
    return a.x + a.y;
}
__device__ __forceinline__ void p6_experts(Frame& F, const Args& A) {
    unsigned char* ws = A.ws;
    const bf16* H1B = (const bf16*)(ws + WS_XN); const unsigned char* UV = ws + WS_UV8; const f32x2v* SCL = (const f32x2v*)(ws + WS_SCL);
    const float* SSQ = (const float*)(ws + WS_SSQ); const v2u* META = (const v2u*)(ws + WS_META); const float* INVS = (const float*)(ws + WS_INVS);
    const float* gfin = A.in[16]; float* out = A.out;
    const int lane = F.lane;
    const int gw = F.vcu * NWAVES + F.wave, NGW = F.G * NWAVES;
    for (int t = gw; t < M; t += NGW) {
        const float ssl = lane < 16 ? SSQ[(size_t)lane * M + t] : 0.f;
        const float rstd = __builtin_amdgcn_rsqf(wave_sum(ssl) * (1.f / DM) + NORM_EPS);
        f32x2v xp[8];
        { const v4u* xr = (const v4u*)(H1B + (size_t)t * DM) + 2 * lane; const v4u x0 = xr[0], x1 = xr[1];
          const unsigned xw[8] = {x0.x, x0.y, x0.z, x0.w, x1.x, x1.y, x1.z, x1.w};
#pragma unroll
          for (int i = 0; i < 8; ++i) xp[i] = (f32x2v){__uint_as_float(xw[i] << 16), __uint_as_float(xw[i] & 0xffff0000u)}; }
        f32x2v acc[8];
#pragma unroll
        for (int i = 0; i < 8; ++i) acc[i] = (f32x2v){0.f, 0.f};
#pragma unroll 1
        for (int b = 0; b < 4; ++b) {
            const v2u me = META[(size_t)t * 128 + b * 32 + (lane & 31)]; const unsigned idx = me.x; const float e = __uint_as_float(me.y);
            const float invs = INVS[(size_t)t * 8 + b * 2 + ((lane >> 4) & 1)];
            const f32x2v isc = SCL[idx];
            v4u r[32]; float p[32];
#pragma unroll
            for (int j = 0; j < 32; ++j) { const unsigned ei = __builtin_amdgcn_readlane(idx, j); r[j] = ((const v4u*)(UV + (size_t)ei * EROW))[lane]; }
#pragma unroll
            for (int j = 0; j < 32; ++j) p[j] = dot16_fp4(r[j].x, r[j].y, xp);
#pragma unroll
            for (int n = 16; n >= 1; n >>= 1) {
                const bool up = (lane & n) != 0;
#pragma unroll
                for (int i = 0; i < n; ++i) { const float send = up ? p[i] : p[i + n], keep = up ? p[i + n] : p[i]; p[i] = keep + __shfl_xor(send, n); }
            }
            const float d = p[0] + __shfl_xor(p[0], 32);
            const float z = d * rstd * isc.x;
            const float a = 0.5f * z * (1.0f + erff(z * 0.70710678118654752f));
            const float w = e * invs * a * isc.y;
#pragma unroll
            for (int j = 0; j < 32; ++j) axpy16_fp4(acc, (v2u){r[j].z, r[j].w}, __uint_as_float(__builtin_amdgcn_readlane(__float_as_uint(w), j)));
        }
        float* hrow = out + (size_t)t * DM + 16 * lane;
        f32x4 h[4]; float s2 = 0.f;
#pragma unroll
        for (int i = 0; i < 4; ++i) { h[i] = (f32x4){xp[2 * i].x, xp[2 * i].y, xp[2 * i + 1].x, xp[2 * i + 1].y} + (f32x4){acc[2 * i].x, acc[2 * i].y, acc[2 * i + 1].x, acc[2 * i + 1].y};
            s2 += (h[i].x * h[i].x + h[i].y * h[i].y) + (h[i].z * h[i].z + h[i].w * h[i].w); }
        const float rf = __builtin_amdgcn_rsqf(wave_sum(s2) * (1.f / DM) + NORM_EPS);
#pragma unroll
        for (int i = 0; i < 4; ++i) *(f32x4*)(hrow + 4 * i) = h[i] * rf * *(const f32x4*)(gfin + 16 * lane + 4 * i);
    }
}

__global__ void __launch_bounds__(NWAVES * 64, 2) fwd_kernel(Args args) {
    extern __shared__ __attribute__((aligned(16))) unsigned char lds[];
    Frame F;
    F.lds = (LAS unsigned char*)lds;
    F.MISC = (volatile LAS unsigned*)(F.lds + MISC_OFF);
    F.tid = threadIdx.x; F.lane = F.tid & 63; F.wave = __builtin_amdgcn_readfirstlane(F.tid >> 6);
    F.G = gridDim.x; { const int bx = blockIdx.x; F.vcu = (F.G % 8 == 0) ? (bx % 8) * (F.G / 8) + bx / 8 : bx; }
    unsigned char* ws = args.ws;
    F.ctl = (gu32*)(ws + WS_CTL);
    for (int u = F.tid; u < (LDS_BYTES - LDSCTL_OFF) / 4; u += NWAVES * 64) ((LAS unsigned*)(F.lds + LDSCTL_OFF))[u] = 0u;
    __syncthreads();
    XcdBarrier bar; bar.bar = (unsigned*)(F.ctl + CW_BAR); bar.x = 0; bar.st = nullptr;
    if (N_LAUNCHES != PER_PHASE) bar = xcd_barrier_post((unsigned*)(F.ctl + CW_BAR), F.MISC + 8);
#define GRID_BAR() do { if (N_LAUNCHES != PER_PHASE) xcd_barrier(bar); } while (0)
    const int lo = args.ph_lo, hi = args.ph_hi;
#ifndef PH_MASK
#define PH_MASK 0x7f
#endif
#define IN(k) (((PH_MASK >> (k)) & 1) && lo <= (k) && (k) < hi)
#define BOTH(k) (IN(k) && IN((k) + 1))

    if (IN(0)) { p0_prologue(F, args); if (BOTH(0)) GRID_BAR(); }

    if (IN(1)) {
        pg8::Gemm g{(const pg8::bf16_t*)(ws + WS_XN), (const pg8::bf16_t*)(ws + WS_WIN), M, NIN, DM}; pg8::StaticOrder S; S.init(M, NIN, F.G, (int)blockIdx.x);
        pg8::EpiInProj E{(pg8::bf16_t*)(ws + WS_QKV), args.in[3], args.in[4], (const float*)(ws + WS_TROW), (const float*)(ws + WS_TCOL), (const float*)(ws + WS_TPOS), C2, (unsigned*)(ws + WS_CTL) + 65536};
        pg8::gemm_phase<pg8::EpiInProj, pg8::StaticOrder, true, true>(F.lds + RING_OFF, g, S, E);
        { const int nfull = (M / 256) * (NIN / 256) % F.G;
          if (nfull == 0) p0_lazy(F, args, F.vcu * NWAVES + F.wave, F.G * NWAVES);
          else if ((int)blockIdx.x >= nfull) p0_lazy(F, args, ((int)blockIdx.x - nfull) * NWAVES + F.wave, (F.G - nfull) * NWAVES); }
        if (BOTH(1)) GRID_BAR();
    }

    if (IN(2)) {
        using abf = attn_body::bf16;
        const abf* planes = (const abf*)(ws + WS_QKV); abf* AO = (abf*)(ws + WS_AO);
        constexpr size_t PL = (size_t)M * 64;
        const __amdgpu_buffer_rsrc_t srd = __builtin_amdgcn_make_buffer_rsrc((void*)(ws + WS_QKV), (short)0, (int)(36 * PL * 2), 0x00020000);
#ifndef NO_A
        const float mub = C2 * 64.0f * 1.02f * wave_max(__builtin_fabsf(args.in[3][F.lane])) * wave_max(__builtin_fabsf(args.in[4][F.lane]));
        const bool sbound = mub < 60.0f;
        for (int ua = F.vcu * 2; ua < 512; ua += F.G * 2)
            for (int k = 0; k < 2; ++k) { const int hA = (ua + k) >> 6, qb = (ua + k) & 63;
                attn_body::attn_unit_a<8>(qb, planes + (size_t)hA * PL, srd, (unsigned)((8 + (hA >> 2)) * PL * 2), (unsigned)((10 + (hA >> 2)) * PL * 2), AO + hA * 64, (char*)lds + RING_OFF, sbound ? mub : 0.f, sbound); }
#endif
        const float d1 = wave_sum(args.in[5][F.lane] * args.in[6][F.lane]), d2 = wave_sum(args.in[7][F.lane] * args.in[8][F.lane]);
        const float lam = __expf(d1) - __expf(d2) + 0.2f;
        float* sc = (float*)(ws + WS_XN) + (size_t)F.vcu * (NWAVES * 4096);
#ifndef NO_B
        for (int ub = F.vcu; ub < 256; ub += F.G) { const int hB = ub >> 6, qb = ub & 63;
            for (int comp = 0; comp < 2; ++comp) {
                const unsigned* nmax = (const unsigned*)(ws + WS_CTL) + 65536;
                const float mb = 1.02f * __builtin_sqrtf(__uint_as_float(nmax[12 + 2 * hB + comp]) * __uint_as_float(nmax[20 + 2 * hB + comp]));
                const bool sb = mb < 60.0f;
                attn_body::attn_unit_b<8>(qb, comp, planes + (size_t)(12 + 2 * hB + comp) * PL, srd, (unsigned)((20 + 2 * hB + comp) * PL * 2), (unsigned)((28 + 2 * hB) * PL * 2),
                                          sc, lam, args.in[9], AO + 512 + hB * 128, (char*)lds + RING_OFF, sb ? mb : 0.f, sb); } }
#endif
        if (BOTH(2)) GRID_BAR();
    }

    if (IN(3)) {
        pg8::Gemm g{(const pg8::bf16_t*)(ws + WS_AO), (const pg8::bf16_t*)(ws + WS_WOUT), M, DM, DM}; pg8::StaticOrder S; S.init(M, DM, F.G, (int)blockIdx.x);
        pg8::EpiOutProj E{args.in[0], args.out, (pg8::bf16_t*)(ws + WS_XN), (float*)(ws + WS_SSQ)};
        pg8::gemm_phase<pg8::EpiOutProj, pg8::StaticOrder, true, true>(F.lds + RING_OFF, g, S, E);
        if (BOTH(3)) GRID_BAR();
    }

    if (IN(4)) {
        pg8::Gemm g{(const pg8::bf16_t*)(ws + WS_XN), (const pg8::bf16_t*)(ws + WS_WQ), M, NQ, DM}; pg8::StaticOrder S; S.init(M, NQ, F.G, (int)blockIdx.x);
        pg8::EpiBf16 E{(pg8::bf16_t*)(ws + WS_QKV), NQ};
        pg8::gemm_phase<pg8::EpiBf16, pg8::StaticOrder, true, true>(F.lds + RING_OFF, g, S, E);
        if (BOTH(4)) GRID_BAR();
    }

    if (IN(5)) { p5_topk(F, args); if (BOTH(5)) GRID_BAR(); }

    if (IN(6)) { p6_experts(F, args); }
#undef IN
#undef BOTH
#undef GRID_BAR
}

extern "C" void kernel_launch(void* const* d_in, const int* in_sizes, int n_in, void* d_out, int out_size, void* d_ws, size_t ws_size, hipStream_t stream) {
    static int grid = 0;
    if (grid == 0) {
        if (n_in != 17 || in_sizes[0] != M * DM || out_size != M * DM || ws_size < WS_END) { fprintf(stderr, "kernel_launch: unexpected shapes (n_in %d, in0 %d, out %d, ws %zu); nothing launched\n", n_in, n_in > 0 ? in_sizes[0] : -1, out_size, ws_size); grid = -1; return; }
        int dev = 0, cus = 0, per_cu = 0;
        if (hipGetDevice(&dev) != hipSuccess || hipDeviceGetAttribute(&cus, hipDeviceAttributeMultiprocessorCount, dev) != hipSuccess) { fprintf(stderr, "kernel_launch: device query failed\n"); grid = -1; return; }
        if (hipFuncSetAttribute((const void*)fwd_kernel, hipFuncAttributeMaxDynamicSharedMemorySize, LDS_BYTES) != hipSuccess) { fprintf(stderr, "kernel_launch: hipFuncSetAttribute failed\n"); grid = -1; return; }
        if (hipOccupancyMaxActiveBlocksPerMultiprocessor(&per_cu, (const void*)fwd_kernel, NWAVES * 64, LDS_BYTES) != hipSuccess || per_cu < 1)
            fprintf(stderr, "kernel_launch: note: occupancy query reports %d workgroups per CU\n", per_cu);
        (void)hipGetLastError();
        grid = cus;
        if (grid != 256) { fprintf(stderr, "kernel_launch: built for a 256-CU device, found %d CUs; nothing launched\n", cus); grid = -1; return; }
    }
    if (grid < 0) return;
    if (hipMemsetAsync((char*)d_ws + WS_CTL, 0, CTL_ZERO_BYTES, stream) != hipSuccess) { fprintf(stderr, "kernel_launch: hipMemsetAsync failed\n"); return; }
    Args a{};
    for (int i = 0; i < 17; ++i) a.in[i] = (const float*)d_in[i];
    a.out = (float*)d_out; a.ws = (unsigned char*)d_ws;
    for (int i = 0; i < 16; ++i) a.inv_ax[i] = pow(10000.0, -(2.0 * i) / 32.0);
    for (int i = 0; i < 8; ++i) a.inv_p[i] = pow(500000.0, -(2.0 * i) / 16.0);
#ifdef PHASE_LIST
    static const int plist[] = {PHASE_LIST}; constexpr int NL = sizeof(plist) / sizeof(int);
#else
    constexpr int NL = N_LAUNCHES;
#endif
    for (int li = 0; li < NL; ++li) {
#ifdef PHASE_LIST
        a.ph_lo = plist[li]; a.ph_hi = plist[li] + 1; a.li = li;
#else
        a.ph_lo = (N_LAUNCHES == PER_PHASE) ? li : 0; a.ph_hi = (N_LAUNCHES == PER_PHASE) ? li + 1 : PER_PHASE; a.li = li;
#endif
        hipLaunchKernelGGL(fwd_kernel, dim3(grid), dim3(NWAVES * 64), LDS_BYTES, stream, a);
        const hipError_t le = hipPeekAtLastError();
        if (le != hipSuccess) { fprintf(stderr, "kernel_launch: launch %d failed: %s\n", li, hipGetErrorName(le)); break; }
    }
}
```

```cpp
#include <hip/hip_runtime.h>
#include <hip/hip_bf16.h>
#include <cstdio>
#include <cstdint>
#include <cmath>
namespace pg8 {
#define PG8_LAS __attribute__((address_space(3)))
typedef unsigned short bf16_t;
typedef short bf16x8 __attribute__((ext_vector_type(8)));
typedef float f32x4 __attribute__((ext_vector_type(4)));
typedef unsigned u32x4 __attribute__((ext_vector_type(4)));
constexpr int BM = 256, BK = 64, HALF = 128, HTB = HALF * BK * 2  , STAGE_BYTES = 8 * HTB, NXCD = 8, WGM = 8;

__host__ __device__ __forceinline__ int lds_byte(int r, int c) { const int st = (r >> 4) * 2 + (c >> 5), rr = r & 15, cc = c & 31, ob = rr * 64 + cc * 2; return st * 1024 + (ob ^ (((ob >> 9) & 1) << 5)); }
__host__ __device__ __forceinline__ void stage_rc(int b, int& R, int& C) { const int st = b / 1024, sb = b % 1024, swz = sb ^ (((sb >> 9) & 1) << 5); R = (st >> 1) * 16 + swz / 64; C = (st & 1) * 32 + (swz % 64) / 2; }
__host__ __device__ __forceinline__ int perm32(int rho) { const int n = rho >> 4, i = rho & 15; return 8 * (i >> 2) + 4 * n + (i & 3); }

struct Unit { int pm, pn; };
struct Gemm { const bf16_t* A; const bf16_t* Bt; int M, N, K; };

struct StaticOrder {
    int nM, nN, nwg, G, c;
    __host__ __device__ void init(int M, int N, int G_, int c_) { nM = M / BM; nN = N / BM; nwg = nM * nN; G = G_; c = c_; }
    __host__ __device__ bool next(int i, Unit& u) const {
        const long L = (long)i * G + c; if (L >= nwg) return false;
        int wgid = (int)L; { const int q = nwg / NXCD, r = nwg % NXCD, xcd = wgid % NXCD, off = wgid / NXCD; wgid = (xcd < r ? xcd * (q + 1) : r * (q + 1) + (xcd - r) * q) + off; }
        const int nig = WGM * nN, gid = wgid / nig, fm = gid * WGM, gsz = (nM - fm) < WGM ? (nM - fm) : WGM;
        u.pm = fm + ((wgid % nig) % gsz); u.pn = (wgid % nig) / gsz; return true;
    }
    __device__ __forceinline__ void a_ready(const Unit&) const {}
    __device__ __forceinline__ void done(const Unit&) const {}
};

__device__ __forceinline__ unsigned cvt_pk_bf16(float lo, float hi) { unsigned r; asm volatile("v_cvt_pk_bf16_f32 %0, %1, %2" : "=v"(r) : "v"(lo), "v"(hi)); return r; }
typedef float f32x2 __attribute__((ext_vector_type(2)));
typedef unsigned u32x2 __attribute__((ext_vector_type(2)));

struct EpiBf16 {
    static constexpr bool PERM = true, AFTER_DRAIN = false;
    bf16_t* O; int ldc;
    __device__ __forceinline__ void operator()(const f32x4 (&acc)[2][2][4][2], const Unit& u, int wr, int wc, int fr, int fq) const {
        const int row0 = u.pm * BM + wr * 64 + fr; const int col0 = u.pn * BM + wc * 32 + 8 * fq;
#pragma unroll
        for (int ai = 0; ai < 2; ++ai)
#pragma unroll
            for (int m = 0; m < 4; ++m) { bf16_t* rowp = O + (size_t)(row0 + ai * HALF + m * 16) * ldc + col0;
#pragma unroll
                for (int bj = 0; bj < 2; ++bj) { const f32x4 v0 = acc[ai][bj][m][0], v1 = acc[ai][bj][m][1];
                    u32x4 w; w.x = cvt_pk_bf16(v0[0], v0[1]); w.y = cvt_pk_bf16(v0[2], v0[3]); w.z = cvt_pk_bf16(v1[0], v1[1]); w.w = cvt_pk_bf16(v1[2], v1[3]);
                    *(u32x4*)(rowp + bj * HALF) = w; } }
    }
};

struct EpiInProj {
    static constexpr bool PERM = true, AFTER_DRAIN = false;
    bf16_t* planes; const float* qg; const float* kg; const float* trow; const float* tcol; const float* tpos; float c2; unsigned* nmax;
    __device__ __forceinline__ void operator()(const f32x4 (&acc)[2][2][4][2], const Unit& u, int wr, int wc, int fr, int fq) const {
        const int slot = u.pn * 4 + wc;
        bf16_t* plane = planes + (size_t)slot * (16384 * 64);
        const int rowb = u.pm * BM + wr * 64 + fr;
        if (slot < 10) {
            const float* g = slot < 8 ? qg : kg; const float sc = slot < 8 ? c2 : 1.f;
            f32x4 gv[2][2];
#pragma unroll
            for (int bj = 0; bj < 2; ++bj)
#pragma unroll
                for (int n = 0; n < 2; ++n) gv[bj][n] = *(const f32x4*)(g + 32 * bj + 16 * n + 4 * fq);
#pragma unroll
            for (int ai = 0; ai < 2; ++ai)
#pragma unroll
                for (int m = 0; m < 4; ++m) { const int row = rowb + ai * HALF + m * 16;
                    float ss = 0.f;
#pragma unroll
                    for (int bj = 0; bj < 2; ++bj)
#pragma unroll
                        for (int n = 0; n < 2; ++n) { const f32x4 x = acc[ai][bj][m][n]; ss += (x[0] * x[0] + x[1] * x[1]) + (x[2] * x[2] + x[3] * x[3]); }
                    ss += __shfl_xor(ss, 16); ss += __shfl_xor(ss, 32);
                    const float rn = __builtin_amdgcn_rsqf(ss * (1.0f / 64.0f) + 1e-6f);
                    const float* tr = trow + (row >> 6) * 32 + 4 * fq; const float* tc = tcol + (row & 63) * 32 + 4 * fq;
#pragma unroll
                    for (int bj = 0; bj < 2; ++bj) { const float* tb = bj ? tc : tr; const f32x4 c = *(const f32x4*)tb, s = *(const f32x4*)(tb + 16);
                        const f32x4 y0 = acc[ai][bj][m][0] * rn * gv[bj][0], y1 = acc[ai][bj][m][1] * rn * gv[bj][1];
                        const f32x4 o0 = (y0 * c - y1 * s) * sc, o1 = (y1 * c + y0 * s) * sc;
                        u32x4 w; w.x = cvt_pk_bf16(o0[0], o0[1]); w.y = cvt_pk_bf16(o0[2], o0[3]); w.z = cvt_pk_bf16(o1[0], o1[1]); w.w = cvt_pk_bf16(o1[2], o1[3]);
                        *(u32x4*)(plane + (size_t)row * 64 + 32 * bj + 8 * fq) = w; } }
        } else if (slot >= 12 && slot < 28) {
            const float sc = slot < 20 ? c2 : 1.f; const bool rot = fq < 2; float nm = 0.f;
#pragma unroll
            for (int ai = 0; ai < 2; ++ai)
#pragma unroll
                for (int m = 0; m < 4; ++m) { const int row = rowb + ai * HALF + m * 16;
                    const float* tp = tpos + (size_t)row * 16 + 4 * (fq & 1);
                    f32x4 c = *(const f32x4*)tp, s = *(const f32x4*)(tp + 8);
                    if (!rot) { c = (f32x4){1.f, 1.f, 1.f, 1.f}; s = (f32x4){0.f, 0.f, 0.f, 0.f}; }
                    const f32x4 y0 = acc[ai][0][m][0], y1 = acc[ai][0][m][1];
                    const f32x4 o0 = (y0 * c - y1 * s) * sc, o1 = (y1 * c + y0 * s) * sc;
                    u32x4 w; w.x = cvt_pk_bf16(o0[0], o0[1]); w.y = cvt_pk_bf16(o0[2], o0[3]); w.z = cvt_pk_bf16(o1[0], o1[1]); w.w = cvt_pk_bf16(o1[2], o1[3]);
                    *(u32x4*)(plane + (size_t)row * 64 + 8 * fq) = w;
                    const f32x4 z0 = acc[ai][1][m][0] * sc, z1 = acc[ai][1][m][1] * sc;
                    u32x4 w2; w2.x = cvt_pk_bf16(z0[0], z0[1]); w2.y = cvt_pk_bf16(z0[2], z0[3]); w2.z = cvt_pk_bf16(z1[0], z1[1]); w2.w = cvt_pk_bf16(z1[2], z1[3]);
                    *(u32x4*)(plane + (size_t)row * 64 + 32 + 8 * fq) = w2;
                    float ss = (o0[0] * o0[0] + o0[1] * o0[1]) + (o0[2] * o0[2] + o0[3] * o0[3]) + (o1[0] * o1[0] + o1[1] * o1[1]) + (o1[2] * o1[2] + o1[3] * o1[3])
                             + (z0[0] * z0[0] + z0[1] * z0[1]) + (z0[2] * z0[2] + z0[3] * z0[3]) + (z1[0] * z1[0] + z1[1] * z1[1]) + (z1[2] * z1[2] + z1[3] * z1[3]);
                    ss += __shfl_xor(ss, 16); ss += __shfl_xor(ss, 32); nm = __builtin_fmaxf(nm, ss); }
#pragma unroll
            for (int o = 1; o < 16; o <<= 1) nm = __builtin_fmaxf(nm, __shfl_xor(nm, o));
            if ((fr | fq) == 0) atomicMax(nmax + slot, __float_as_uint(nm));
        } else {
#pragma unroll
            for (int ai = 0; ai < 2; ++ai)
#pragma unroll
                for (int m = 0; m < 4; ++m) { const int row = rowb + ai * HALF + m * 16;
#pragma unroll
                    for (int bj = 0; bj < 2; ++bj) { const f32x4 v0 = acc[ai][bj][m][0], v1 = acc[ai][bj][m][1];
                        u32x4 w; w.x = cvt_pk_bf16(v0[0], v0[1]); w.y = cvt_pk_bf16(v0[2], v0[3]); w.z = cvt_pk_bf16(v1[0], v1[1]); w.w = cvt_pk_bf16(v1[2], v1[3]);
                        *(u32x4*)(plane + (size_t)row * 64 + 32 * bj + 8 * fq) = w; } }
        }
    }
};

struct EpiOutProj {
    static constexpr bool PERM = false, AFTER_DRAIN = false;
    const float* x; float* h1; bf16_t* h1b; float* ssq;
    __device__ __forceinline__ void operator()(const f32x4 (&acc)[2][2][4][2], const Unit& u, int wr, int wc, int fr, int fq) const {
        const int col0 = u.pn * BM + wc * 32 + 4 * fq;
#pragma unroll
        for (int ai = 0; ai < 2; ++ai)
#pragma unroll
            for (int m = 0; m < 4; ++m) { const int row = u.pm * BM + ai * HALF + wr * 64 + m * 16 + fr; const size_t off = (size_t)row * 1024 + col0; float ss = 0.f;
#pragma unroll
                for (int bj = 0; bj < 2; ++bj)
#pragma unroll
                    for (int n = 0; n < 2; ++n) { const size_t o = off + bj * HALF + n * 16; const f32x4 h = *(const f32x4*)(x + o) + acc[ai][bj][m][n];
                        u32x2 w; w.x = cvt_pk_bf16(h[0], h[1]); w.y = cvt_pk_bf16(h[2], h[3]); *(u32x2*)(h1b + o) = w;
                        ss += (h[0] * h[0] + h[1] * h[1]) + (h[2] * h[2] + h[3] * h[3]); }
                ss += __shfl_xor(ss, 16); ss += __shfl_xor(ss, 32);
                if (fq == 0) ssq[(size_t)(u.pn * 4 + wc) * 16384 + row] = ss; }
    }
};

template <class Epi, class Sched, bool ALIGN_EPI = false, bool SP2 = false>
__device__ __forceinline__ void gemm_phase(PG8_LAS unsigned char* lds, const Gemm g, const Sched& S, const Epi& E) {
    const int tid = threadIdx.x, wid = __builtin_amdgcn_readfirstlane(tid >> 6), lane = tid & 63, wr = wid >> 2, wc = wid & 3, fr = lane & 15, fq = lane >> 4;
    const int K = g.K, nt = K / BK;
    unsigned voffA[2], voffB[2];
#pragma unroll
    for (int i = 0; i < 2; ++i) { int R, C; stage_rc(tid * 16 + i * 8192, R, C); const int Rb = Epi::PERM ? ((R & ~31) + perm32(R & 31)) : R;
        voffA[i] = (unsigned)(R * K + C) * 2u; voffB[i] = (unsigned)(Rb * K + C) * 2u; }
    const size_t kstep = (size_t)(BK * 2);
    const size_t hstep = (size_t)HALF * K * 2;
    const size_t tstep = 2 * hstep;
    const unsigned ldsw = (unsigned)wid * 1024u;
    const int aoff = lds_byte(wr * 64 + fr, fq * 8), boff = lds_byte(wc * 32 + fr, fq * 8);
#define PG8_SA(b, h) (((b) * 2 + (h)) * HTB)
#define PG8_SB(b, h) ((4 + (b) * 2 + (h)) * HTB)
#define PG8_STAGE(bufoff, gbase, voff) do { _Pragma("unroll") for (int _i = 0; _i < 2; ++_i) \
        __builtin_amdgcn_global_load_lds((const unsigned*)((const char*)(gbase) + (voff)[_i]), (PG8_LAS unsigned*)(lds + (bufoff) + ldsw + _i * 8192), 16, 0, 0); } while (0)
#define PG8_LDA(dst, b, h) do { _Pragma("unroll") for (int m = 0; m < 4; ++m) _Pragma("unroll") for (int k = 0; k < 2; ++k) dst[m][k] = *(const PG8_LAS bf16x8*)(lds + PG8_SA(b, h) + aoff + m * 2048 + k * 1024); } while (0)
#define PG8_LDB(dst, b, h) do { _Pragma("unroll") for (int n = 0; n < 2; ++n) _Pragma("unroll") for (int k = 0; k < 2; ++k) dst[n][k] = *(const PG8_LAS bf16x8*)(lds + PG8_SB(b, h) + boff + n * 2048 + k * 1024); } while (0)
#define PG8_MMA(ai, bj, At, Bt) do { __builtin_amdgcn_s_setprio(1); _Pragma("unroll") for (int m = 0; m < 4; ++m) _Pragma("unroll") for (int n = 0; n < 2; ++n) _Pragma("unroll") for (int k = 0; k < 2; ++k) \
        acc[ai][bj][m][n] = __builtin_amdgcn_mfma_f32_16x16x32_bf16(Bt[n][k], At[m][k], acc[ai][bj][m][n], 0, 0, 0); __builtin_amdgcn_s_setprio(0); } while (0)
#define PG8_WAIT_V(n) asm volatile("s_waitcnt vmcnt(" #n ")" ::: "memory")
#define PG8_WAIT_L(n) asm volatile("s_waitcnt lgkmcnt(" #n ")" ::: "memory")
#define PG8_BAR __builtin_amdgcn_s_barrier()
#define PG8_SCHED __builtin_amdgcn_sched_barrier(0)
    Unit cur, nxt; int ui = 0;
    if (!S.next(0, cur)) return;
    f32x4 acc[2][2][4][2];
#pragma unroll
    for (int a = 0; a < 2; ++a)
#pragma unroll
        for (int b = 0; b < 2; ++b)
#pragma unroll
            for (int m = 0; m < 4; ++m)
#pragma unroll
                for (int n = 0; n < 2; ++n) acc[a][b][m][n] = (f32x4){0.f, 0.f, 0.f, 0.f};
    bf16x8 At[4][2], B0[2][2], B1[2][2];
    const char* cA = (const char*)g.A + (size_t)cur.pm * tstep; const char* cB = (const char*)g.Bt + (size_t)cur.pn * tstep;
    S.a_ready(cur);
    if constexpr (SP2) {
        PG8_STAGE(PG8_SB(0, 0), cB, voffB); PG8_STAGE(PG8_SB(0, 1), cB + hstep, voffB); PG8_STAGE(PG8_SA(0, 0), cA, voffA); PG8_STAGE(PG8_SA(0, 1), cA + hstep, voffA);
        if (wr == 1) PG8_BAR;
        PG8_WAIT_V(2); PG8_BAR;
        PG8_STAGE(PG8_SB(1, 0), cB + kstep, voffB); PG8_STAGE(PG8_SA(1, 0), cA + kstep, voffA); PG8_STAGE(PG8_SB(1, 1), cB + hstep + kstep, voffB);
        PG8_WAIT_V(6); PG8_BAR;
    } else {
        PG8_STAGE(PG8_SB(0, 0), cB, voffB); PG8_STAGE(PG8_SA(0, 0), cA, voffA); PG8_STAGE(PG8_SB(0, 1), cB + hstep, voffB); PG8_STAGE(PG8_SA(0, 1), cA + hstep, voffA);
        if (wr == 1) PG8_BAR;
        PG8_WAIT_V(4); PG8_BAR;
        PG8_STAGE(PG8_SB(1, 0), cB + kstep, voffB); PG8_STAGE(PG8_SA(1, 0), cA + kstep, voffA); PG8_STAGE(PG8_SB(1, 1), cB + hstep + kstep, voffB);
        PG8_WAIT_V(6); PG8_BAR;
    }
    for (;;) {
        const bool has_next = S.next(ui + 1, nxt);
        const char* nA = has_next ? (const char*)g.A + (size_t)nxt.pm * tstep : cA; const char* nB = has_next ? (const char*)g.Bt + (size_t)nxt.pn * tstep : cB;
        for (int t = 0; t < nt; t += 2) {
            const bool last = (t == nt - 2);
            const char* a1 = cA + (size_t)(t + 1) * kstep;
            const char* a2 = last ? nA : cA + (size_t)(t + 2) * kstep; const char* b2 = last ? nB : cB + (size_t)(t + 2) * kstep;
            const char* a3 = a2 + kstep; const char* b3 = b2 + kstep;
            if (last && has_next) S.a_ready(nxt);
            if constexpr (SP2) {
            PG8_LDB(B0, 0, 0); PG8_LDB(B1, 0, 1); PG8_SCHED; PG8_LDA(At, 0, 0); PG8_STAGE(PG8_SA(1, 1), a1 + hstep, voffA);
            PG8_WAIT_V(8); PG8_WAIT_L(0); PG8_BAR; PG8_MMA(0, 0, At, B0); PG8_MMA(0, 1, At, B1); PG8_BAR; PG8_SCHED;
            PG8_LDA(At, 0, 1); PG8_STAGE(PG8_SB(0, 0), b2, voffB); PG8_STAGE(PG8_SB(0, 1), b2 + hstep, voffB); PG8_STAGE(PG8_SA(0, 0), a2, voffA);
            PG8_WAIT_V(8); PG8_WAIT_L(0); PG8_BAR; PG8_MMA(1, 0, At, B0); PG8_MMA(1, 1, At, B1); PG8_BAR; PG8_SCHED;
            PG8_LDB(B0, 1, 0); PG8_LDB(B1, 1, 1); PG8_SCHED; PG8_LDA(At, 1, 0); PG8_STAGE(PG8_SA(0, 1), a2 + hstep, voffA);
            PG8_WAIT_V(8); PG8_WAIT_L(0); PG8_BAR; PG8_MMA(0, 0, At, B0); PG8_MMA(0, 1, At, B1); PG8_BAR; PG8_SCHED;
            PG8_LDA(At, 1, 1); PG8_STAGE(PG8_SB(1, 0), b3, voffB); PG8_STAGE(PG8_SB(1, 1), b3 + hstep, voffB); PG8_STAGE(PG8_SA(1, 0), a3, voffA);
            PG8_WAIT_V(8); PG8_WAIT_L(0); PG8_BAR; PG8_MMA(1, 0, At, B0); PG8_MMA(1, 1, At, B1); PG8_BAR; PG8_SCHED;
            } else {
            PG8_LDB(B0, 0, 0); PG8_SCHED; PG8_LDA(At, 0, 0); PG8_STAGE(PG8_SA(1, 1), a1 + hstep, voffA);
            PG8_WAIT_L(8); PG8_BAR; PG8_WAIT_L(0); PG8_MMA(0, 0, At, B0); PG8_BAR; PG8_SCHED;
            PG8_LDB(B1, 0, 1); PG8_STAGE(PG8_SB(0, 0), b2, voffB);
            PG8_BAR; PG8_WAIT_L(0); PG8_MMA(0, 1, At, B1); PG8_BAR;
            PG8_LDA(At, 0, 1); PG8_STAGE(PG8_SA(0, 0), a2, voffA);
            PG8_BAR; PG8_WAIT_L(0); PG8_MMA(1, 0, At, B0); PG8_BAR; PG8_SCHED;
            PG8_STAGE(PG8_SB(0, 1), b2 + hstep, voffB);
            PG8_WAIT_V(6); PG8_BAR; PG8_MMA(1, 1, At, B1); PG8_BAR;
            PG8_LDB(B0, 1, 0); PG8_SCHED; PG8_LDA(At, 1, 0); PG8_STAGE(PG8_SA(0, 1), a2 + hstep, voffA);
            PG8_WAIT_L(8); PG8_BAR; PG8_WAIT_L(0); PG8_MMA(0, 0, At, B0); PG8_BAR; PG8_SCHED;
            PG8_LDB(B1, 1, 1); PG8_STAGE(PG8_SB(1, 0), b3, voffB);
            PG8_BAR; PG8_WAIT_L(0); PG8_MMA(0, 1, At, B1); PG8_BAR;
            PG8_LDA(At, 1, 1); PG8_STAGE(PG8_SA(1, 0), a3, voffA);
            PG8_BAR; PG8_WAIT_L(0); PG8_MMA(1, 0, At, B0); PG8_BAR; PG8_SCHED;
            PG8_STAGE(PG8_SB(1, 1), b3 + hstep, voffB);
            PG8_WAIT_V(6); PG8_BAR; PG8_MMA(1, 1, At, B1); PG8_BAR;
            }
        }
        if constexpr (ALIGN_EPI) { if (wr == 0) PG8_BAR; }
        if constexpr (!Epi::AFTER_DRAIN) { E(acc, cur, wr, wc, fr, fq); S.done(cur); }
        if (!has_next) break;
#pragma unroll
        for (int a = 0; a < 2; ++a)
#pragma unroll
            for (int b = 0; b < 2; ++b)
#pragma unroll
                for (int m = 0; m < 4; ++m)
#pragma unroll
                    for (int n = 0; n < 2; ++n) acc[a][b][m][n] = (f32x4){0.f, 0.f, 0.f, 0.f};
        cur = nxt; cA = nA; cB = nB; ++ui;
        if constexpr (ALIGN_EPI) { if (wr == 1) PG8_BAR; }
    }
    PG8_WAIT_V(0);
    if constexpr (!ALIGN_EPI) { if (wr == 0) PG8_BAR; }
    PG8_BAR;
    if constexpr (Epi::AFTER_DRAIN) { E.fused(acc, cur, wr, wc, fr, fq, lds, wid, lane); S.done(cur); }
#undef PG8_SA
#undef PG8_SB
#undef PG8_STAGE
#undef PG8_LDA
#undef PG8_LDB
#undef PG8_MMA
#undef PG8_WAIT_V
#undef PG8_WAIT_L
#undef PG8_BAR
#undef PG8_SCHED
}
}
namespace attn_body {
using bf16=__hip_bfloat16;
using bf16x8=__attribute__((ext_vector_type(8)))short;
using s16x4=__attribute__((ext_vector_type(4)))short;
using f32x16=__attribute__((ext_vector_type(16)))float;
using u32x4=__attribute__((ext_vector_type(4)))unsigned;
constexpr int SEQ=16384,D=64,PP=64;
constexpr int NW=8,QBLK=32,QB=QBLK*NW,KVBLK=64,NQB=SEQ/QB,NT=SEQ/KVBLK;
constexpr int OPITCH=1024;
__device__ __forceinline__ int crow(int r,int hi){return (r&3)+8*(r>>2)+4*hi;}
#define SBAR() __builtin_amdgcn_sched_barrier(0)
constexpr int NSLOT=3, SLOTB=8192;
constexpr int LDS_K=0, LDS_V=NSLOT*SLOTB, LDS_WS=LDS_V+NSLOT*2*SLOTB, LDS_OST=LDS_WS+NW*64*4, LDS_BYTES=LDS_OST+NW*8192;
__device__ __forceinline__ void glds16(const void*gsrc,unsigned lds_dst){unsigned keep;
  asm volatile("s_mov_b32 %0, m0\n\ts_mov_b32 m0, %2\n\ts_nop 0\n\tglobal_load_lds_dwordx4 %1, off\n\ts_mov_b32 m0, %0":"=&s"(keep):"v"(gsrc),"s"(lds_dst):"memory");}
__device__ __forceinline__ void glds16b(__amdgpu_buffer_rsrc_t srd,unsigned voff,unsigned soff,unsigned lds_dst){unsigned keep;
  asm volatile("s_nop 4\n\ts_mov_b32 %0, m0\n\ts_mov_b32 m0, %4\n\ts_nop 0\n\tbuffer_load_dwordx4 %1, %2, %3 offen lds\n\ts_mov_b32 m0, %0":"=&s"(keep):"v"(voff),"s"(srd),"s"(soff),"s"(lds_dst):"memory");}
__device__ __forceinline__ float max3f(float a,float b,float c){float r;asm("v_max3_f32 %0, %1, %2, %3":"=v"(r):"v"(a),"v"(b),"v"(c));return r;}
__device__ __forceinline__ float max2f(float a,float b){float r;asm("v_max_f32_e32 %0, %1, %2":"=v"(r):"v"(a),"v"(b));return r;}
__device__ __forceinline__ float fadd_s(float a,float b){float r;asm("v_add_f32_e32 %0, %1, %2":"=v"(r):"v"(a),"v"(b));return r;}
__device__ __forceinline__ float fsub_s(float a,float b){float r;asm("v_sub_f32_e32 %0, %1, %2":"=v"(r):"v"(a),"v"(b));return r;}
typedef float f32x2_t __attribute__((ext_vector_type(2))); typedef __bf16 bf16x2_t __attribute__((ext_vector_type(2)));
__device__ __forceinline__ unsigned cvtpk_s(float lo,float hi){f32x2_t v={lo,hi};bf16x2_t b=__builtin_convertvector(v,bf16x2_t);return __builtin_bit_cast(unsigned,b);}
#define WAIT_BAR(N) asm volatile("s_waitcnt vmcnt(" #N ") lgkmcnt(0)\n\ts_barrier":::"memory")

__device__ __forceinline__ void zero16(f32x16&x){
  #pragma unroll
  for(int r=0;r<16;++r){float z;asm volatile("v_mov_b32 %0, 0":"=v"(z));x[r]=z;}
}
__device__ __forceinline__ void qkt(f32x16&p0,f32x16&p1,const char*Kslot,const bf16x8*qr,const f32x16&negm,int r32,int hi){
  const char*kb=Kslot+hi*1024+r32*16;
  #pragma unroll
  for(int d0=0;d0<4;++d0){
    const bf16x8 b0=*reinterpret_cast<const bf16x8*>(kb+d0*2048);
    const bf16x8 b1=*reinterpret_cast<const bf16x8*>(kb+d0*2048+512);
    if(d0==0){p0=__builtin_amdgcn_mfma_f32_32x32x16_bf16(b0,qr[0],negm,0,0,0);p1=__builtin_amdgcn_mfma_f32_32x32x16_bf16(b1,qr[0],negm,0,0,0);}
    else{p0=__builtin_amdgcn_mfma_f32_32x32x16_bf16(b0,qr[d0],p0,0,0,0);p1=__builtin_amdgcn_mfma_f32_32x32x16_bf16(b1,qr[d0],p1,0,0,0);}}
}
typedef __attribute__((address_space(3))) const char* lds_cptr;
typedef short v4i16_t __attribute__((ext_vector_type(4)));
__device__ __forceinline__ void kload8(bf16x8*kf,lds_cptr kp){
  kf[0]=*(const __attribute__((address_space(3))) bf16x8*)(kp);      kf[1]=*(const __attribute__((address_space(3))) bf16x8*)(kp+512);
  kf[2]=*(const __attribute__((address_space(3))) bf16x8*)(kp+2048); kf[3]=*(const __attribute__((address_space(3))) bf16x8*)(kp+2560);
  kf[4]=*(const __attribute__((address_space(3))) bf16x8*)(kp+4096); kf[5]=*(const __attribute__((address_space(3))) bf16x8*)(kp+4608);
  kf[6]=*(const __attribute__((address_space(3))) bf16x8*)(kp+6144); kf[7]=*(const __attribute__((address_space(3))) bf16x8*)(kp+6656);
}
__device__ __forceinline__ void kload2(bf16x8*kf,lds_cptr kp,int j){ kf[2*j]=*(const __attribute__((address_space(3))) bf16x8*)(kp+j*2048); kf[2*j+1]=*(const __attribute__((address_space(3))) bf16x8*)(kp+j*2048+512); }
__device__ __forceinline__ s16x4 vtr(lds_cptr p){ return __builtin_bit_cast(s16x4,__builtin_amdgcn_ds_read_tr16_b64_v4i16((__attribute__((address_space(3))) v4i16_t*)p)); }
__device__ __forceinline__ float rowmax(const f32x16&p0,const f32x16&p1){
  float a=max3f(p0[0],p0[1],p1[0]),b=max3f(p0[2],p0[3],p1[1]);a=max3f(a,p1[2],p1[3]);
  #pragma unroll
  for(int r=4;r<16;r+=4){a=max3f(a,p0[r],p0[r+1]);b=max3f(b,p0[r+2],p0[r+3]);a=max3f(a,p1[r],p1[r+1]);b=max3f(b,p1[r+2],p1[r+3]);}
  const float m=max2f(a,b);
  auto rr=__builtin_amdgcn_permlane32_swap(__float_as_uint(m),__float_as_uint(m),false,false);
  return max2f(__uint_as_float(rr[0]),__uint_as_float(rr[1]));
}
template<int NB> __device__ __forceinline__ void pv(f32x16*o,int vb,bf16x8 pa0,bf16x8 pa1,bf16x8 pa2,bf16x8 pa3){
  #pragma unroll
  for(int d0=0;d0<NB;++d0){s16x4 lo[4],hi[4];
    #pragma unroll
    for(int ks=0;ks<4;++ks){
      asm volatile("ds_read_b64_tr_b16 %0,%1 offset:%c2":"=&v"(lo[ks]):"v"(vb),"i"(d0*4096+ks*1024):"memory");
      asm volatile("ds_read_b64_tr_b16 %0,%1 offset:%c2":"=&v"(hi[ks]):"v"(vb),"i"(d0*4096+ks*1024+512):"memory");}
    asm volatile("s_waitcnt lgkmcnt(0)":::"memory");SBAR();
    #define PK(k) (bf16x8){lo[k][0],lo[k][1],lo[k][2],lo[k][3],hi[k][0],hi[k][1],hi[k][2],hi[k][3]}
    o[d0]=__builtin_amdgcn_mfma_f32_32x32x16_bf16(pa0,PK(0),o[d0],0,0,0);
    o[d0]=__builtin_amdgcn_mfma_f32_32x32x16_bf16(pa1,PK(1),o[d0],0,0,0);
    o[d0]=__builtin_amdgcn_mfma_f32_32x32x16_bf16(pa2,PK(2),o[d0],0,0,0);
    o[d0]=__builtin_amdgcn_mfma_f32_32x32x16_bf16(pa3,PK(3),o[d0],0,0,0);
    #undef PK
  }
}
#ifndef ATTN_STORE16
#define ATTN_STORE16(p,v) (*(u32x4*)(p)=(v))
#endif
#define PKW(P,B) cvtpk_s(P[B],P[B+1])
#define PAF(k) __builtin_bit_cast(bf16x8,pw##k)
#define PIN(x) asm volatile("":"+v"(x))
#define MX3(a,b,c) __builtin_fmaxf(__builtin_fmaxf((a),(b)),(c))
#define EX(v) __builtin_amdgcn_exp2f(v)
#define MF32(a,b,c) __builtin_amdgcn_mfma_f32_32x32x16_bf16(a,b,c,0,0,0)
#define GAPA(MF,A0,A1,A2,A3,W0,W1,PW) do{ MF; sacc+=A0; sacc+=A1; sacc+=A2; sacc+=A3; PIN(sacc); W0; W1; PIN(PW); SBAR(); }while(0)
#define ROT() do{sl_prev=sl_cur;sl_cur=sl_next;sl_next=(sl_next==(NSLOT-1)*SLOTB)?0:sl_next+SLOTB;}while(0)
#define DECIDE(C0,C1) do{ float a=MX3(C0[0],C0[1],C1[0]),b=MX3(C0[2],C0[3],C1[1]); a=MX3(a,C1[2],C1[3]); \
      _Pragma("unroll") for(int r=4;r<16;r+=4){a=MX3(a,C0[r],C0[r+1]);b=MX3(b,C0[r+2],C0[r+3]);a=MX3(a,C1[r],C1[r+1]);b=MX3(b,C1[r+2],C1[r+3]);} \
      float rm=__builtin_fmaxf(a,b); { auto rr=__builtin_amdgcn_permlane32_swap(__float_as_uint(rm),__float_as_uint(rm),false,false); rm=__builtin_fmaxf(__uint_as_float(rr[0]),__uint_as_float(rr[1])); } \
      resc=false; \
      if(__builtin_expect(__any(rm>(float)THRL),0)){ const float dl=__builtin_fmaxf(rm,0.f); mhat+=dl; \
        _Pragma("unroll") for(int r=0;r<16;++r){C0[r]-=dl;C1[r]-=dl;} \
        _Pragma("unroll") for(int r=0;r<16;++r)negm[r]=-mhat; asm volatile("":"+v"(negm)); \
        const float f=__builtin_amdgcn_exp2f(-dl); l_reg*=f; if(hi==0)wsf[r32]=f; resc=true; } }while(0)
#define START(P0,P1) do{ const float rm=rowmax(P0,P1); resc=false; \
    { const float dl=rm; mhat=fadd_s(mhat,dl); \
      _Pragma("unroll") for(int r=0;r<16;++r){P0[r]=fsub_s(P0[r],dl);P1[r]=fsub_s(P1[r],dl);} \
      _Pragma("unroll") for(int r=0;r<16;++r)negm[r]=-mhat; asm volatile("":"+v"(negm)); } \
    _Pragma("unroll") for(int r=0;r<16;++r)P0[r]=__builtin_amdgcn_exp2f(P0[r]); }while(0)
#define KRD(G,j) do{ if(G){ kload2(kf,kp0+sl_next,j); SBAR(); } }while(0)

template<int THRL> __device__ __forceinline__ void attn_unit_a(int qb,const bf16*Qp,__amdgpu_buffer_rsrc_t srd,unsigned kbyte,unsigned vbyte,bf16*Ob,char*shm,float mub,bool SB){
  const int tid=threadIdx.x,lane=tid&63,r32=lane&31,hi=lane>>5; const int wid=__builtin_amdgcn_readfirstlane(tid>>6);
  const int q0=qb*QB;
  const bf16*Qw=Qp+(long)(q0+wid*QBLK)*PP;
  const unsigned lds0=(unsigned)(uintptr_t)shm;
  float*wsf=(float*)(shm+LDS_WS)+wid*64;
  const unsigned kvoff=(unsigned)(lane*PP+wid*8)*2u, vvoff=(unsigned)((16*(wid&3)+(lane>>2))*PP+(wid>>2)*32+(lane&3)*8)*2u;
  const unsigned kdst=lds0+LDS_K+wid*1024, vdst=lds0+LDS_V+wid*1024;
  #define DMA_K(t,slot) glds16b(srd,kvoff,(unsigned)__builtin_amdgcn_readfirstlane(kbyte+(unsigned)(t)*(KVBLK*PP*2)),(unsigned)__builtin_amdgcn_readfirstlane(kdst+(slot)))
  #define DMA_V(t,slot) glds16b(srd,vvoff,(unsigned)__builtin_amdgcn_readfirstlane(vbyte+(unsigned)(t)*(KVBLK*PP*2)),(unsigned)__builtin_amdgcn_readfirstlane(vdst+2*(slot)))
  const int vb0=(int)(lds0+LDS_V)+((lane>>4)&1)*32+(lane&3)*8+(4*hi+((lane&15)>>2))*64;
  const char*Kbase=shm+LDS_K; bf16x8 kf[8];
  const lds_cptr shm3=(lds_cptr)shm; const lds_cptr kp0=shm3+LDS_K+hi*1024+r32*16; const lds_cptr vp0=shm3+LDS_V+((lane>>4)&1)*32+(lane&3)*8+(4*hi+((lane&15)>>2))*64;
  DMA_K(0,0);DMA_V(0,0);DMA_K(1,SLOTB);
  bf16x8 qr[4];
  #pragma unroll
  for(int d0=0;d0<4;++d0)qr[d0]=*reinterpret_cast<const bf16x8*>(&Qw[(long)r32*PP+d0*16+hi*8]);
  float mhat=0.f,l_reg=0.f;f32x16 o[2];zero16(o[0]);zero16(o[1]);f32x16 negm;zero16(negm);
  if(SB){ _Pragma("unroll") for(int r=0;r<16;++r)negm[r]=-mub; asm volatile("":"+v"(negm)); }
  bool resc=false;
  #define RESC() do{ if(!SB && resc){ asm volatile("s_waitcnt lgkmcnt(0)":::"memory"); \
      _Pragma("unroll") for(int d_=0;d_<2;++d_) _Pragma("unroll") for(int r=0;r<16;++r)o[d_][r]*=wsf[crow(r,hi)]; } }while(0)
  f32x16 pA0,pA1,pB0,pB1;
  int sl_prev=0,sl_cur=0,sl_next=SLOTB;
  DMA_K(2,2*SLOTB);
  WAIT_BAR(3);
  qkt(pA0,pA1,Kbase,qr,negm,r32,hi);asm volatile("s_nop 15\n\ts_nop 7":"+v"(pA0),"+v"(pA1));
  if(SB){ _Pragma("unroll") for(int r=0;r<16;++r)pA0[r]=__builtin_amdgcn_exp2f(pA0[r]); } else { START(pA0,pA1); }
  _Pragma("unroll") for(int r=0;r<16;++r)pA1[r]=__builtin_amdgcn_exp2f(pA1[r]);
  WAIT_BAR(0);
  DMA_K(3,0);DMA_V(1,SLOTB);
  ROT();
  kload8(kf,kp0+sl_cur);
  WAIT_BAR(2);
  s16x4 vlo[8],vhi[8]; u32x4 pw0,pw1,pw2,pw3;
  #define VFR(i) (bf16x8){vlo[i][0],vlo[i][1],vlo[i][2],vlo[i][3],vhi[i][0],vhi[i][1],vhi[i][2],vhi[i][3]}
  #define GAPB(MF,X,B) do{ MF; X[B]=EX(X[B]); X[B+1]=EX(X[B+1]); X[B+2]=EX(X[B+2]); X[B+3]=EX(X[B+3]); PIN(X); SBAR(); }while(0)
  #define VRD(i) do{ vlo[i]=vtr(vp_+(((i)>>2)*4096+((i)&3)*1024)); vhi[i]=vtr(vp_+(((i)>>2)*4096+((i)&3)*1024+512)); }while(0)
  #define STEP(C0,C1,P0,P1,t,GK,GV,GL) do{ SBAR(); \
    const lds_cptr vp_=vp0+2*sl_prev; \
    VRD(0); SBAR(); float sacc=(P0[0]+P0[1]); \
    GAPA(C0=MF32(kf[0],qr[0],negm), P0[2],P0[3],P0[4],P0[5],     pw0[0]=PKW(P0,0), pw0[1]=PKW(P0,2), pw0); \
    VRD(4); SBAR(); GAPA(C1=MF32(kf[1],qr[0],negm), P0[6],P0[7],P0[8],P0[9],     pw0[2]=PKW(P0,4), pw0[3]=PKW(P0,6), pw0); \
    VRD(1); SBAR(); GAPA(C0=MF32(kf[2],qr[1],C0),   P0[10],P0[11],P0[12],P0[13], pw1[0]=PKW(P0,8), pw1[1]=PKW(P0,10), pw1); \
    VRD(5); SBAR(); GAPA(C1=MF32(kf[3],qr[1],C1),   P0[14],P0[15],P1[0],P1[1],   pw1[2]=PKW(P0,12),pw1[3]=PKW(P0,14), pw1); \
    VRD(2); SBAR(); GAPA(C0=MF32(kf[4],qr[2],C0),   P1[2],P1[3],P1[4],P1[5],     pw2[0]=PKW(P1,0), pw2[1]=PKW(P1,2), pw2); \
    VRD(6); SBAR(); GAPA(C1=MF32(kf[5],qr[2],C1),   P1[6],P1[7],P1[8],P1[9],     pw2[2]=PKW(P1,4), pw2[3]=PKW(P1,6), pw2); \
    VRD(3); SBAR(); GAPA(C0=MF32(kf[6],qr[3],C0),   P1[10],P1[11],P1[12],P1[13], pw3[0]=PKW(P1,8), pw3[1]=PKW(P1,10), pw3); \
    VRD(7); SBAR(); GAPA(C1=MF32(kf[7],qr[3],C1),   P1[14],P1[15],0.f,0.f,       pw3[2]=PKW(P1,12),pw3[3]=PKW(P1,14), pw3); \
    l_reg+=sacc; \
    if(GK){DMA_K((t)+3,sl_cur);} if(GV){DMA_V((t)+1,sl_next);} \
    if(!SB){ DECIDE(C0,C1); } \
    SBAR(); __builtin_amdgcn_s_setprio(1); \
    GAPB(o[0]=MF32(PAF(0),VFR(0),o[0]), C0,0); \
    GAPB(o[1]=MF32(PAF(0),VFR(4),o[1]), C0,4); \
    KRD(GL,0); GAPB(o[0]=MF32(PAF(1),VFR(1),o[0]), C0,8); \
    KRD(GL,1); GAPB(o[1]=MF32(PAF(1),VFR(5),o[1]), C0,12); \
    KRD(GL,2); GAPB(o[0]=MF32(PAF(2),VFR(2),o[0]), C1,0); \
    KRD(GL,3); GAPB(o[1]=MF32(PAF(2),VFR(6),o[1]), C1,4); \
    GAPB(o[0]=MF32(PAF(3),VFR(3),o[0]), C1,8); \
    GAPB(o[1]=MF32(PAF(3),VFR(7),o[1]), C1,12); __builtin_amdgcn_s_setprio(0); \
    }while(0)
  int t=1;
  for(;t+5<NT;t+=2){
    STEP(pB0,pB1,pA0,pA1,t,true,true,true);     WAIT_BAR(2); RESC(); ROT();
    STEP(pA0,pA1,pB0,pB1,t+1,true,true,true);   WAIT_BAR(2); RESC(); ROT();
  }
  #define ENDW(tt) do{ if((tt)+3<NT){WAIT_BAR(2);} else if((tt)+2<NT){WAIT_BAR(1);} else {WAIT_BAR(0);} }while(0)
  for(;t+1<NT;t+=2){
    STEP(pB0,pB1,pA0,pA1,t,(t+3<NT),(t+1<NT),(t+1<NT));       ENDW(t);   RESC(); ROT();
    STEP(pA0,pA1,pB0,pB1,t+1,(t+4<NT),(t+2<NT),(t+2<NT));     ENDW(t+1); RESC(); ROT();
  }
  STEP(pB0,pB1,pA0,pA1,NT-1,false,false,false); RESC();
  { float sacc=pB0[0]+pB0[1]; _Pragma("unroll") for(int r=2;r<16;++r)sacc+=pB0[r]; _Pragma("unroll") for(int r=0;r<16;++r)sacc+=pB1[r]; l_reg+=sacc;
    pw0=(u32x4){PKW(pB0,0),PKW(pB0,2),PKW(pB0,4),PKW(pB0,6)};pw1=(u32x4){PKW(pB0,8),PKW(pB0,10),PKW(pB0,12),PKW(pB0,14)};pw2=(u32x4){PKW(pB1,0),PKW(pB1,2),PKW(pB1,4),PKW(pB1,6)};pw3=(u32x4){PKW(pB1,8),PKW(pB1,10),PKW(pB1,12),PKW(pB1,14)};
    SBAR(); pv<2>(o,vb0+2*sl_cur,PAF(0),PAF(1),PAF(2),PAF(3)); }
  #undef VFR
  #undef GAPB
  #undef VRD
  #undef STEP
  #undef ENDW
  {auto rr=__builtin_amdgcn_permlane32_swap(__float_as_uint(l_reg),__float_as_uint(l_reg),false,false);l_reg=__uint_as_float(rr[0])+__uint_as_float(rr[1]);}
  if(hi==0)wsf[32+r32]=l_reg;asm volatile("s_waitcnt lgkmcnt(0)":::"memory");
  float rli[16];
  #pragma unroll
  for(int r=0;r<16;++r)rli[r]=__builtin_amdgcn_rcpf(wsf[32+crow(r,hi)]);
  bf16*Ow=Ob+(long)(q0+wid*QBLK)*OPITCH;
  { bf16*stg=(bf16*)(shm+LDS_OST)+wid*4096;
    #pragma unroll
    for(int r=0;r<16;++r){const int orow=crow(r,hi);
      #pragma unroll
      for(int d0=0;d0<2;++d0)stg[orow*64+d0*32+r32]=__float2bfloat16(o[d0][r]*rli[r]);}
    asm volatile("s_waitcnt lgkmcnt(0)":::"memory");
    #pragma unroll
    for(int i=0;i<4;++i){const int row=i*8+(lane>>3),ch=lane&7; const u32x4 v=*(const u32x4*)(stg+row*64+ch*8); ATTN_STORE16(Ow+(long)row*OPITCH+ch*8,v);} }
  asm volatile("s_waitcnt lgkmcnt(0)\n\ts_barrier":::"memory");
  #undef DMA_K
  #undef DMA_V
  #undef RESC
}
template<int THRL> __device__ __forceinline__ void attn_unit_b(int qb,int comp,const bf16*Qp,__amdgpu_buffer_rsrc_t srd,unsigned kbyte,unsigned vbyte,float*sc,float lam,const float*subg,bf16*Ob,char*shm,float mub,bool SB){
  const int tid=threadIdx.x,lane=tid&63,r32=lane&31,hi=lane>>5; const int wid=__builtin_amdgcn_readfirstlane(tid>>6);
  const int q0=qb*QB;
  const bf16*Qw=Qp+(long)(q0+wid*QBLK)*PP;
  const unsigned lds0=(unsigned)(uintptr_t)shm;
  float*wsf=(float*)(shm+LDS_WS)+wid*64;
  const unsigned kvoff=(unsigned)(lane*PP+wid*8)*2u;
  const unsigned vvoff=(unsigned)((16*(wid&3)+(lane>>2))*PP+(wid>>2)*32+(lane&3)*8)*2u;
  const unsigned kdst=lds0+LDS_K+wid*1024, vdst=lds0+LDS_V+wid*1024;
  #define DMA_K(t,slot) glds16b(srd,kvoff,(unsigned)__builtin_amdgcn_readfirstlane(kbyte+(unsigned)(t)*(KVBLK*PP*2)),(unsigned)__builtin_amdgcn_readfirstlane(kdst+(slot)))
  #define DMA_V(t,slot) do{ const unsigned so_=(unsigned)__builtin_amdgcn_readfirstlane(vbyte+(unsigned)(t)*(KVBLK*PP*2)); glds16b(srd,vvoff,so_,(unsigned)__builtin_amdgcn_readfirstlane(vdst+2*(slot))); glds16b(srd,vvoff,so_+(unsigned)(SEQ*PP*2),(unsigned)__builtin_amdgcn_readfirstlane(vdst+2*(slot)+8192)); }while(0)
  const int vb0=(int)(lds0+LDS_V)+((lane>>4)&1)*32+(lane&3)*8+(4*hi+((lane&15)>>2))*64;
  const char*Kbase=shm+LDS_K; bf16x8 kf[8];
  const lds_cptr shm3=(lds_cptr)shm; const lds_cptr kp0=shm3+LDS_K+hi*1024+r32*16; const lds_cptr vp0=shm3+LDS_V+((lane>>4)&1)*32+(lane&3)*8+(4*hi+((lane&15)>>2))*64;
  DMA_K(0,0);DMA_V(0,0);DMA_K(1,SLOTB);
  bf16x8 qr[4];
  #pragma unroll
  for(int d0=0;d0<4;++d0)qr[d0]=*reinterpret_cast<const bf16x8*>(&Qw[(long)r32*PP+d0*16+hi*8]);
  float mhat=0.f,l_reg=0.f;f32x16 o[4];zero16(o[0]);zero16(o[1]);zero16(o[2]);zero16(o[3]);f32x16 negm;zero16(negm);
  if(SB){ _Pragma("unroll") for(int r=0;r<16;++r)negm[r]=-mub; asm volatile("":"+v"(negm)); }
  bool resc=false;
  #define RESC() do{ if(!SB && resc){ asm volatile("s_waitcnt lgkmcnt(0)":::"memory"); \
      _Pragma("unroll") for(int d_=0;d_<4;++d_) _Pragma("unroll") for(int r=0;r<16;++r)o[d_][r]*=wsf[crow(r,hi)]; } }while(0)
  f32x16 pA0,pA1,pB0,pB1;
  int sl_prev=0,sl_cur=0,sl_next=SLOTB;
  DMA_K(2,2*SLOTB);
  WAIT_BAR(4);
  qkt(pA0,pA1,Kbase,qr,negm,r32,hi);asm volatile("s_nop 15\n\ts_nop 7":"+v"(pA0),"+v"(pA1));
  if(SB){ _Pragma("unroll") for(int r=0;r<16;++r)pA0[r]=__builtin_amdgcn_exp2f(pA0[r]); } else { START(pA0,pA1); }
  _Pragma("unroll") for(int r=0;r<16;++r)pA1[r]=__builtin_amdgcn_exp2f(pA1[r]);
  WAIT_BAR(0);
  DMA_K(3,0);DMA_V(1,SLOTB);
  ROT();
  kload8(kf,kp0+sl_cur);
  WAIT_BAR(3);
  s16x4 vfl[4],vfh[4]; u32x4 pw0,pw1,pw2,pw3;
  #define VFRB(g) (bf16x8){vfl[(g)&3][0],vfl[(g)&3][1],vfl[(g)&3][2],vfl[(g)&3][3],vfh[(g)&3][0],vfh[(g)&3][1],vfh[(g)&3][2],vfh[(g)&3][3]}
  #define VRDB(g) do{ vfl[(g)&3]=vtr(vp_+(((g)&3)*4096+((g)>>2)*1024)); vfh[(g)&3]=vtr(vp_+(((g)&3)*4096+((g)>>2)*1024+512)); }while(0)
  #define GAPB2(g,X,B) do{ o[(g)&3]=MF32(PAF4((g)>>2),VFRB(g),o[(g)&3]); X[B]=EX(X[B]); X[B+1]=EX(X[B+1]); PIN(X); SBAR(); }while(0)
  #define PAF4(k) ((k)==0?PAF(0):(k)==1?PAF(1):(k)==2?PAF(2):PAF(3))
  #define STEPB(C0,C1,P0,P1,t,GK,GV,GL) do{ SBAR(); \
    const lds_cptr vp_=vp0+2*sl_prev; \
    float sacc=(P0[0]+P0[1]); \
    GAPA(C0=MF32(kf[0],qr[0],negm), P0[2],P0[3],P0[4],P0[5],     pw0[0]=PKW(P0,0), pw0[1]=PKW(P0,2), pw0); \
    GAPA(C1=MF32(kf[1],qr[0],negm), P0[6],P0[7],P0[8],P0[9],     pw0[2]=PKW(P0,4), pw0[3]=PKW(P0,6), pw0); \
    GAPA(C0=MF32(kf[2],qr[1],C0),   P0[10],P0[11],P0[12],P0[13], pw1[0]=PKW(P0,8), pw1[1]=PKW(P0,10), pw1); \
    GAPA(C1=MF32(kf[3],qr[1],C1),   P0[14],P0[15],P1[0],P1[1],   pw1[2]=PKW(P0,12),pw1[3]=PKW(P0,14), pw1); \
    GAPA(C0=MF32(kf[4],qr[2],C0),   P1[2],P1[3],P1[4],P1[5],     pw2[0]=PKW(P1,0), pw2[1]=PKW(P1,2), pw2); \
    GAPA(C1=MF32(kf[5],qr[2],C1),   P1[6],P1[7],P1[8],P1[9],     pw2[2]=PKW(P1,4), pw2[3]=PKW(P1,6), pw2); \
    GAPA(C0=MF32(kf[6],qr[3],C0),   P1[10],P1[11],P1[12],P1[13], pw3[0]=PKW(P1,8), pw3[1]=PKW(P1,10), pw3); \
    GAPA(C1=MF32(kf[7],qr[3],C1),   P1[14],P1[15],0.f,0.f,       pw3[2]=PKW(P1,12),pw3[3]=PKW(P1,14), pw3); \
    l_reg+=sacc; \
    if(GK){DMA_K((t)+3,sl_cur);} if(GV){DMA_V((t)+1,sl_next);} \
    VRDB(0); VRDB(1); SBAR(); \
    if(!SB){ DECIDE(C0,C1); } \
    SBAR(); __builtin_amdgcn_s_setprio(1); \
    VRDB(2);  SBAR(); GAPB2(0, C0,0); \
    VRDB(3);  SBAR(); GAPB2(1, C0,2); \
    VRDB(4);  SBAR(); GAPB2(2, C0,4); \
    VRDB(5);  SBAR(); GAPB2(3, C0,6); \
    KRD(GL,0); VRDB(6);  SBAR(); GAPB2(4, C0,8); \
    VRDB(7);  SBAR(); GAPB2(5, C0,10); \
    KRD(GL,1); VRDB(8);  SBAR(); GAPB2(6, C0,12); \
    VRDB(9);  SBAR(); GAPB2(7, C0,14); \
    KRD(GL,2); VRDB(10); SBAR(); GAPB2(8, C1,0); \
    VRDB(11); SBAR(); GAPB2(9, C1,2); \
    KRD(GL,3); VRDB(12); SBAR(); GAPB2(10,C1,4); \
    VRDB(13); SBAR(); GAPB2(11,C1,6); \
    VRDB(14); SBAR(); GAPB2(12,C1,8); \
    VRDB(15); SBAR(); GAPB2(13,C1,10); \
    GAPB2(14,C1,12); \
    GAPB2(15,C1,14); __builtin_amdgcn_s_setprio(0); \
    }while(0)
  int t=1;
  for(;t+5<NT;t+=2){
    STEPB(pB0,pB1,pA0,pA1,t,true,true,true);     WAIT_BAR(3); RESC(); ROT();
    STEPB(pA0,pA1,pB0,pB1,t+1,true,true,true);   WAIT_BAR(3); RESC(); ROT();
  }
  #define ENDW(tt) do{ if((tt)+3<NT){WAIT_BAR(3);} else if((tt)+2<NT){WAIT_BAR(2);} else {WAIT_BAR(0);} }while(0)
  for(;t+1<NT;t+=2){
    STEPB(pB0,pB1,pA0,pA1,t,(t+3<NT),(t+1<NT),(t+1<NT));       ENDW(t);   RESC(); ROT();
    STEPB(pA0,pA1,pB0,pB1,t+1,(t+4<NT),(t+2<NT),(t+2<NT));     ENDW(t+1); RESC(); ROT();
  }
  STEPB(pB0,pB1,pA0,pA1,NT-1,false,false,false); RESC();
  { float sacc=pB0[0]+pB0[1]; _Pragma("unroll") for(int r=2;r<16;++r)sacc+=pB0[r]; _Pragma("unroll") for(int r=0;r<16;++r)sacc+=pB1[r]; l_reg+=sacc;
    pw0=(u32x4){PKW(pB0,0),PKW(pB0,2),PKW(pB0,4),PKW(pB0,6)};pw1=(u32x4){PKW(pB0,8),PKW(pB0,10),PKW(pB0,12),PKW(pB0,14)};pw2=(u32x4){PKW(pB1,0),PKW(pB1,2),PKW(pB1,4),PKW(pB1,6)};pw3=(u32x4){PKW(pB1,8),PKW(pB1,10),PKW(pB1,12),PKW(pB1,14)};
    SBAR(); pv<4>(o,vb0+2*sl_cur,PAF(0),PAF(1),PAF(2),PAF(3)); }
  #undef VFRB
  #undef VRDB
  #undef GAPB2
  #undef PAF4
  #undef STEPB
  #undef ENDW
  {auto rr=__builtin_amdgcn_permlane32_swap(__float_as_uint(l_reg),__float_as_uint(l_reg),false,false);l_reg=__uint_as_float(rr[0])+__uint_as_float(rr[1]);}
  if(hi==0)wsf[32+r32]=l_reg;asm volatile("s_waitcnt lgkmcnt(0)":::"memory");
  float rli[16];
  #pragma unroll
  for(int r=0;r<16;++r)rli[r]=__builtin_amdgcn_rcpf(wsf[32+crow(r,hi)]);
  int lane_e=lane; asm volatile("":"+v"(lane_e));
  const int r32e=lane_e&31, hie=lane_e>>5;
  float*scw=sc+(long)wid*4096+lane_e;
  if(comp==0){
    #pragma unroll
    for(int d0=0;d0<4;++d0)
      #pragma unroll
      for(int r=0;r<16;++r)scw[(d0*16+r)*64]=o[d0][r]*rli[r];
  } else {
    float ssq[16];
    #pragma unroll
    for(int r=0;r<16;++r)ssq[r]=0.f;
    #pragma unroll
    for(int d0=0;d0<4;++d0)
      #pragma unroll
      for(int r=0;r<16;++r){ const float dv=scw[(d0*16+r)*64]-lam*(o[d0][r]*rli[r]); o[d0][r]=dv; ssq[r]+=dv*dv; }
    #pragma unroll
    for(int r=0;r<16;++r){ float s=ssq[r]; s+=__shfl_xor(s,1); s+=__shfl_xor(s,2); s+=__shfl_xor(s,4); s+=__shfl_xor(s,8); s+=__shfl_xor(s,16); ssq[r]=__builtin_amdgcn_rsqf(s*(1.0f/128.0f)+1e-5f)*0.8f; }
    float gsub[4];
    #pragma unroll
    for(int d0=0;d0<4;++d0)gsub[d0]=subg[d0*32+r32e];
    bf16*Ow=Ob+(long)(q0+wid*QBLK)*OPITCH;
    bf16*stg=(bf16*)(shm+LDS_OST)+wid*4096;
    #pragma unroll
    for(int r=0;r<16;++r){const int orow=crow(r,hie);
      #pragma unroll
      for(int d0=0;d0<4;++d0)stg[orow*128+d0*32+r32e]=__float2bfloat16(o[d0][r]*ssq[r]*gsub[d0]);}
    asm volatile("s_waitcnt lgkmcnt(0)":::"memory");
    #pragma unroll
    for(int i=0;i<8;++i){const int row=i*4+(lane_e>>4),ch=lane_e&15; const u32x4 v=*(const u32x4*)(stg+row*128+ch*8); ATTN_STORE16(Ow+(long)row*OPITCH+ch*8,v);}
  }
  asm volatile("s_waitcnt vmcnt(0) lgkmcnt(0)\n\ts_barrier":::"memory");
  #undef DMA_K
  #undef DMA_V
  #undef RESC
}
#undef PKW
#undef PAF
#undef PIN
#undef MX3
#undef EX
#undef MF32
#undef GAPA
#undef ROT
#undef DECIDE
#undef START
#undef KRD
#undef SBAR
#undef WAIT_BAR
constexpr int ATTN_LDS_BYTES=LDS_BYTES;
}
constexpr int NWAVES = 8;
#ifndef MK_N_LAUNCHES
#define MK_N_LAUNCHES 1
#endif
constexpr int PER_PHASE = 7;
constexpr int N_LAUNCHES = MK_N_LAUNCHES;
static_assert(N_LAUNCHES == 1 || N_LAUNCHES == PER_PHASE, "MK_N_LAUNCHES is 1 or 7");

constexpr int M = 16384, DM = 1024, NIN = 2304, NQ = 2048, NEXP = 16384;
constexpr float C2 = 0.125f * 1.4426950408889634f;
constexpr float NORM_EPS = 1e-6f;

constexpr size_t MiB = 1u << 20;
constexpr size_t WS_CTL = 0, CTL_ZERO_BYTES = 1 * MiB;
constexpr size_t WS_TROW = 1 * MiB, WS_TCOL = 1 * MiB + 65536, WS_TPOS = 1 * MiB + 524288;
constexpr size_t WS_SK = 3 * MiB;
constexpr size_t WS_SSQ = 4 * MiB;
constexpr size_t WS_INVS = 5 * MiB;
constexpr size_t WS_WIN = 6 * MiB, WS_WOUT = 11 * MiB, WS_WQ = 13 * MiB;
constexpr size_t WS_UV8 = 32 * MiB;
constexpr int EROW = 1024;
constexpr size_t WS_SCL = 5 * MiB + 524288;
constexpr size_t WS_XN = 96 * MiB;
constexpr size_t WS_QKV = 128 * MiB;
constexpr size_t WS_AO = 200 * MiB;
constexpr size_t WS_META = 232 * MiB;
constexpr size_t WS_END = 248 * MiB;
constexpr int CW_TMO = 0, CW_CODE = 1, CW_BAR = 4096;

constexpr int RING_OFF = 0, RING_BYTES = 147456;
constexpr int LDSCTL_OFF = RING_BYTES, MISC_OFF = LDSCTL_OFF + 320;
constexpr int LDS_BYTES = RING_BYTES + 4096;
static_assert(attn_body::ATTN_LDS_BYTES <= RING_BYTES && pg8::STAGE_BYTES <= RING_BYTES, "LDS map");

#define GAS __attribute__((address_space(1)))
#define LAS __attribute__((address_space(3)))
typedef unsigned short bf16;
typedef unsigned v4u __attribute__((ext_vector_type(4)));
typedef unsigned v2u __attribute__((ext_vector_type(2)));
typedef float f32x4 __attribute__((ext_vector_type(4)));
typedef float f32x16 __attribute__((ext_vector_type(16)));
typedef short bf16x8 __attribute__((ext_vector_type(8)));
typedef __bf16 bf16x2_t __attribute__((ext_vector_type(2)));
typedef GAS unsigned gu32;
#define RLX_AGENT __ATOMIC_RELAXED, __HIP_MEMORY_SCOPE_AGENT
#define LDS_WAIT() asm volatile("s_waitcnt lgkmcnt(0)" ::: "memory")
#define VM_WAIT() asm volatile("s_waitcnt vmcnt(0)" ::: "memory")
__device__ __forceinline__ unsigned f2bf(float f) { unsigned u = __builtin_bit_cast(unsigned, f); return (u + 0x7fffu + ((u >> 16) & 1u)) >> 16; }
__device__ __forceinline__ unsigned pk2(float lo, float hi) { return f2bf(lo) | (f2bf(hi) << 16); }
#define XB_TMO      128
#define XB_XCNT(j)  (256  + 64 * (j))
#define XB_XSUB(j)  (1280 + 64 * (j))
#define XB_XGEN(j)  (2304 + 64 * (j))
#define XB_TOP      3328
#define XB_TOPGEN   3392
#define XCD_BAR_WORDS 3456
#define XB_SPIN_CAP (1u << 18)

__device__ __forceinline__ unsigned xb_ld(unsigned* p)              { return __hip_atomic_load(p, __ATOMIC_RELAXED, __HIP_MEMORY_SCOPE_AGENT); }
__device__ __forceinline__ unsigned xb_add(unsigned* p, unsigned v) { return __hip_atomic_fetch_add(p, v, __ATOMIC_RELAXED, __HIP_MEMORY_SCOPE_AGENT); }
__device__ __forceinline__ unsigned xb_xcc_id() { return (unsigned)__builtin_amdgcn_s_getreg((3 << 11) | 20) & 0xFu; }
#define XB_SPIN(cond, bar) do { unsigned _sp = 0; while (cond) { __builtin_amdgcn_s_sleep(1); \
    if ((++_sp & 255u) == 0u) { if (xb_ld(&(bar)[XB_TMO])) break; if (_sp > XB_SPIN_CAP) { atomicAdd(&(bar)[XB_TMO], 1u); break; } } } } while (0)

struct XcdBarrier {
    unsigned* bar; unsigned x;
    volatile LAS unsigned* st;
};

__device__ __forceinline__ XcdBarrier xcd_barrier_post(unsigned* bar, volatile LAS unsigned* st) {
    XcdBarrier b; b.bar = bar; b.x = xb_xcc_id(); b.st = st;
    if (threadIdx.x == 0) (void)xb_add(&bar[XB_XCNT(b.x)], 1u);
    return b;
}
__device__ __forceinline__ void xcd_barrier_complete(unsigned* bar, unsigned x, unsigned& nloc, unsigned& nx) {
    const unsigned G = gridDim.x * gridDim.y * gridDim.z;
    unsigned sum, cnt, mine, sp = 0u;
    for (;;) {
        sum = 0u; cnt = 0u; mine = 0u;
#pragma unroll
        for (unsigned j = 0; j < 16; ++j) { const unsigned c = xb_ld(&bar[XB_XCNT(j)]); sum += c; cnt += (c > 0u) ? 1u : 0u; mine = (j == x) ? c : mine; }
        if (sum == G) break;
        __builtin_amdgcn_s_sleep(1);
        if ((++sp & 255u) == 0u) { if (xb_ld(&bar[XB_TMO])) break; if (sp > XB_SPIN_CAP) { atomicAdd(&bar[XB_TMO], 1u); break; } }
    }
    nloc = mine > 0u ? mine : 1u; nx = cnt > 0u ? cnt : 1u;
}

__device__ __forceinline__ void xcd_barrier(const XcdBarrier& b) {
    asm volatile("s_waitcnt vmcnt(0)" ::: "memory");
    __syncthreads();
    if (threadIdx.x == 0) {
        unsigned* bar = b.bar;
        __builtin_amdgcn_s_waitcnt(0);
        unsigned nloc = b.st[0], nx = b.st[1];
        if (nloc == 0u) { xcd_barrier_complete(bar, b.x, nloc, nx); b.st[0] = nloc; b.st[1] = nx; }
        const unsigned old = xb_add(&bar[XB_XSUB(b.x)], 1u);
        const unsigned gen = old / nloc;
        if (old + 1u == (gen + 1u) * nloc) {
            __builtin_amdgcn_fence(__ATOMIC_RELEASE, "agent");
            asm volatile("s_waitcnt vmcnt(0)" ::: "memory");
            const unsigned og = xb_add(&bar[XB_TOP], 1u);
            const unsigned tg = og / nx;
            if (og + 1u == (tg + 1u) * nx) xb_add(&bar[XB_TOPGEN], 1u);
            else XB_SPIN(xb_ld(&bar[XB_TOPGEN]) == tg, bar);
            __builtin_amdgcn_fence(__ATOMIC_ACQUIRE, "agent");
            xb_add(&bar[XB_XGEN(b.x)], 1u);
            asm volatile("s_waitcnt vmcnt(0)" ::: "memory");
        } else {
            XB_SPIN(xb_ld(&bar[XB_XGEN(b.x)]) == gen, bar);
            __builtin_amdgcn_fence(__ATOMIC_ACQUIRE, "agent");
            asm volatile("s_waitcnt vmcnt(0)" ::: "memory");
        }
    }
    __syncthreads();
}
struct Frame {
    LAS unsigned char* lds;
    volatile LAS unsigned* MISC;
    gu32* ctl;
    int tid, lane, wave;
    int vcu, G;
};
struct Args { const float* in[17]; float* out; unsigned char* ws; double inv_ax[16]; double inv_p[8]; int ph_lo, ph_hi, li, pad; };

__device__ __forceinline__ float wave_sum(float v) {
#pragma unroll
    for (int o = 1; o < 64; o <<= 1) v += __shfl_xor(v, o);
    return v;
}
__host__ __device__ __forceinline__ int inproj_dst_col(int j) {
    const int s = j >> 6, d = j & 63; int bj, p;
    if (s < 10) { bj = d >> 5; p = 8 * ((d >> 2) & 3) + 4 * ((d >> 4) & 1) + (d & 3); }
    else if (s >= 12 && s < 28) { if (d < 32) { bj = 0; p = 8 * (2 * (d >> 4) + ((d >> 2) & 1)) + 4 * ((d >> 3) & 1) + (d & 3); } else { bj = 1; p = d - 32; } }
    else { bj = d >> 5; p = d & 31; }
    return (s >> 2) * 256 + bj * 128 + (s & 3) * 32 + p;
}
template <int MODE> __device__ __forceinline__ void p0_transpose_item(const float* W, int K, int N, bf16* WT, const float* kscale, LAS float* scr, int item, int lane) {
    const int nblk = N / 32, kb = item / nblk, nb = item % nblk, k0 = 64 * kb, n0 = 32 * nb;
    { f32x4 w[8];
#pragma unroll
      for (int i = 0; i < 8; ++i) w[i] = *(const GAS f32x4*)(W + (size_t)(k0 + (lane >> 3) + 8 * i) * N + n0 + 4 * (lane & 7));
#pragma unroll
      for (int i = 0; i < 8; ++i) { const int kk = (lane >> 3) + 8 * i; f32x4 v = w[i]; if (MODE == 2) v = v * kscale[k0 + kk];
          LAS float* d = scr + kk * 33 + 4 * (lane & 7); d[0] = v.x; d[1] = v.y; d[2] = v.z; d[3] = v.w; } }
    LDS_WAIT(); asm volatile("" ::: "memory");
    const int c = lane & 7;
#pragma unroll
    for (int j = 0; j < 4; ++j) { const int n = (lane >> 3) + 8 * j; const LAS float* s = scr + (8 * c) * 33 + n;
        v4u o; o.x = pk2(s[0 * 33], s[1 * 33]); o.y = pk2(s[2 * 33], s[3 * 33]); o.z = pk2(s[4 * 33], s[5 * 33]); o.w = pk2(s[6 * 33], s[7 * 33]);
        const int dr = (MODE == 1) ? inproj_dst_col(n0 + n) : (n0 + n);
        *(GAS v4u*)(WT + (size_t)dr * K + k0 + 8 * c) = o; }
    LDS_WAIT(); asm volatile("" ::: "memory");
}
template <bool NORM> __device__ __forceinline__ void p0_row_to_bf16(const float* src, bf16* dst, const float* cscale, int lane) {
    const GAS f32x4* xr = (const GAS f32x4*)src + lane;
    f32x4 v[4]; float s = 0.f;
#pragma unroll
    for (int j = 0; j < 4; ++j) { v[j] = xr[64 * j]; s += (v[j].x * v[j].x + v[j].y * v[j].y) + (v[j].z * v[j].z + v[j].w * v[j].w); }
    float rstd = 1.f;
    if (NORM) rstd = __builtin_amdgcn_rsqf(wave_sum(s) * (1.f / DM) + NORM_EPS);
    GAS unsigned long long* o8 = (GAS unsigned long long*)dst + lane;
#pragma unroll
    for (int j = 0; j < 4; ++j) { f32x4 w = v[j] * rstd; if (cscale) w = w * ((const GAS f32x4*)cscale)[lane + 64 * j];
        o8[64 * j] = (unsigned long long)pk2(w.x, w.y) | ((unsigned long long)pk2(w.z, w.w) << 32); }
}
__device__ __forceinline__ void sincos_rev(double ang, float& c, float& s) {
    double rev = ang * 0.15915494309189535; rev -= __builtin_rint(rev);
    const float r = (float)rev; c = __builtin_amdgcn_cosf(r); s = __builtin_amdgcn_sinf(r);
}
__device__ __forceinline__ float wave_max(float v) {
#pragma unroll
    for (int o = 1; o < 64; o <<= 1) v = __builtin_fmaxf(v, __shfl_xor(v, o));
    return v;
}
__device__ __forceinline__ float p0_row_to_fp8(const float* src, unsigned char* dst, const float* cscale, int lane) {
    const GAS f32x4* xr = (const GAS f32x4*)src + 4 * lane;
    f32x4 v[4]; float mx = 0.f;
#pragma unroll
    for (int j = 0; j < 4; ++j) { v[j] = xr[j]; if (cscale) v[j] = v[j] * ((const GAS f32x4*)cscale)[4 * lane + j];
        mx = __builtin_fmaxf(mx, __builtin_fmaxf(__builtin_fmaxf(__builtin_fabsf(v[j].x), __builtin_fabsf(v[j].y)), __builtin_fmaxf(__builtin_fabsf(v[j].z), __builtin_fabsf(v[j].w)))); }
    mx = wave_max(mx);
    const int ex = (int)((__float_as_uint(mx) >> 23) & 255u) - 126;
    const bool ok = mx > 1e-30f && mx < 1e30f;
    const float sc = ok ? __uint_as_float((unsigned)(127 + 8 - ex) << 23) : 1.f, isc = ok ? __uint_as_float((unsigned)(127 - 8 + ex) << 23) : 1.f;
    v4u o;
#pragma unroll
    for (int j = 0; j < 4; ++j) { const f32x4 w = v[j] * sc; int pk = __builtin_amdgcn_cvt_pk_fp8_f32(w.x, w.y, 0, false); pk = __builtin_amdgcn_cvt_pk_fp8_f32(w.z, w.w, pk, true); o[j] = (unsigned)pk; }
    *(GAS v4u*)(dst + 16 * lane) = o;
    return isc;
}
__device__ __forceinline__ float p0_row_to_fp4(const float* src, unsigned char* dst, const float* cscale, int lane) {
    const GAS f32x4* xr = (const GAS f32x4*)src + 4 * lane;
    f32x4 v[4]; float mx = 0.f;
#pragma unroll
    for (int j = 0; j < 4; ++j) { v[j] = xr[j]; if (cscale) v[j] = v[j] * ((const GAS f32x4*)cscale)[4 * lane + j];
        mx = __builtin_fmaxf(mx, __builtin_fmaxf(__builtin_fmaxf(__builtin_fabsf(v[j].x), __builtin_fabsf(v[j].y)), __builtin_fmaxf(__builtin_fabsf(v[j].z), __builtin_fabsf(v[j].w)))); }
    mx = wave_max(mx);
    const bool ok = mx > 1e-30f && mx < 1e30f;
    const float sc = ok ? 6.0f / mx : 1.f, isc = ok ? mx * (1.0f / 6.0f) : 1.f;
    unsigned d0 = 0u, d1 = 0u;
    { const f32x4 a = v[0] * sc, b = v[1] * sc, c = v[2] * sc, d = v[3] * sc;
      d0 = __builtin_amdgcn_cvt_scalef32_pk_fp4_f32(d0, a.x, a.y, 1.0f, 0); d0 = __builtin_amdgcn_cvt_scalef32_pk_fp4_f32(d0, a.z, a.w, 1.0f, 1);
      d0 = __builtin_amdgcn_cvt_scalef32_pk_fp4_f32(d0, b.x, b.y, 1.0f, 2); d0 = __builtin_amdgcn_cvt_scalef32_pk_fp4_f32(d0, b.z, b.w, 1.0f, 3);
      d1 = __builtin_amdgcn_cvt_scalef32_pk_fp4_f32(d1, c.x, c.y, 1.0f, 0); d1 = __builtin_amdgcn_cvt_scalef32_pk_fp4_f32(d1, c.z, c.w, 1.0f, 1);
      d1 = __builtin_amdgcn_cvt_scalef32_pk_fp4_f32(d1, d.x, d.y, 1.0f, 2); d1 = __builtin_amdgcn_cvt_scalef32_pk_fp4_f32(d1, d.z, d.w, 1.0f, 3); }
    *(GAS v2u*)(dst + 16 * lane) = (v2u){d0, d1};
    return isc;
}
__device__ __forceinline__ void p0_prologue(Frame& F, const Args& A) {
    unsigned char* ws = A.ws;
    LAS float* scr = (LAS float*)(F.lds + RING_OFF + F.wave * 16384);
    const int gw = F.vcu * NWAVES + F.wave, NGW = F.G * NWAVES;
    { float* tpos = (float*)(ws + WS_TPOS); float* trow = (float*)(ws + WS_TROW); float* tcol = (float*)(ws + WS_TCOL);
      const int gt = F.vcu * (NWAVES * 64) + F.tid, NTH = F.G * NWAVES * 64;
      for (int i = gt; i < M * 8; i += NTH) { const int pos = i >> 3, f = i & 7; float c, s; sincos_rev((double)pos * A.inv_p[f], c, s); tpos[pos * 16 + f] = c; tpos[pos * 16 + 8 + f] = s; }
      for (int i = gt; i < 256 * 16; i += NTH) { const int idx = i >> 4, f = i & 15; float c, s; sincos_rev((double)idx * A.inv_ax[f], c, s); trow[idx * 32 + f] = c; trow[idx * 32 + 16 + f] = s; }
      for (int i = gt; i < 64 * 16; i += NTH) { const int idx = i >> 4, f = i & 15; float c, s; sincos_rev((double)idx * A.inv_ax[f], c, s); tcol[idx * 32 + f] = c; tcol[idx * 32 + 16 + f] = s; }
      const float* sk = A.in[13]; unsigned* skb = (unsigned*)(ws + WS_SK);
      for (int i = gt; i < 8 * 2 * 128 * 128 / 2; i += NTH) skb[i] = pk2(sk[2 * i], sk[2 * i + 1]);
    }
    constexpr int I_IN = (DM / 64) * (NIN / 32);
    for (int it = gw; it < I_IN; it += NGW) p0_transpose_item<1>(A.in[2], DM, NIN, (bf16*)(ws + WS_WIN), nullptr, scr, it, F.lane);
    { f32x4 gsc[4];
#pragma unroll
      for (int j = 0; j < 4; ++j) gsc[j] = ((const GAS f32x4*)A.in[1])[F.lane + 64 * j];
      for (int m0 = gw; m0 < M; m0 += 4 * NGW) {
        f32x4 v[4][4]; float ss[4];
#pragma unroll
        for (int r = 0; r < 4; ++r) { const int m = (m0 + r * NGW < M) ? m0 + r * NGW : m0; const GAS f32x4* xr = (const GAS f32x4*)(A.in[0] + (size_t)m * DM) + F.lane;
#pragma unroll
            for (int j = 0; j < 4; ++j) v[r][j] = xr[64 * j]; }
#pragma unroll
        for (int r = 0; r < 4; ++r) { float s_ = 0.f;
#pragma unroll
            for (int j = 0; j < 4; ++j) s_ += (v[r][j].x * v[r][j].x + v[r][j].y * v[r][j].y) + (v[r][j].z * v[r][j].z + v[r][j].w * v[r][j].w);
            ss[r] = __builtin_amdgcn_rsqf(wave_sum(s_) * (1.f / DM) + NORM_EPS); }
#pragma unroll
        for (int r = 0; r < 4; ++r) { const int m = m0 + r * NGW; if (m < M) { GAS unsigned long long* o8 = (GAS unsigned long long*)((bf16*)(ws + WS_XN) + (size_t)m * DM) + F.lane;
#pragma unroll
            for (int j = 0; j < 4; ++j) { const f32x4 w = v[r][j] * ss[r] * gsc[j]; o8[64 * j] = (unsigned long long)pk2(w.x, w.y) | ((unsigned long long)pk2(w.z, w.w) << 32); } } }
      } }
}
__device__ __forceinline__ void p0_lazy(Frame& F, const Args& A, int gw, int NGW) {
    unsigned char* ws = A.ws;
    LAS float* scr = (LAS float*)(F.lds + RING_OFF + F.wave * 16384);
    constexpr int I_OUT = (DM / 64) * (DM / 32), I_Q = (DM / 64) * (NQ / 32);
    for (int it = gw; it < I_OUT + I_Q; it += NGW) {
        if (it < I_OUT) p0_transpose_item<0>(A.in[10], DM, DM, (bf16*)(ws + WS_WOUT), nullptr, scr, it, F.lane);
        else p0_transpose_item<2>(A.in[12], DM, NQ, (bf16*)(ws + WS_WQ), A.in[11], scr, it - I_OUT, F.lane);
    }
    for (int m = gw; m < NEXP; m += NGW) {
        const float iu = p0_row_to_fp4(A.in[14] + (size_t)m * DM, ws + WS_UV8 + (size_t)m * EROW, A.in[11], F.lane);
        const float iv = p0_row_to_fp4(A.in[15] + (size_t)m * DM, ws + WS_UV8 + (size_t)m * EROW + 8, nullptr, F.lane);
        if (F.lane == 0) { float* sc = (float*)(ws + WS_SCL) + 2 * m; sc[0] = iu; sc[1] = iv; }
    }
}

__device__ __forceinline__ void topk_insert(float (&L)[16], float c) {
#pragma unroll
    for (int j = 15; j >= 1; --j) L[j] = __builtin_amdgcn_fmed3f(L[j - 1], L[j], c);
    L[0] = __builtin_fmaxf(L[0], c);
}
__device__ __forceinline__ void cex(float& a, float& b) { const float hi = __builtin_amdgcn_fmed3f(a, b, INFINITY), lo = __builtin_amdgcn_fmed3f(a, b, -INFINITY); a = hi; b = lo; }
__device__ __forceinline__ void sort16_desc(float (&v)[16]) {
    constexpr unsigned char P[60][2] = {{0,13},{1,12},{2,15},{3,14},{4,8},{5,6},{7,11},{9,10},{0,5},{1,7},{2,9},{3,4},{6,13},{8,14},{10,15},{11,12},{0,1},{2,3},{4,5},{6,8},{7,9},{10,11},{12,13},{14,15},
        {0,2},{1,3},{4,10},{5,11},{6,7},{8,9},{12,14},{13,15},{1,2},{3,12},{4,6},{5,7},{8,10},{9,11},{13,14},{1,4},{2,6},{5,8},{7,10},{9,13},{11,14},{2,4},{3,6},{9,12},{11,13},{3,5},{6,8},{7,9},{10,12},
        {3,4},{5,6},{7,8},{9,10},{11,12},{6,7},{8,9}};
#pragma unroll
    for (int k = 0; k < 60; ++k) cex(v[P[k][0]], v[P[k][1]]);
}
__device__ __forceinline__ void merge_top16(float (&a)[16], const float (&b)[16]) {
#pragma unroll
    for (int i = 0; i < 16; ++i) a[i] = __builtin_amdgcn_fmed3f(a[i], b[15 - i], INFINITY);
#pragma unroll
    for (int st = 8; st >= 1; st >>= 1)
#pragma unroll
        for (int i = 0; i < 16; ++i) if ((i & st) == 0) cex(a[i], a[i + st]);
}
__device__ __forceinline__ void p5_topk(Frame& F, const Args& A) {
    unsigned char* ws = A.ws;
    const bf16* QP = (const bf16*)(ws + WS_QKV); const bf16* SK = (const bf16*)(ws + WS_SK); const float* SSQ = (const float*)(ws + WS_SSQ);
    v2u* META = (v2u*)(ws + WS_META); float* INVS = (float*)(ws + WS_INVS);
    const int lane = F.lane, r32 = lane & 31, hi = lane >> 5;
    const int cpg = F.G / 8, h = F.vcu / cpg, cg = F.vcu % cpg;
    { const v4u* src = (const v4u*)(SK + (size_t)h * 2 * 128 * 128);
      for (int i = F.tid; i < 2 * 128 * 16; i += NWAVES * 64) { const int p = i >> 11, key = (i >> 4) & 127, c = i & 15;
          *(LAS v4u*)(F.lds + RING_OFF + (((p * 8 + (c >> 1)) * 2 + (c & 1)) * 2048 + key * 16)) = src[i]; }
      LDS_WAIT(); __syncthreads(); }
    const LAS unsigned char* ska = F.lds + RING_OFF + hi * 2048 + r32 * 16;
    for (int g = cg * NWAVES + F.wave; g < M / 32; g += cpg * NWAVES) {
        const int t = g * 32 + r32;
        const bf16* qp = QP + (size_t)t * NQ + h * 256 + 8 * hi;
        float ss = 0.f;
#pragma unroll
        for (int i = 0; i < 16; ++i) ss += SSQ[(size_t)i * M + t];
        const float rstd = __builtin_amdgcn_rsqf(ss * (1.f / DM) + NORM_EPS);
        float m0[16], m1[16];
#pragma unroll
        for (int p = 0; p < 2; ++p) {
            f32x16 acc[4];
#pragma unroll
            for (int b = 0; b < 4; ++b) acc[b] = f32x16{};
            bf16x8 bq[8];
#pragma unroll
            for (int s = 0; s < 8; ++s) bq[s] = *(const bf16x8*)(qp + p * 128 + 16 * s);
#pragma unroll
            for (int s = 0; s < 8; ++s) {
#pragma unroll
                for (int b = 0; b < 4; ++b) { const bf16x8 ak = *(const LAS bf16x8*)(ska + (p * 8 + s) * 4096 + b * 512); acc[b] = __builtin_amdgcn_mfma_f32_32x32x16_bf16(ak, bq[s], acc[b], 0, 0, 0); }
                if (s & 1) __builtin_amdgcn_sched_barrier(0); }
            float L[16], G[16];
#pragma unroll
            for (int b = 0; b < 4; ++b) {
#pragma unroll
                for (int r = 0; r < 16; ++r) G[r] = __uint_as_float((__float_as_uint(acc[b][r]) & ~127u) | (unsigned)(b * 32 + (r & 3) + 8 * (r >> 2)));
                sort16_desc(G);
                if (b == 0) {
#pragma unroll
                    for (int r = 0; r < 16; ++r) L[r] = G[r];
                } else merge_top16(L, G);
            }
            { const unsigned hi4 = 4u * hi;
#pragma unroll
              for (int j = 0; j < 16; ++j) L[j] = __uint_as_float(__float_as_uint(L[j]) | hi4); }
            float O[16];
#pragma unroll
            for (int j = 0; j < 16; ++j) O[j] = __shfl_xor(L[j], 32);
            merge_top16(L, O);
#pragma unroll
            for (int j = 0; j < 16; ++j) { if (p == 0) m0[j] = L[j]; else m1[j] = L[j]; }
        }
        float T[16];
#pragma unroll
        for (int j = 0; j < 16; ++j) T[j] = -INFINITY;
#pragma unroll
        for (int a = 0; a < 16; ++a)
#pragma unroll
            for (int b = 0; b < 16; ++b) if ((a + 1) * (b + 1) <= 16) { const float v = m0[a] + m1[b]; const unsigned key = (__float_as_uint(v) & ~255u) | (unsigned)(a * 16 + b); topk_insert(T, __uint_as_float(key)); }
        const float thr = T[15], ref = T[0];
        int cnt = 0; float sum = 0.f; const float kk = rstd * 1.4426950408889634f;
        LAS v2u* mst = (LAS v2u*)(F.lds + RING_OFF + 65536 + F.wave * 4096);
        LAS v2u* meta = mst + r32 * 16;
#pragma unroll
        for (int a = 0; a < 16; ++a)
#pragma unroll
            for (int b = 0; b < 16; ++b) if ((a + 1) * (b + 1) <= 16) { const float v = m0[a] + m1[b]; const unsigned key = (__float_as_uint(v) & ~255u) | (unsigned)(a * 16 + b);
                if (__uint_as_float(key) >= thr) { const unsigned idx = ((__float_as_uint(m0[a]) & 127u) << 7) | (__float_as_uint(m1[b]) & 127u);
                    const float e = __builtin_amdgcn_exp2f((v - ref) * kk); if (hi == 0 && cnt < 16) meta[cnt] = (v2u){idx, __float_as_uint(e)}; sum += e; ++cnt; } }
        if (hi == 0) INVS[(size_t)t * 8 + h] = 1.0f / sum;
        LDS_WAIT(); asm volatile("" ::: "memory");
#pragma unroll
        for (int i = 0; i < 4; ++i) { const int ch = i * 64 + lane, tok = ch >> 3, c8 = ch & 7;
            const v4u val = *(const LAS v4u*)((const LAS unsigned char*)mst + tok * 128 + c8 * 16);
            *(v4u*)((unsigned char*)(META + ((size_t)(g * 32 + tok) * 8 + h) * 16) + c8 * 16) = val; }
        LDS_WAIT(); asm volatile("" ::: "memory");
    }
    __syncthreads();
}

typedef float f32x2v __attribute__((ext_vector_type(2)));
__device__ __forceinline__ float dot16_fp8(const v4u r, const f32x2v (&xp)[8]) {
    f32x2v a = {0.f, 0.f};
    const unsigned w[4] = {r.x, r.y, r.z, r.w};
#pragma unroll
    for (int c = 0; c < 4; ++c) { a = __builtin_amdgcn_cvt_pk_f32_fp8((int)w[c], false) * xp[2 * c] + a; a = __builtin_amdgcn_cvt_pk_f32_fp8((int)w[c], true) * xp[2 * c + 1] + a; }
    return a.x + a.y;
}
__device__ __forceinline__ void axpy16_fp8(f32x2v (&acc)[8], const v4u r, float wj) {
    const f32x2v ww = {wj, wj};
    const unsigned w[4] = {r.x, r.y, r.z, r.w};
#pragma unroll
    for (int c = 0; c < 4; ++c) { acc[2 * c] = __builtin_amdgcn_cvt_pk_f32_fp8((int)w[c], false) * ww + acc[2 * c]; acc[2 * c + 1] = __builtin_amdgcn_cvt_pk_f32_fp8((int)w[c], true) * ww + acc[2 * c + 1]; }
}
__device__ __forceinline__ void axpy16_fp4(f32x2v (&acc)[8], const v2u r, float wj) {
    const f32x2v ww = {wj, wj};
    const unsigned d0 = r.x, d1 = r.y;
    acc[0] = __builtin_amdgcn_cvt_scalef32_pk_f32_fp4(d0, 1.0f, 0) * ww + acc[0]; acc[1] = __builtin_amdgcn_cvt_scalef32_pk_f32_fp4(d0, 1.0f, 1) * ww + acc[1];
    acc[2] = __builtin_amdgcn_cvt_scalef32_pk_f32_fp4(d0, 1.0f, 2) * ww + acc[2]; acc[3] = __builtin_amdgcn_cvt_scalef32_pk_f32_fp4(d0, 1.0f, 3) * ww + acc[3];
    acc[4] = __builtin_amdgcn_cvt_scalef32_pk_f32_fp4(d1, 1.0f, 0) * ww + acc[4]; acc[5] = __builtin_amdgcn_cvt_scalef32_pk_f32_fp4(d1, 1.0f, 1) * ww + acc[5];
    acc[6] = __builtin_amdgcn_cvt_scalef32_pk_f32_fp4(d1, 1.0f, 2) * ww + acc[6]; acc[7] = __builtin_amdgcn_cvt_scalef32_pk_f32_fp4(d1, 1.0f, 3) * ww + acc[7];
}
__device__ __forceinline__ float dot16_fp4(unsigned d0, unsigned d1, const f32x2v (&xp)[8]) {
    f32x2v a = __builtin_amdgcn_cvt_scalef32_pk_f32_fp4(d0, 1.0f, 0) * xp[0];
    a = __builtin_amdgcn_cvt_scalef32_pk_f32_fp4(d0, 1.0f, 1) * xp[1] + a; a = __builtin_amdgcn_cvt_scalef32_pk_f32_fp4(d0, 1.0f, 2) * xp[2] + a; a = __builtin_amdgcn_cvt_scalef32_pk_f32_fp4(d0, 1.0f, 3) * xp[3] + a;
    a = __builtin_amdgcn_cvt_scalef32_pk_f32_fp4(d1, 1.0f, 0) * xp[4] + a; a = __builtin_amdgcn_cvt_scalef32_pk_f32_fp4(d1, 1.0f, 1) * xp[5] + a;
    a = __builtin_amdgcn_cvt_scalef32_pk_f32_fp4(d1, 1.0f, 2) * xp[6] + a; a = __builtin_amdgcn_cvt_scalef32_pk_f32_fp4(d1, 1.0f, 3) * xp[7] + a;
    return a.x + a.y;
}
__device__ __forceinline__ void p6_experts(Frame& F, const Args& A) {
    unsigned char* ws = A.ws;
    const bf16* H1B = (const bf16*)(ws + WS_XN); const unsigned char* UV = ws + WS_UV8; const f32x2v* SCL = (const f32x2v*)(ws + WS_SCL);
    const float* SSQ = (const float*)(ws + WS_SSQ); const v2u* META = (const v2u*)(ws + WS_META); const float* INVS = (const float*)(ws + WS_INVS);
    const float* gfin = A.in[16]; float* out = A.out;
    const int lane = F.lane;
    const int gw = F.vcu * NWAVES + F.wave, NGW = F.G * NWAVES;
    for (int t = gw; t < M; t += NGW) {
        const float ssl = lane < 16 ? SSQ[(size_t)lane * M + t] : 0.f;
        const float rstd = __builtin_amdgcn_rsqf(wave_sum(ssl) * (1.f / DM) + NORM_EPS);
        f32x2v xp[8];
        { const v4u* xr = (const v4u*)(H1B + (size_t)t * DM) + 2 * lane; const v4u x0 = __builtin_nontemporal_load(xr), x1 = __builtin_nontemporal_load(xr + 1);
          const unsigned xw[8] = {x0.x, x0.y, x0.z, x0.w, x1.x, x1.y, x1.z, x1.w};
#pragma unroll
          for (int i = 0; i < 8; ++i) xp[i] = (f32x2v){__uint_as_float(xw[i] << 16), __uint_as_float(xw[i] & 0xffff0000u)}; }
        f32x2v acc[8];
#pragma unroll
        for (int i = 0; i < 8; ++i) acc[i] = (f32x2v){0.f, 0.f};
#pragma unroll 1
        for (int b = 0; b < 4; ++b) {
            const v2u me = __builtin_nontemporal_load(&META[(size_t)t * 128 + b * 32 + (lane & 31)]); const unsigned idx = me.x; const float e = __uint_as_float(me.y);
            const float invs = INVS[(size_t)t * 8 + b * 2 + ((lane >> 4) & 1)];
            const f32x2v isc = SCL[idx];
            v4u r[32]; float p[32];
#pragma unroll
            for (int j = 0; j < 32; ++j) { const unsigned ei = __builtin_amdgcn_readlane(idx, j); r[j] = ((const v4u*)(UV + (size_t)ei * EROW))[lane]; }
#pragma unroll
            for (int j = 0; j < 32; ++j) p[j] = dot16_fp4(r[j].x, r[j].y, xp);
#pragma unroll
            for (int n = 16; n >= 1; n >>= 1) {
                const bool up = (lane & n) != 0;
#pragma unroll
                for (int i = 0; i < n; ++i) { const float send = up ? p[i] : p[i + n], keep = up ? p[i + n] : p[i]; p[i] = keep + __shfl_xor(send, n); }
            }
            const float d = p[0] + __shfl_xor(p[0], 32);
            const float z = d * rstd * isc.x;
            const float a = 0.5f * z * (1.0f + erff(z * 0.70710678118654752f));
            const float w = e * invs * a * isc.y;
#pragma unroll
            for (int j = 0; j < 32; ++j) axpy16_fp4(acc, (v2u){r[j].z, r[j].w}, __uint_as_float(__builtin_amdgcn_readlane(__float_as_uint(w), j)));
        }
        float* hrow = out + (size_t)t * DM + 16 * lane;
        f32x4 h[4]; float s2 = 0.f;
#pragma unroll
        for (int i = 0; i < 4; ++i) { h[i] = (f32x4){xp[2 * i].x, xp[2 * i].y, xp[2 * i + 1].x, xp[2 * i + 1].y} + (f32x4){acc[2 * i].x, acc[2 * i].y, acc[2 * i + 1].x, acc[2 * i + 1].y};
            s2 += (h[i].x * h[i].x + h[i].y * h[i].y) + (h[i].z * h[i].z + h[i].w * h[i].w); }
        const float rf = __builtin_amdgcn_rsqf(wave_sum(s2) * (1.f / DM) + NORM_EPS);
#pragma unroll
        for (int i = 0; i < 4; ++i) __builtin_nontemporal_store(h[i] * rf * *(const f32x4*)(gfin + 16 * lane + 4 * i), (f32x4*)(hrow + 4 * i));
    }
}

__global__ void __launch_bounds__(NWAVES * 64, 2) fwd_kernel(Args args) {
    extern __shared__ __attribute__((aligned(16))) unsigned char lds[];
    Frame F;
    F.lds = (LAS unsigned char*)lds;
    F.MISC = (volatile LAS unsigned*)(F.lds + MISC_OFF);
    F.tid = threadIdx.x; F.lane = F.tid & 63; F.wave = __builtin_amdgcn_readfirstlane(F.tid >> 6);
    F.G = gridDim.x; { const int bx = blockIdx.x; F.vcu = (F.G % 8 == 0) ? (bx % 8) * (F.G / 8) + bx / 8 : bx; }
    unsigned char* ws = args.ws;
    F.ctl = (gu32*)(ws + WS_CTL);
    for (int u = F.tid; u < (LDS_BYTES - LDSCTL_OFF) / 4; u += NWAVES * 64) ((LAS unsigned*)(F.lds + LDSCTL_OFF))[u] = 0u;
    __syncthreads();
    XcdBarrier bar; bar.bar = (unsigned*)(F.ctl + CW_BAR); bar.x = 0; bar.st = nullptr;
    if (N_LAUNCHES != PER_PHASE) bar = xcd_barrier_post((unsigned*)(F.ctl + CW_BAR), F.MISC + 8);
#define GRID_BAR() do { if (N_LAUNCHES != PER_PHASE) xcd_barrier(bar); } while (0)
    const int lo = args.ph_lo, hi = args.ph_hi;
#ifndef PH_MASK
#define PH_MASK 0x7f
#endif
#define IN(k) (((PH_MASK >> (k)) & 1) && lo <= (k) && (k) < hi)
#define BOTH(k) (IN(k) && IN((k) + 1))

    if (IN(0)) { p0_prologue(F, args); if (BOTH(0)) GRID_BAR(); }

    if (IN(1)) {
        pg8::Gemm g{(const pg8::bf16_t*)(ws + WS_XN), (const pg8::bf16_t*)(ws + WS_WIN), M, NIN, DM}; pg8::StaticOrder S; S.init(M, NIN, F.G, (int)blockIdx.x);
        pg8::EpiInProj E{(pg8::bf16_t*)(ws + WS_QKV), args.in[3], args.in[4], (const float*)(ws + WS_TROW), (const float*)(ws + WS_TCOL), (const float*)(ws + WS_TPOS), C2, (unsigned*)(ws + WS_CTL) + 65536};
        pg8::gemm_phase<pg8::EpiInProj, pg8::StaticOrder, true, true>(F.lds + RING_OFF, g, S, E);
        { const int nfull = (M / 256) * (NIN / 256) % F.G;
          if (nfull == 0) p0_lazy(F, args, F.vcu * NWAVES + F.wave, F.G * NWAVES);
          else if ((int)blockIdx.x >= nfull) p0_lazy(F, args, ((int)blockIdx.x - nfull) * NWAVES + F.wave, (F.G - nfull) * NWAVES); }
        if (BOTH(1)) GRID_BAR();
    }

    if (IN(2)) {
        using abf = attn_body::bf16;
        const abf* planes = (const abf*)(ws + WS_QKV); abf* AO = (abf*)(ws + WS_AO);
        constexpr size_t PL = (size_t)M * 64;
        const __amdgpu_buffer_rsrc_t srd = __builtin_amdgcn_make_buffer_rsrc((void*)(ws + WS_QKV), (short)0, (int)(36 * PL * 2), 0x00020000);
#ifndef NO_A
        const float mub = C2 * 64.0f * 1.02f * wave_max(__builtin_fabsf(args.in[3][F.lane])) * wave_max(__builtin_fabsf(args.in[4][F.lane]));
        const bool sbound = mub < 60.0f;
        for (int ua = F.vcu * 2; ua < 512; ua += F.G * 2)
            for (int k = 0; k < 2; ++k) { const int hA = (ua + k) >> 6, qb = (ua + k) & 63;
                attn_body::attn_unit_a<8>(qb, planes + (size_t)hA * PL, srd, (unsigned)((8 + (hA >> 2)) * PL * 2), (unsigned)((10 + (hA >> 2)) * PL * 2), AO + hA * 64, (char*)lds + RING_OFF, sbound ? mub : 0.f, sbound); }
#endif
        const float d1 = wave_sum(args.in[5][F.lane] * args.in[6][F.lane]), d2 = wave_sum(args.in[7][F.lane] * args.in[8][F.lane]);
        const float lam = __expf(d1) - __expf(d2) + 0.2f;
        float* sc = (float*)(ws + WS_XN) + (size_t)F.vcu * (NWAVES * 4096);
#ifndef NO_B
        for (int ub = F.vcu; ub < 256; ub += F.G) { const int hB = ub >> 6, qb = ub & 63;
            for (int comp = 0; comp < 2; ++comp) {
                const unsigned* nmax = (const unsigned*)(ws + WS_CTL) + 65536;
                const float mb = 1.02f * __builtin_sqrtf(__uint_as_float(nmax[12 + 2 * hB + comp]) * __uint_as_float(nmax[20 + 2 * hB + comp]));
                const bool sb = mb < 60.0f;
                attn_body::attn_unit_b<8>(qb, comp, planes + (size_t)(12 + 2 * hB + comp) * PL, srd, (unsigned)((20 + 2 * hB + comp) * PL * 2), (unsigned)((28 + 2 * hB) * PL * 2),
                                          sc, lam, args.in[9], AO + 512 + hB * 128, (char*)lds + RING_OFF, sb ? mb : 0.f, sb); } }
#endif
        if (BOTH(2)) GRID_BAR();
    }

    if (IN(3)) {
        pg8::Gemm g{(const pg8::bf16_t*)(ws + WS_AO), (const pg8::bf16_t*)(ws + WS_WOUT), M, DM, DM}; pg8::StaticOrder S; S.init(M, DM, F.G, (int)blockIdx.x);
        pg8::EpiOutProj E{args.in[0], args.out, (pg8::bf16_t*)(ws + WS_XN), (float*)(ws + WS_SSQ)};
        pg8::gemm_phase<pg8::EpiOutProj, pg8::StaticOrder, true, true>(F.lds + RING_OFF, g, S, E);
        if (BOTH(3)) GRID_BAR();
    }

    if (IN(4)) {
        pg8::Gemm g{(const pg8::bf16_t*)(ws + WS_XN), (const pg8::bf16_t*)(ws + WS_WQ), M, NQ, DM}; pg8::StaticOrder S; S.init(M, NQ, F.G, (int)blockIdx.x);
        pg8::EpiBf16 E{(pg8::bf16_t*)(ws + WS_QKV), NQ};
        pg8::gemm_phase<pg8::EpiBf16, pg8::StaticOrder, true, true>(F.lds + RING_OFF, g, S, E);
        if (BOTH(4)) GRID_BAR();
    }

    if (IN(5)) { p5_topk(F, args); if (BOTH(5)) GRID_BAR(); }

    if (IN(6)) { p6_experts(F, args); }
#undef IN
#undef BOTH
#undef GRID_BAR
}

extern "C" void kernel_launch(void* const* d_in, const int* in_sizes, int n_in, void* d_out, int out_size, void* d_ws, size_t ws_size, hipStream_t stream) {
    static int grid = 0;
    if (grid == 0) {
        if (n_in != 17 || in_sizes[0] != M * DM || out_size != M * DM || ws_size < WS_END) { fprintf(stderr, "kernel_launch: unexpected shapes (n_in %d, in0 %d, out %d, ws %zu); nothing launched\n", n_in, n_in > 0 ? in_sizes[0] : -1, out_size, ws_size); grid = -1; return; }
        int dev = 0, cus = 0, per_cu = 0;
        if (hipGetDevice(&dev) != hipSuccess || hipDeviceGetAttribute(&cus, hipDeviceAttributeMultiprocessorCount, dev) != hipSuccess) { fprintf(stderr, "kernel_launch: device query failed\n"); grid = -1; return; }
        if (hipFuncSetAttribute((const void*)fwd_kernel, hipFuncAttributeMaxDynamicSharedMemorySize, LDS_BYTES) != hipSuccess) { fprintf(stderr, "kernel_launch: hipFuncSetAttribute failed\n"); grid = -1; return; }
        if (hipOccupancyMaxActiveBlocksPerMultiprocessor(&per_cu, (const void*)fwd_kernel, NWAVES * 64, LDS_BYTES) != hipSuccess || per_cu < 1)
            fprintf(stderr, "kernel_launch: note: occupancy query reports %d workgroups per CU\n", per_cu);
        (void)hipGetLastError();
        grid = cus;
        if (grid != 256) { fprintf(stderr, "kernel_launch: built for a 256-CU device, found %d CUs; nothing launched\n", cus); grid = -1; return; }
    }
    if (grid < 0) return;
    if (hipMemsetAsync((char*)d_ws + WS_CTL, 0, CTL_ZERO_BYTES, stream) != hipSuccess) { fprintf(stderr, "kernel_launch: hipMemsetAsync failed\n"); return; }
    Args a{};
    for (int i = 0; i < 17; ++i) a.in[i] = (const float*)d_in[i];
    a.out = (float*)d_out; a.ws = (unsigned char*)d_ws;
    for (int i = 0; i < 16; ++i) a.inv_ax[i] = pow(10000.0, -(2.0 * i) / 32.0);
    for (int i = 0; i < 8; ++i) a.inv_p[i] = pow(500000.0, -(2.0 * i) / 16.0);
#ifdef PHASE_LIST
    static const int plist[] = {PHASE_LIST}; constexpr int NL = sizeof(plist) / sizeof(int);
#else
    constexpr int NL = N_LAUNCHES;
#endif
    for (int li = 0; li < NL; ++li) {
#ifdef PHASE_LIST
        a.ph_lo = plist[li]; a.ph_hi = plist[li] + 1; a.li = li;
#else
        a.ph_lo = (N_LAUNCHES == PER_PHASE) ? li : 0; a.ph_hi = (N_LAUNCHES == PER_PHASE) ? li + 1 : PER_PHASE; a.li = li;
#endif
        hipLaunchKernelGGL(fwd_kernel, dim3(grid), dim3(NWAVES * 64), LDS_BYTES, stream, a);
        const hipError_t le = hipPeekAtLastError();
        if (le != hipSuccess) { fprintf(stderr, "kernel_launch: launch %d failed: %s\n", li, hipGetErrorName(le)); break; }
    }
}
```

```cpp
#include <hip/hip_runtime.h>
#include <hip/hip_bf16.h>
#include <cstdio>
#include <cstdint>
#include <cmath>
namespace pg8 {
#define PG8_LAS __attribute__((address_space(3)))
typedef unsigned short bf16_t;
typedef short bf16x8 __attribute__((ext_vector_type(8)));
typedef float f32x4 __attribute__((ext_vector_type(4)));
typedef unsigned u32x4 __attribute__((ext_vector_type(4)));
constexpr int BM = 256, BK = 64, HALF = 128, HTB = HALF * BK * 2  , STAGE_BYTES = 8 * HTB, NXCD = 8, WGM = 8;

__host__ __device__ __forceinline__ int lds_byte(int r, int c) { const int st = (r >> 4) * 2 + (c >> 5), rr = r & 15, cc = c & 31, ob = rr * 64 + cc * 2; return st * 1024 + (ob ^ (((ob >> 9) & 1) << 5)); }
__host__ __device__ __forceinline__ void stage_rc(int b, int& R, int& C) { const int st = b / 1024, sb = b % 1024, swz = sb ^ (((sb >> 9) & 1) << 5); R = (st >> 1) * 16 + swz / 64; C = (st & 1) * 32 + (swz % 64) / 2; }
__host__ __device__ __forceinline__ int perm32(int rho) { const int n = rho >> 4, i = rho & 15; return 8 * (i >> 2) + 4 * n + (i & 3); }

struct Unit { int pm, pn; };
struct Gemm { const bf16_t* A; const bf16_t* Bt; int M, N, K; };

struct StaticOrder {
    int nM, nN, nwg, G, c;
    __host__ __device__ void init(int M, int N, int G_, int c_) { nM = M / BM; nN = N / BM; nwg = nM * nN; G = G_; c = c_; }
    __host__ __device__ bool next(int i, Unit& u) const {
        const long L = (long)i * G + c; if (L >= nwg) return false;
        int wgid = (int)L; { const int q = nwg / NXCD, r = nwg % NXCD, xcd = wgid % NXCD, off = wgid / NXCD; wgid = (xcd < r ? xcd * (q + 1) : r * (q + 1) + (xcd - r) * q) + off; }
        const int nig = WGM * nN, gid = wgid / nig, fm = gid * WGM, gsz = (nM - fm) < WGM ? (nM - fm) : WGM;
        u.pm = fm + ((wgid % nig) % gsz); u.pn = (wgid % nig) / gsz; return true;
    }
    __device__ __forceinline__ void a_ready(const Unit&) const {}
    __device__ __forceinline__ void done(const Unit&) const {}
};

__device__ __forceinline__ unsigned cvt_pk_bf16(float lo, float hi) { unsigned r; asm volatile("v_cvt_pk_bf16_f32 %0, %1, %2" : "=v"(r) : "v"(lo), "v"(hi)); return r; }
typedef float f32x2 __attribute__((ext_vector_type(2)));
typedef unsigned u32x2 __attribute__((ext_vector_type(2)));

struct EpiBf16 {
    static constexpr bool PERM = true, AFTER_DRAIN = false;
    bf16_t* O; int ldc;
    __device__ __forceinline__ void operator()(const f32x4 (&acc)[2][2][4][2], const Unit& u, int wr, int wc, int fr, int fq) const {
        const int row0 = u.pm * BM + wr * 64 + fr; const int col0 = u.pn * BM + wc * 32 + 8 * fq;
#pragma unroll
        for (int ai = 0; ai < 2; ++ai)
#pragma unroll
            for (int m = 0; m < 4; ++m) { bf16_t* rowp = O + (size_t)(row0 + ai * HALF + m * 16) * ldc + col0;
#pragma unroll
                for (int bj = 0; bj < 2; ++bj) { const f32x4 v0 = acc[ai][bj][m][0], v1 = acc[ai][bj][m][1];
                    u32x4 w; w.x = cvt_pk_bf16(v0[0], v0[1]); w.y = cvt_pk_bf16(v0[2], v0[3]); w.z = cvt_pk_bf16(v1[0], v1[1]); w.w = cvt_pk_bf16(v1[2], v1[3]);
                    *(u32x4*)(rowp + bj * HALF) = w; } }
    }
};

struct EpiInProj {
    static constexpr bool PERM = true, AFTER_DRAIN = false;
    bf16_t* planes; const float* qg; const float* kg; const float* trow; const float* tcol; const float* tpos; float c2; unsigned* nmax;
    __device__ __forceinline__ void operator()(const f32x4 (&acc)[2][2][4][2], const Unit& u, int wr, int wc, int fr, int fq) const {
        const int slot = u.pn * 4 + wc;
        bf16_t* plane = planes + (size_t)slot * (16384 * 64);
        const int rowb = u.pm * BM + wr * 64 + fr;
        if (slot < 10) {
            const float* g = slot < 8 ? qg : kg; const float sc = slot < 8 ? c2 : 1.f;
            f32x4 gv[2][2];
#pragma unroll
            for (int bj = 0; bj < 2; ++bj)
#pragma unroll
                for (int n = 0; n < 2; ++n) gv[bj][n] = *(const f32x4*)(g + 32 * bj + 16 * n + 4 * fq);
#pragma unroll
            for (int ai = 0; ai < 2; ++ai)
#pragma unroll
                for (int m = 0; m < 4; ++m) { const int row = rowb + ai * HALF + m * 16;
                    float ss = 0.f;
#pragma unroll
                    for (int bj = 0; bj < 2; ++bj)
#pragma unroll
                        for (int n = 0; n < 2; ++n) { const f32x4 x = acc[ai][bj][m][n]; ss += (x[0] * x[0] + x[1] * x[1]) + (x[2] * x[2] + x[3] * x[3]); }
                    ss += __shfl_xor(ss, 16); ss += __shfl_xor(ss, 32);
                    const float rn = __builtin_amdgcn_rsqf(ss * (1.0f / 64.0f) + 1e-6f);
                    const float* tr = trow + (row >> 6) * 32 + 4 * fq; const float* tc = tcol + (row & 63) * 32 + 4 * fq;
#pragma unroll
                    for (int bj = 0; bj < 2; ++bj) { const float* tb = bj ? tc : tr; const f32x4 c = *(const f32x4*)tb, s = *(const f32x4*)(tb + 16);
                        const f32x4 y0 = acc[ai][bj][m][0] * rn * gv[bj][0], y1 = acc[ai][bj][m][1] * rn * gv[bj][1];
                        const f32x4 o0 = (y0 * c - y1 * s) * sc, o1 = (y1 * c + y0 * s) * sc;
                        u32x4 w; w.x = cvt_pk_bf16(o0[0], o0[1]); w.y = cvt_pk_bf16(o0[2], o0[3]); w.z = cvt_pk_bf16(o1[0], o1[1]); w.w = cvt_pk_bf16(o1[2], o1[3]);
                        *(u32x4*)(plane + (size_t)row * 64 + 32 * bj + 8 * fq) = w; } }
        } else if (slot >= 12 && slot < 28) {
            const float sc = slot < 20 ? c2 : 1.f; const bool rot = fq < 2; float nm = 0.f;
#pragma unroll
            for (int ai = 0; ai < 2; ++ai)
#pragma unroll
                for (int m = 0; m < 4; ++m) { const int row = rowb + ai * HALF + m * 16;
                    const float* tp = tpos + (size_t)row * 16 + 4 * (fq & 1);
                    f32x4 c = *(const f32x4*)tp, s = *(const f32x4*)(tp + 8);
                    if (!rot) { c = (f32x4){1.f, 1.f, 1.f, 1.f}; s = (f32x4){0.f, 0.f, 0.f, 0.f}; }
                    const f32x4 y0 = acc[ai][0][m][0], y1 = acc[ai][0][m][1];
                    const f32x4 o0 = (y0 * c - y1 * s) * sc, o1 = (y1 * c + y0 * s) * sc;
                    u32x4 w; w.x = cvt_pk_bf16(o0[0], o0[1]); w.y = cvt_pk_bf16(o0[2], o0[3]); w.z = cvt_pk_bf16(o1[0], o1[1]); w.w = cvt_pk_bf16(o1[2], o1[3]);
                    *(u32x4*)(plane + (size_t)row * 64 + 8 * fq) = w;
                    const f32x4 z0 = acc[ai][1][m][0] * sc, z1 = acc[ai][1][m][1] * sc;
                    u32x4 w2; w2.x = cvt_pk_bf16(z0[0], z0[1]); w2.y = cvt_pk_bf16(z0[2], z0[3]); w2.z = cvt_pk_bf16(z1[0], z1[1]); w2.w = cvt_pk_bf16(z1[2], z1[3]);
                    *(u32x4*)(plane + (size_t)row * 64 + 32 + 8 * fq) = w2;
                    float ss = (o0[0] * o0[0] + o0[1] * o0[1]) + (o0[2] * o0[2] + o0[3] * o0[3]) + (o1[0] * o1[0] + o1[1] * o1[1]) + (o1[2] * o1[2] + o1[3] * o1[3])
                             + (z0[0] * z0[0] + z0[1] * z0[1]) + (z0[2] * z0[2] + z0[3] * z0[3]) + (z1[0] * z1[0] + z1[1] * z1[1]) + (z1[2] * z1[2] + z1[3] * z1[3]);
                    ss += __shfl_xor(ss, 16); ss += __shfl_xor(ss, 32); nm = __builtin_fmaxf(nm, ss); }
#pragma unroll
            for (int o = 1; o < 16; o <<= 1) nm = __builtin_fmaxf(nm, __shfl_xor(nm, o));
            if ((fr | fq) == 0) atomicMax(nmax + slot, __float_as_uint(nm));
        } else {
#pragma unroll
            for (int ai = 0; ai < 2; ++ai)
#pragma unroll
                for (int m = 0; m < 4; ++m) { const int row = rowb + ai * HALF + m * 16;
#pragma unroll
                    for (int bj = 0; bj < 2; ++bj) { const f32x4 v0 = acc[ai][bj][m][0], v1 = acc[ai][bj][m][1];
                        u32x4 w; w.x = cvt_pk_bf16(v0[0], v0[1]); w.y = cvt_pk_bf16(v0[2], v0[3]); w.z = cvt_pk_bf16(v1[0], v1[1]); w.w = cvt_pk_bf16(v1[2], v1[3]);
                        *(u32x4*)(plane + (size_t)row * 64 + 32 * bj + 8 * fq) = w; } }
        }
    }
};

struct EpiOutProj {
    static constexpr bool PERM = false, AFTER_DRAIN = false;
    const float* x; float* h1; bf16_t* h1b; float* ssq;
    __device__ __forceinline__ void operator()(const f32x4 (&acc)[2][2][4][2], const Unit& u, int wr, int wc, int fr, int fq) const {
        const int col0 = u.pn * BM + wc * 32 + 4 * fq;
#pragma unroll
        for (int ai = 0; ai < 2; ++ai)
#pragma unroll
            for (int m = 0; m < 4; ++m) { const int row = u.pm * BM + ai * HALF + wr * 64 + m * 16 + fr; const size_t off = (size_t)row * 1024 + col0; float ss = 0.f;
#pragma unroll
                for (int bj = 0; bj < 2; ++bj)
#pragma unroll
                    for (int n = 0; n < 2; ++n) { const size_t o = off + bj * HALF + n * 16; const f32x4 h = *(const f32x4*)(x + o) + acc[ai][bj][m][n];
                        u32x2 w; w.x = cvt_pk_bf16(h[0], h[1]); w.y = cvt_pk_bf16(h[2], h[3]); *(u32x2*)(h1b + o) = w;
                        ss += (h[0] * h[0] + h[1] * h[1]) + (h[2] * h[2] + h[3] * h[3]); }
                ss += __shfl_xor(ss, 16); ss += __shfl_xor(ss, 32);
                if (fq == 0) ssq[(size_t)(u.pn * 4 + wc) * 16384 + row] = ss; }
    }
};

template <class Epi, class Sched, bool ALIGN_EPI = false, bool SP2 = false>
__device__ __forceinline__ void gemm_phase(PG8_LAS unsigned char* lds, const Gemm g, const Sched& S, const Epi& E) {
    const int tid = threadIdx.x, wid = __builtin_amdgcn_readfirstlane(tid >> 6), lane = tid & 63, wr = wid >> 2, wc = wid & 3, fr = lane & 15, fq = lane >> 4;
    const int K = g.K, nt = K / BK;
    unsigned voffA[2], voffB[2];
#pragma unroll
    for (int i = 0; i < 2; ++i) { int R, C; stage_rc(tid * 16 + i * 8192, R, C); const int Rb = Epi::PERM ? ((R & ~31) + perm32(R & 31)) : R;
        voffA[i] = (unsigned)(R * K + C) * 2u; voffB[i] = (unsigned)(Rb * K + C) * 2u; }
    const size_t kstep = (size_t)(BK * 2);
    const size_t hstep = (size_t)HALF * K * 2;
    const size_t tstep = 2 * hstep;
    const unsigned ldsw = (unsigned)wid * 1024u;
    const int aoff = lds_byte(wr * 64 + fr, fq * 8), boff = lds_byte(wc * 32 + fr, fq * 8);
#define PG8_SA(b, h) (((b) * 2 + (h)) * HTB)
#define PG8_SB(b, h) ((4 + (b) * 2 + (h)) * HTB)
#define PG8_STAGE(bufoff, gbase, voff) do { _Pragma("unroll") for (int _i = 0; _i < 2; ++_i) \
        __builtin_amdgcn_global_load_lds((const unsigned*)((const char*)(gbase) + (voff)[_i]), (PG8_LAS unsigned*)(lds + (bufoff) + ldsw + _i * 8192), 16, 0, 0); } while (0)
#define PG8_LDA(dst, b, h) do { _Pragma("unroll") for (int m = 0; m < 4; ++m) _Pragma("unroll") for (int k = 0; k < 2; ++k) dst[m][k] = *(const PG8_LAS bf16x8*)(lds + PG8_SA(b, h) + aoff + m * 2048 + k * 1024); } while (0)
#define PG8_LDB(dst, b, h) do { _Pragma("unroll") for (int n = 0; n < 2; ++n) _Pragma("unroll") for (int k = 0; k < 2; ++k) dst[n][k] = *(const PG8_LAS bf16x8*)(lds + PG8_SB(b, h) + boff + n * 2048 + k * 1024); } while (0)
#define PG8_MMA(ai, bj, At, Bt) do { __builtin_amdgcn_s_setprio(1); _Pragma("unroll") for (int m = 0; m < 4; ++m) _Pragma("unroll") for (int n = 0; n < 2; ++n) _Pragma("unroll") for (int k = 0; k < 2; ++k) \
        acc[ai][bj][m][n] = __builtin_amdgcn_mfma_f32_16x16x32_bf16(Bt[n][k], At[m][k], acc[ai][bj][m][n], 0, 0, 0); __builtin_amdgcn_s_setprio(0); } while (0)
#define PG8_WAIT_V(n) asm volatile("s_waitcnt vmcnt(" #n ")" ::: "memory")
#define PG8_WAIT_L(n) asm volatile("s_waitcnt lgkmcnt(" #n ")" ::: "memory")
#define PG8_BAR __builtin_amdgcn_s_barrier()
#define PG8_SCHED __builtin_amdgcn_sched_barrier(0)
    Unit cur, nxt; int ui = 0;
    if (!S.next(0, cur)) return;
    f32x4 acc[2][2][4][2];
#pragma unroll
    for (int a = 0; a < 2; ++a)
#pragma unroll
        for (int b = 0; b < 2; ++b)
#pragma unroll
            for (int m = 0; m < 4; ++m)
#pragma unroll
                for (int n = 0; n < 2; ++n) acc[a][b][m][n] = (f32x4){0.f, 0.f, 0.f, 0.f};
    bf16x8 At[4][2], B0[2][2], B1[2][2];
    const char* cA = (const char*)g.A + (size_t)cur.pm * tstep; const char* cB = (const char*)g.Bt + (size_t)cur.pn * tstep;
    S.a_ready(cur);
    if constexpr (SP2) {
        PG8_STAGE(PG8_SB(0, 0), cB, voffB); PG8_STAGE(PG8_SB(0, 1), cB + hstep, voffB); PG8_STAGE(PG8_SA(0, 0), cA, voffA); PG8_STAGE(PG8_SA(0, 1), cA + hstep, voffA);
        if (wr == 1) PG8_BAR;
        PG8_WAIT_V(2); PG8_BAR;
        PG8_STAGE(PG8_SB(1, 0), cB + kstep, voffB); PG8_STAGE(PG8_SA(1, 0), cA + kstep, voffA); PG8_STAGE(PG8_SB(1, 1), cB + hstep + kstep, voffB);
        PG8_WAIT_V(6); PG8_BAR;
    } else {
        PG8_STAGE(PG8_SB(0, 0), cB, voffB); PG8_STAGE(PG8_SA(0, 0), cA, voffA); PG8_STAGE(PG8_SB(0, 1), cB + hstep, voffB); PG8_STAGE(PG8_SA(0, 1), cA + hstep, voffA);
        if (wr == 1) PG8_BAR;
        PG8_WAIT_V(4); PG8_BAR;
        PG8_STAGE(PG8_SB(1, 0), cB + kstep, voffB); PG8_STAGE(PG8_SA(1, 0), cA + kstep, voffA); PG8_STAGE(PG8_SB(1, 1), cB + hstep + kstep, voffB);
        PG8_WAIT_V(6); PG8_BAR;
    }
    for (;;) {
        const bool has_next = S.next(ui + 1, nxt);
        const char* nA = has_next ? (const char*)g.A + (size_t)nxt.pm * tstep : cA; const char* nB = has_next ? (const char*)g.Bt + (size_t)nxt.pn * tstep : cB;
        for (int t = 0; t < nt; t += 2) {
            const bool last = (t == nt - 2);
            const char* a1 = cA + (size_t)(t + 1) * kstep;
            const char* a2 = last ? nA : cA + (size_t)(t + 2) * kstep; const char* b2 = last ? nB : cB + (size_t)(t + 2) * kstep;
            const char* a3 = a2 + kstep; const char* b3 = b2 + kstep;
            if (last && has_next) S.a_ready(nxt);
            if constexpr (SP2) {
            PG8_LDB(B0, 0, 0); PG8_LDB(B1, 0, 1); PG8_SCHED; PG8_LDA(At, 0, 0); PG8_STAGE(PG8_SA(1, 1), a1 + hstep, voffA);
            PG8_WAIT_V(8); PG8_WAIT_L(0); PG8_BAR; PG8_MMA(0, 0, At, B0); PG8_MMA(0, 1, At, B1); PG8_BAR; PG8_SCHED;
            PG8_LDA(At, 0, 1); PG8_STAGE(PG8_SB(0, 0), b2, voffB); PG8_STAGE(PG8_SB(0, 1), b2 + hstep, voffB); PG8_STAGE(PG8_SA(0, 0), a2, voffA);
            PG8_WAIT_V(8); PG8_WAIT_L(0); PG8_BAR; PG8_MMA(1, 0, At, B0); PG8_MMA(1, 1, At, B1); PG8_BAR; PG8_SCHED;
            PG8_LDB(B0, 1, 0); PG8_LDB(B1, 1, 1); PG8_SCHED; PG8_LDA(At, 1, 0); PG8_STAGE(PG8_SA(0, 1), a2 + hstep, voffA);
            PG8_WAIT_V(8); PG8_WAIT_L(0); PG8_BAR; PG8_MMA(0, 0, At, B0); PG8_MMA(0, 1, At, B1); PG8_BAR; PG8_SCHED;
            PG8_LDA(At, 1, 1); PG8_STAGE(PG8_SB(1, 0), b3, voffB); PG8_STAGE(PG8_SB(1, 1), b3 + hstep, voffB); PG8_STAGE(PG8_SA(1, 0), a3, voffA);
            PG8_WAIT_V(8); PG8_WAIT_L(0); PG8_BAR; PG8_MMA(1, 0, At, B0); PG8_MMA(1, 1, At, B1); PG8_BAR; PG8_SCHED;
            } else {
            PG8_LDB(B0, 0, 0); PG8_SCHED; PG8_LDA(At, 0, 0); PG8_STAGE(PG8_SA(1, 1), a1 + hstep, voffA);
            PG8_WAIT_L(8); PG8_BAR; PG8_WAIT_L(0); PG8_MMA(0, 0, At, B0); PG8_BAR; PG8_SCHED;
            PG8_LDB(B1, 0, 1); PG8_STAGE(PG8_SB(0, 0), b2, voffB);
            PG8_BAR; PG8_WAIT_L(0); PG8_MMA(0, 1, At, B1); PG8_BAR;
            PG8_LDA(At, 0, 1); PG8_STAGE(PG8_SA(0, 0), a2, voffA);
            PG8_BAR; PG8_WAIT_L(0); PG8_MMA(1, 0, At, B0); PG8_BAR; PG8_SCHED;
            PG8_STAGE(PG8_SB(0, 1), b2 + hstep, voffB);
            PG8_WAIT_V(6); PG8_BAR; PG8_MMA(1, 1, At, B1); PG8_BAR;
            PG8_LDB(B0, 1, 0); PG8_SCHED; PG8_LDA(At, 1, 0); PG8_STAGE(PG8_SA(0, 1), a2 + hstep, voffA);
            PG8_WAIT_L(8); PG8_BAR; PG8_WAIT_L(0); PG8_MMA(0, 0, At, B0); PG8_BAR; PG8_SCHED;
            PG8_LDB(B1, 1, 1); PG8_STAGE(PG8_SB(1, 0), b3, voffB);
            PG8_BAR; PG8_WAIT_L(0); PG8_MMA(0, 1, At, B1); PG8_BAR;
            PG8_LDA(At, 1, 1); PG8_STAGE(PG8_SA(1, 0), a3, voffA);
            PG8_BAR; PG8_WAIT_L(0); PG8_MMA(1, 0, At, B0); PG8_BAR; PG8_SCHED;
            PG8_STAGE(PG8_SB(1, 1), b3 + hstep, voffB);
            PG8_WAIT_V(6); PG8_BAR; PG8_MMA(1, 1, At, B1); PG8_BAR;
            }
        }
        if constexpr (ALIGN_EPI) { if (wr == 0) PG8_BAR; }
        if constexpr (!Epi::AFTER_DRAIN) { E(acc, cur, wr, wc, fr, fq); S.done(cur); }
        if (!has_next) break;
#pragma unroll
        for (int a = 0; a < 2; ++a)
#pragma unroll
            for (int b = 0; b < 2; ++b)
#pragma unroll
                for (int m = 0; m < 4; ++m)
#pragma unroll
                    for (int n = 0; n < 2; ++n) acc[a][b][m][n] = (f32x4){0.f, 0.f, 0.f, 0.f};
        cur = nxt; cA = nA; cB = nB; ++ui;
        if constexpr (ALIGN_EPI) { if (wr == 1) PG8_BAR; }
    }
    PG8_WAIT_V(0);
    if constexpr (!ALIGN_EPI) { if (wr == 0) PG8_BAR; }
    PG8_BAR;
    if constexpr (Epi::AFTER_DRAIN) { E.fused(acc, cur, wr, wc, fr, fq, lds, wid, lane); S.done(cur); }
#undef PG8_SA
#undef PG8_SB
#undef PG8_STAGE
#undef PG8_LDA
#undef PG8_LDB
#undef PG8_MMA
#undef PG8_WAIT_V
#undef PG8_WAIT_L
#undef PG8_BAR
#undef PG8_SCHED
}
}
namespace attn_body {
using bf16=__hip_bfloat16;
using bf16x8=__attribute__((ext_vector_type(8)))short;
using s16x4=__attribute__((ext_vector_type(4)))short;
using f32x16=__attribute__((ext_vector_type(16)))float;
using u32x4=__attribute__((ext_vector_type(4)))unsigned;
constexpr int SEQ=16384,D=64,PP=64;
constexpr int NW=8,QBLK=32,QB=QBLK*NW,KVBLK=64,NQB=SEQ/QB,NT=SEQ/KVBLK;
constexpr int OPITCH=1024;
__device__ __forceinline__ int crow(int r,int hi){return (r&3)+8*(r>>2)+4*hi;}
#define SBAR() __builtin_amdgcn_sched_barrier(0)
constexpr int NSLOT=3, SLOTB=8192;
constexpr int LDS_K=0, LDS_V=NSLOT*SLOTB, LDS_WS=LDS_V+NSLOT*2*SLOTB, LDS_OST=LDS_WS+NW*64*4, LDS_BYTES=LDS_OST+NW*8192;
__device__ __forceinline__ void glds16(const void*gsrc,unsigned lds_dst){unsigned keep;
  asm volatile("s_mov_b32 %0, m0\n\ts_mov_b32 m0, %2\n\ts_nop 0\n\tglobal_load_lds_dwordx4 %1, off\n\ts_mov_b32 m0, %0":"=&s"(keep):"v"(gsrc),"s"(lds_dst):"memory");}
__device__ __forceinline__ void glds16b(__amdgpu_buffer_rsrc_t srd,unsigned voff,unsigned soff,unsigned lds_dst){unsigned keep;
  asm volatile("s_nop 4\n\ts_mov_b32 %0, m0\n\ts_mov_b32 m0, %4\n\ts_nop 0\n\tbuffer_load_dwordx4 %1, %2, %3 offen lds\n\ts_mov_b32 m0, %0":"=&s"(keep):"v"(voff),"s"(srd),"s"(soff),"s"(lds_dst):"memory");}
__device__ __forceinline__ float max3f(float a,float b,float c){float r;asm("v_max3_f32 %0, %1, %2, %3":"=v"(r):"v"(a),"v"(b),"v"(c));return r;}
__device__ __forceinline__ float max2f(float a,float b){float r;asm("v_max_f32_e32 %0, %1, %2":"=v"(r):"v"(a),"v"(b));return r;}
__device__ __forceinline__ float fadd_s(float a,float b){float r;asm("v_add_f32_e32 %0, %1, %2":"=v"(r):"v"(a),"v"(b));return r;}
__device__ __forceinline__ float fsub_s(float a,float b){float r;asm("v_sub_f32_e32 %0, %1, %2":"=v"(r):"v"(a),"v"(b));return r;}
typedef float f32x2_t __attribute__((ext_vector_type(2))); typedef __bf16 bf16x2_t __attribute__((ext_vector_type(2)));
__device__ __forceinline__ unsigned cvtpk_s(float lo,float hi){f32x2_t v={lo,hi};bf16x2_t b=__builtin_convertvector(v,bf16x2_t);return __builtin_bit_cast(unsigned,b);}
#define WAIT_BAR(N) asm volatile("s_waitcnt vmcnt(" #N ") lgkmcnt(0)\n\ts_barrier":::"memory")

__device__ __forceinline__ void zero16(f32x16&x){
  #pragma unroll
  for(int r=0;r<16;++r){float z;asm volatile("v_mov_b32 %0, 0":"=v"(z));x[r]=z;}
}
__device__ __forceinline__ void qkt(f32x16&p0,f32x16&p1,const char*Kslot,const bf16x8*qr,const f32x16&negm,int r32,int hi){
  const char*kb=Kslot+hi*1024+r32*16;
  #pragma unroll
  for(int d0=0;d0<4;++d0){
    const bf16x8 b0=*reinterpret_cast<const bf16x8*>(kb+d0*2048);
    const bf16x8 b1=*reinterpret_cast<const bf16x8*>(kb+d0*2048+512);
    if(d0==0){p0=__builtin_amdgcn_mfma_f32_32x32x16_bf16(b0,qr[0],negm,0,0,0);p1=__builtin_amdgcn_mfma_f32_32x32x16_bf16(b1,qr[0],negm,0,0,0);}
    else{p0=__builtin_amdgcn_mfma_f32_32x32x16_bf16(b0,qr[d0],p0,0,0,0);p1=__builtin_amdgcn_mfma_f32_32x32x16_bf16(b1,qr[d0],p1,0,0,0);}}
}
typedef __attribute__((address_space(3))) const char* lds_cptr;
typedef short v4i16_t __attribute__((ext_vector_type(4)));
__device__ __forceinline__ void kload8(bf16x8*kf,lds_cptr kp){
  kf[0]=*(const __attribute__((address_space(3))) bf16x8*)(kp);      kf[1]=*(const __attribute__((address_space(3))) bf16x8*)(kp+512);
  kf[2]=*(const __attribute__((address_space(3))) bf16x8*)(kp+2048); kf[3]=*(const __attribute__((address_space(3))) bf16x8*)(kp+2560);
  kf[4]=*(const __attribute__((address_space(3))) bf16x8*)(kp+4096); kf[5]=*(const __attribute__((address_space(3))) bf16x8*)(kp+4608);
  kf[6]=*(const __attribute__((address_space(3))) bf16x8*)(kp+6144); kf[7]=*(const __attribute__((address_space(3))) bf16x8*)(kp+6656);
}
__device__ __forceinline__ void kload2(bf16x8*kf,lds_cptr kp,int j){ kf[2*j]=*(const __attribute__((address_space(3))) bf16x8*)(kp+j*2048); kf[2*j+1]=*(const __attribute__((address_space(3))) bf16x8*)(kp+j*2048+512); }
__device__ __forceinline__ s16x4 vtr(lds_cptr p){ return __builtin_bit_cast(s16x4,__builtin_amdgcn_ds_read_tr16_b64_v4i16((__attribute__((address_space(3))) v4i16_t*)p)); }
__device__ __forceinline__ float rowmax(const f32x16&p0,const f32x16&p1){
  float a=max3f(p0[0],p0[1],p1[0]),b=max3f(p0[2],p0[3],p1[1]);a=max3f(a,p1[2],p1[3]);
  #pragma unroll
  for(int r=4;r<16;r+=4){a=max3f(a,p0[r],p0[r+1]);b=max3f(b,p0[r+2],p0[r+3]);a=max3f(a,p1[r],p1[r+1]);b=max3f(b,p1[r+2],p1[r+3]);}
  const float m=max2f(a,b);
  auto rr=__builtin_amdgcn_permlane32_swap(__float_as_uint(m),__float_as_uint(m),false,false);
  return max2f(__uint_as_float(rr[0]),__uint_as_float(rr[1]));
}
template<int NB> __device__ __forceinline__ void pv(f32x16*o,int vb,bf16x8 pa0,bf16x8 pa1,bf16x8 pa2,bf16x8 pa3){
  #pragma unroll
  for(int d0=0;d0<NB;++d0){s16x4 lo[4],hi[4];
    #pragma unroll
    for(int ks=0;ks<4;++ks){
      asm volatile("ds_read_b64_tr_b16 %0,%1 offset:%c2":"=&v"(lo[ks]):"v"(vb),"i"(d0*4096+ks*1024):"memory");
      asm volatile("ds_read_b64_tr_b16 %0,%1 offset:%c2":"=&v"(hi[ks]):"v"(vb),"i"(d0*4096+ks*1024+512):"memory");}
    asm volatile("s_waitcnt lgkmcnt(0)":::"memory");SBAR();
    #define PK(k) (bf16x8){lo[k][0],lo[k][1],lo[k][2],lo[k][3],hi[k][0],hi[k][1],hi[k][2],hi[k][3]}
    o[d0]=__builtin_amdgcn_mfma_f32_32x32x16_bf16(pa0,PK(0),o[d0],0,0,0);
    o[d0]=__builtin_amdgcn_mfma_f32_32x32x16_bf16(pa1,PK(1),o[d0],0,0,0);
    o[d0]=__builtin_amdgcn_mfma_f32_32x32x16_bf16(pa2,PK(2),o[d0],0,0,0);
    o[d0]=__builtin_amdgcn_mfma_f32_32x32x16_bf16(pa3,PK(3),o[d0],0,0,0);
    #undef PK
  }
}
#ifndef ATTN_STORE16
#define ATTN_STORE16(p,v) (*(u32x4*)(p)=(v))
#endif
#define PKW(P,B) cvtpk_s(P[B],P[B+1])
#define PAF(k) __builtin_bit_cast(bf16x8,pw##k)
#define PIN(x) asm volatile("":"+v"(x))
#define MX3(a,b,c) __builtin_fmaxf(__builtin_fmaxf((a),(b)),(c))
#define EX(v) __builtin_amdgcn_exp2f(v)
#define MF32(a,b,c) __builtin_amdgcn_mfma_f32_32x32x16_bf16(a,b,c,0,0,0)
#define GAPA(MF,A0,A1,A2,A3,W0,W1,PW) do{ MF; sacc+=A0; sacc+=A1; sacc+=A2; sacc+=A3; PIN(sacc); W0; W1; PIN(PW); SBAR(); }while(0)
#define ROT() do{sl_prev=sl_cur;sl_cur=sl_next;sl_next=(sl_next==(NSLOT-1)*SLOTB)?0:sl_next+SLOTB;}while(0)
#define DECIDE(C0,C1) do{ float a=MX3(C0[0],C0[1],C1[0]),b=MX3(C0[2],C0[3],C1[1]); a=MX3(a,C1[2],C1[3]); \
      _Pragma("unroll") for(int r=4;r<16;r+=4){a=MX3(a,C0[r],C0[r+1]);b=MX3(b,C0[r+2],C0[r+3]);a=MX3(a,C1[r],C1[r+1]);b=MX3(b,C1[r+2],C1[r+3]);} \
      float rm=__builtin_fmaxf(a,b); { auto rr=__builtin_amdgcn_permlane32_swap(__float_as_uint(rm),__float_as_uint(rm),false,false); rm=__builtin_fmaxf(__uint_as_float(rr[0]),__uint_as_float(rr[1])); } \
      resc=false; \
      if(__builtin_expect(__any(rm>(float)THRL),0)){ const float dl=__builtin_fmaxf(rm,0.f); mhat+=dl; \
        _Pragma("unroll") for(int r=0;r<16;++r){C0[r]-=dl;C1[r]-=dl;} \
        _Pragma("unroll") for(int r=0;r<16;++r)negm[r]=-mhat; asm volatile("":"+v"(negm)); \
        const float f=__builtin_amdgcn_exp2f(-dl); l_reg*=f; if(hi==0)wsf[r32]=f; resc=true; } }while(0)
#define START(P0,P1) do{ const float rm=rowmax(P0,P1); resc=false; \
    { const float dl=rm; mhat=fadd_s(mhat,dl); \
      _Pragma("unroll") for(int r=0;r<16;++r){P0[r]=fsub_s(P0[r],dl);P1[r]=fsub_s(P1[r],dl);} \
      _Pragma("unroll") for(int r=0;r<16;++r)negm[r]=-mhat; asm volatile("":"+v"(negm)); } \
    _Pragma("unroll") for(int r=0;r<16;++r)P0[r]=__builtin_amdgcn_exp2f(P0[r]); }while(0)
#define KRD(G,j) do{ if(G){ kload2(kf,kp0+sl_next,j); SBAR(); } }while(0)

template<int THRL> __device__ __forceinline__ void attn_unit_a(int qb,const bf16*Qp,__amdgpu_buffer_rsrc_t srd,unsigned kbyte,unsigned vbyte,bf16*Ob,char*shm,float mub,bool SB){
  const int tid=threadIdx.x,lane=tid&63,r32=lane&31,hi=lane>>5; const int wid=__builtin_amdgcn_readfirstlane(tid>>6);
  const int q0=qb*QB;
  const bf16*Qw=Qp+(long)(q0+wid*QBLK)*PP;
  const unsigned lds0=(unsigned)(uintptr_t)shm;
  float*wsf=(float*)(shm+LDS_WS)+wid*64;
  const unsigned kvoff=(unsigned)(lane*PP+wid*8)*2u, vvoff=(unsigned)((16*(wid&3)+(lane>>2))*PP+(wid>>2)*32+(lane&3)*8)*2u;
  const unsigned kdst=lds0+LDS_K+wid*1024, vdst=lds0+LDS_V+wid*1024;
  #define DMA_K(t,slot) glds16b(srd,kvoff,(unsigned)__builtin_amdgcn_readfirstlane(kbyte+(unsigned)(t)*(KVBLK*PP*2)),(unsigned)__builtin_amdgcn_readfirstlane(kdst+(slot)))
  #define DMA_V(t,slot) glds16b(srd,vvoff,(unsigned)__builtin_amdgcn_readfirstlane(vbyte+(unsigned)(t)*(KVBLK*PP*2)),(unsigned)__builtin_amdgcn_readfirstlane(vdst+2*(slot)))
  const int vb0=(int)(lds0+LDS_V)+((lane>>4)&1)*32+(lane&3)*8+(4*hi+((lane&15)>>2))*64;
  const char*Kbase=shm+LDS_K; bf16x8 kf[8];
  const lds_cptr shm3=(lds_cptr)shm; const lds_cptr kp0=shm3+LDS_K+hi*1024+r32*16; const lds_cptr vp0=shm3+LDS_V+((lane>>4)&1)*32+(lane&3)*8+(4*hi+((lane&15)>>2))*64;
  DMA_K(0,0);DMA_V(0,0);DMA_K(1,SLOTB);
  bf16x8 qr[4];
  #pragma unroll
  for(int d0=0;d0<4;++d0)qr[d0]=*reinterpret_cast<const bf16x8*>(&Qw[(long)r32*PP+d0*16+hi*8]);
  float mhat=0.f,l_reg=0.f;f32x16 o[2];zero16(o[0]);zero16(o[1]);f32x16 negm;zero16(negm);
  if(SB){ _Pragma("unroll") for(int r=0;r<16;++r)negm[r]=-mub; asm volatile("":"+v"(negm)); }
  bool resc=false;
  #define RESC() do{ if(!SB && resc){ asm volatile("s_waitcnt lgkmcnt(0)":::"memory"); \
      _Pragma("unroll") for(int d_=0;d_<2;++d_) _Pragma("unroll") for(int r=0;r<16;++r)o[d_][r]*=wsf[crow(r,hi)]; } }while(0)
  f32x16 pA0,pA1,pB0,pB1;
  int sl_prev=0,sl_cur=0,sl_next=SLOTB;
  DMA_K(2,2*SLOTB);
  WAIT_BAR(3);
  qkt(pA0,pA1,Kbase,qr,negm,r32,hi);asm volatile("s_nop 15\n\ts_nop 7":"+v"(pA0),"+v"(pA1));
  if(SB){ _Pragma("unroll") for(int r=0;r<16;++r)pA0[r]=__builtin_amdgcn_exp2f(pA0[r]); } else { START(pA0,pA1); }
  _Pragma("unroll") for(int r=0;r<16;++r)pA1[r]=__builtin_amdgcn_exp2f(pA1[r]);
  WAIT_BAR(0);
  DMA_K(3,0);DMA_V(1,SLOTB);
  ROT();
  kload8(kf,kp0+sl_cur);
  WAIT_BAR(2);
  s16x4 vlo[8],vhi[8]; u32x4 pw0,pw1,pw2,pw3;
  #define VFR(i) (bf16x8){vlo[i][0],vlo[i][1],vlo[i][2],vlo[i][3],vhi[i][0],vhi[i][1],vhi[i][2],vhi[i][3]}
  #define GAPB(MF,X,B) do{ MF; X[B]=EX(X[B]); X[B+1]=EX(X[B+1]); X[B+2]=EX(X[B+2]); X[B+3]=EX(X[B+3]); PIN(X); SBAR(); }while(0)
  #define VRD(i) do{ vlo[i]=vtr(vp_+(((i)>>2)*4096+((i)&3)*1024)); vhi[i]=vtr(vp_+(((i)>>2)*4096+((i)&3)*1024+512)); }while(0)
  #define STEP(C0,C1,P0,P1,t,GK,GV,GL) do{ SBAR(); \
    const lds_cptr vp_=vp0+2*sl_prev; \
    VRD(0); SBAR(); float sacc=(P0[0]+P0[1]); \
    GAPA(C0=MF32(kf[0],qr[0],negm), P0[2],P0[3],P0[4],P0[5],     pw0[0]=PKW(P0,0), pw0[1]=PKW(P0,2), pw0); \
    VRD(4); SBAR(); GAPA(C1=MF32(kf[1],qr[0],negm), P0[6],P0[7],P0[8],P0[9],     pw0[2]=PKW(P0,4), pw0[3]=PKW(P0,6), pw0); \
    VRD(1); SBAR(); GAPA(C0=MF32(kf[2],qr[1],C0),   P0[10],P0[11],P0[12],P0[13], pw1[0]=PKW(P0,8), pw1[1]=PKW(P0,10), pw1); \
    VRD(5); SBAR(); GAPA(C1=MF32(kf[3],qr[1],C1),   P0[14],P0[15],P1[0],P1[1],   pw1[2]=PKW(P0,12),pw1[3]=PKW(P0,14), pw1); \
    VRD(2); SBAR(); GAPA(C0=MF32(kf[4],qr[2],C0),   P1[2],P1[3],P1[4],P1[5],     pw2[0]=PKW(P1,0), pw2[1]=PKW(P1,2), pw2); \
    VRD(6); SBAR(); GAPA(C1=MF32(kf[5],qr[2],C1),   P1[6],P1[7],P1[8],P1[9],     pw2[2]=PKW(P1,4), pw2[3]=PKW(P1,6), pw2); \
    VRD(3); SBAR(); GAPA(C0=MF32(kf[6],qr[3],C0),   P1[10],P1[11],P1[12],P1[13], pw3[0]=PKW(P1,8), pw3[1]=PKW(P1,10), pw3); \
    VRD(7); SBAR(); GAPA(C1=MF32(kf[7],qr[3],C1),   P1[14],P1[15],0.f,0.f,       pw3[2]=PKW(P1,12),pw3[3]=PKW(P1,14), pw3); \
    l_reg+=sacc; \
    if(GK){DMA_K((t)+3,sl_cur);} if(GV){DMA_V((t)+1,sl_next);} \
    if(!SB){ DECIDE(C0,C1); } \
    SBAR(); __builtin_amdgcn_s_setprio(1); \
    GAPB(o[0]=MF32(PAF(0),VFR(0),o[0]), C0,0); \
    GAPB(o[1]=MF32(PAF(0),VFR(4),o[1]), C0,4); \
    KRD(GL,0); GAPB(o[0]=MF32(PAF(1),VFR(1),o[0]), C0,8); \
    KRD(GL,1); GAPB(o[1]=MF32(PAF(1),VFR(5),o[1]), C0,12); \
    KRD(GL,2); GAPB(o[0]=MF32(PAF(2),VFR(2),o[0]), C1,0); \
    KRD(GL,3); GAPB(o[1]=MF32(PAF(2),VFR(6),o[1]), C1,4); \
    GAPB(o[0]=MF32(PAF(3),VFR(3),o[0]), C1,8); \
    GAPB(o[1]=MF32(PAF(3),VFR(7),o[1]), C1,12); __builtin_amdgcn_s_setprio(0); \
    }while(0)
  int t=1;
  asm volatile(".p2align 8\n\t.fill 12, 4, 0xbf800000");
  for(;t+5<NT;t+=2){
    STEP(pB0,pB1,pA0,pA1,t,true,true,true);     WAIT_BAR(2); RESC(); ROT();
    STEP(pA0,pA1,pB0,pB1,t+1,true,true,true);   WAIT_BAR(2); RESC(); ROT();
  }
  #define ENDW(tt) do{ if((tt)+3<NT){WAIT_BAR(2);} else if((tt)+2<NT){WAIT_BAR(1);} else {WAIT_BAR(0);} }while(0)
  for(;t+1<NT;t+=2){
    STEP(pB0,pB1,pA0,pA1,t,(t+3<NT),(t+1<NT),(t+1<NT));       ENDW(t);   RESC(); ROT();
    STEP(pA0,pA1,pB0,pB1,t+1,(t+4<NT),(t+2<NT),(t+2<NT));     ENDW(t+1); RESC(); ROT();
  }
  STEP(pB0,pB1,pA0,pA1,NT-1,false,false,false); RESC();
  { float sacc=pB0[0]+pB0[1]; _Pragma("unroll") for(int r=2;r<16;++r)sacc+=pB0[r]; _Pragma("unroll") for(int r=0;r<16;++r)sacc+=pB1[r]; l_reg+=sacc;
    pw0=(u32x4){PKW(pB0,0),PKW(pB0,2),PKW(pB0,4),PKW(pB0,6)};pw1=(u32x4){PKW(pB0,8),PKW(pB0,10),PKW(pB0,12),PKW(pB0,14)};pw2=(u32x4){PKW(pB1,0),PKW(pB1,2),PKW(pB1,4),PKW(pB1,6)};pw3=(u32x4){PKW(pB1,8),PKW(pB1,10),PKW(pB1,12),PKW(pB1,14)};
    SBAR(); pv<2>(o,vb0+2*sl_cur,PAF(0),PAF(1),PAF(2),PAF(3)); }
  #undef VFR
  #undef GAPB
  #undef VRD
  #undef STEP
  #undef ENDW
  {auto rr=__builtin_amdgcn_permlane32_swap(__float_as_uint(l_reg),__float_as_uint(l_reg),false,false);l_reg=__uint_as_float(rr[0])+__uint_as_float(rr[1]);}
  if(hi==0)wsf[32+r32]=l_reg;asm volatile("s_waitcnt lgkmcnt(0)":::"memory");
  float rli[16];
  #pragma unroll
  for(int r=0;r<16;++r)rli[r]=__builtin_amdgcn_rcpf(wsf[32+crow(r,hi)]);
  bf16*Ow=Ob+(long)(q0+wid*QBLK)*OPITCH;
  { bf16*stg=(bf16*)(shm+LDS_OST)+wid*4096;
    #pragma unroll
    for(int r=0;r<16;++r){const int orow=crow(r,hi);
      #pragma unroll
      for(int d0=0;d0<2;++d0)stg[orow*64+d0*32+r32]=__float2bfloat16(o[d0][r]*rli[r]);}
    asm volatile("s_waitcnt lgkmcnt(0)":::"memory");
    #pragma unroll
    for(int i=0;i<4;++i){const int row=i*8+(lane>>3),ch=lane&7; const u32x4 v=*(const u32x4*)(stg+row*64+ch*8); ATTN_STORE16(Ow+(long)row*OPITCH+ch*8,v);} }
  asm volatile("s_waitcnt lgkmcnt(0)\n\ts_barrier":::"memory");
  #undef DMA_K
  #undef DMA_V
  #undef RESC
}
template<int THRL> __device__ __forceinline__ void attn_unit_b(int qb,int comp,const bf16*Qp,__amdgpu_buffer_rsrc_t srd,unsigned kbyte,unsigned vbyte,float*sc,float lam,const float*subg,bf16*Ob,char*shm,float mub,bool SB){
  const int tid=threadIdx.x,lane=tid&63,r32=lane&31,hi=lane>>5; const int wid=__builtin_amdgcn_readfirstlane(tid>>6);
  const int q0=qb*QB;
  const bf16*Qw=Qp+(long)(q0+wid*QBLK)*PP;
  const unsigned lds0=(unsigned)(uintptr_t)shm;
  float*wsf=(float*)(shm+LDS_WS)+wid*64;
  const unsigned kvoff=(unsigned)(lane*PP+wid*8)*2u;
  const unsigned vvoff=(unsigned)((16*(wid&3)+(lane>>2))*PP+(wid>>2)*32+(lane&3)*8)*2u;
  const unsigned kdst=lds0+LDS_K+wid*1024, vdst=lds0+LDS_V+wid*1024;
  #define DMA_K(t,slot) glds16b(srd,kvoff,(unsigned)__builtin_amdgcn_readfirstlane(kbyte+(unsigned)(t)*(KVBLK*PP*2)),(unsigned)__builtin_amdgcn_readfirstlane(kdst+(slot)))
  #define DMA_V(t,slot) do{ const unsigned so_=(unsigned)__builtin_amdgcn_readfirstlane(vbyte+(unsigned)(t)*(KVBLK*PP*2)); glds16b(srd,vvoff,so_,(unsigned)__builtin_amdgcn_readfirstlane(vdst+2*(slot))); glds16b(srd,vvoff,so_+(unsigned)(SEQ*PP*2),(unsigned)__builtin_amdgcn_readfirstlane(vdst+2*(slot)+8192)); }while(0)
  const int vb0=(int)(lds0+LDS_V)+((lane>>4)&1)*32+(lane&3)*8+(4*hi+((lane&15)>>2))*64;
  const char*Kbase=shm+LDS_K; bf16x8 kf[8];
  const lds_cptr shm3=(lds_cptr)shm; const lds_cptr kp0=shm3+LDS_K+hi*1024+r32*16; const lds_cptr vp0=shm3+LDS_V+((lane>>4)&1)*32+(lane&3)*8+(4*hi+((lane&15)>>2))*64;
  DMA_K(0,0);DMA_V(0,0);DMA_K(1,SLOTB);
  bf16x8 qr[4];
  #pragma unroll
  for(int d0=0;d0<4;++d0)qr[d0]=*reinterpret_cast<const bf16x8*>(&Qw[(long)r32*PP+d0*16+hi*8]);
  float mhat=0.f,l_reg=0.f;f32x16 o[4];zero16(o[0]);zero16(o[1]);zero16(o[2]);zero16(o[3]);f32x16 negm;zero16(negm);
  if(SB){ _Pragma("unroll") for(int r=0;r<16;++r)negm[r]=-mub; asm volatile("":"+v"(negm)); }
  bool resc=false;
  #define RESC() do{ if(!SB && resc){ asm volatile("s_waitcnt lgkmcnt(0)":::"memory"); \
      _Pragma("unroll") for(int d_=0;d_<4;++d_) _Pragma("unroll") for(int r=0;r<16;++r)o[d_][r]*=wsf[crow(r,hi)]; } }while(0)
  f32x16 pA0,pA1,pB0,pB1;
  int sl_prev=0,sl_cur=0,sl_next=SLOTB;
  DMA_K(2,2*SLOTB);
  WAIT_BAR(4);
  qkt(pA0,pA1,Kbase,qr,negm,r32,hi);asm volatile("s_nop 15\n\ts_nop 7":"+v"(pA0),"+v"(pA1));
  if(SB){ _Pragma("unroll") for(int r=0;r<16;++r)pA0[r]=__builtin_amdgcn_exp2f(pA0[r]); } else { START(pA0,pA1); }
  _Pragma("unroll") for(int r=0;r<16;++r)pA1[r]=__builtin_amdgcn_exp2f(pA1[r]);
  WAIT_BAR(0);
  DMA_K(3,0);DMA_V(1,SLOTB);
  ROT();
  kload8(kf,kp0+sl_cur);
  WAIT_BAR(3);
  s16x4 vfl[4],vfh[4]; u32x4 pw0,pw1,pw2,pw3;
  #define VFRB(g) (bf16x8){vfl[(g)&3][0],vfl[(g)&3][1],vfl[(g)&3][2],vfl[(g)&3][3],vfh[(g)&3][0],vfh[(g)&3][1],vfh[(g)&3][2],vfh[(g)&3][3]}
  #define VRDB(g) do{ vfl[(g)&3]=vtr(vp_+(((g)&3)*4096+((g)>>2)*1024)); vfh[(g)&3]=vtr(vp_+(((g)&3)*4096+((g)>>2)*1024+512)); }while(0)
  #define GAPB2(g,X,B) do{ o[(g)&3]=MF32(PAF4((g)>>2),VFRB(g),o[(g)&3]); X[B]=EX(X[B]); X[B+1]=EX(X[B+1]); PIN(X); SBAR(); }while(0)
  #define PAF4(k) ((k)==0?PAF(0):(k)==1?PAF(1):(k)==2?PAF(2):PAF(3))
  #define STEPB(C0,C1,P0,P1,t,GK,GV,GL) do{ SBAR(); \
    const lds_cptr vp_=vp0+2*sl_prev; \
    float sacc=(P0[0]+P0[1]); \
    GAPA(C0=MF32(kf[0],qr[0],negm), P0[2],P0[3],P0[4],P0[5],     pw0[0]=PKW(P0,0), pw0[1]=PKW(P0,2), pw0); \
    GAPA(C1=MF32(kf[1],qr[0],negm), P0[6],P0[7],P0[8],P0[9],     pw0[2]=PKW(P0,4), pw0[3]=PKW(P0,6), pw0); \
    GAPA(C0=MF32(kf[2],qr[1],C0),   P0[10],P0[11],P0[12],P0[13], pw1[0]=PKW(P0,8), pw1[1]=PKW(P0,10), pw1); \
    GAPA(C1=MF32(kf[3],qr[1],C1),   P0[14],P0[15],P1[0],P1[1],   pw1[2]=PKW(P0,12),pw1[3]=PKW(P0,14), pw1); \
    GAPA(C0=MF32(kf[4],qr[2],C0),   P1[2],P1[3],P1[4],P1[5],     pw2[0]=PKW(P1,0), pw2[1]=PKW(P1,2), pw2); \
    GAPA(C1=MF32(kf[5],qr[2],C1),   P1[6],P1[7],P1[8],P1[9],     pw2[2]=PKW(P1,4), pw2[3]=PKW(P1,6), pw2); \
    GAPA(C0=MF32(kf[6],qr[3],C0),   P1[10],P1[11],P1[12],P1[13], pw3[0]=PKW(P1,8), pw3[1]=PKW(P1,10), pw3); \
    GAPA(C1=MF32(kf[7],qr[3],C1),   P1[14],P1[15],0.f,0.f,       pw3[2]=PKW(P1,12),pw3[3]=PKW(P1,14), pw3); \
    l_reg+=sacc; \
    if(GK){DMA_K((t)+3,sl_cur);} if(GV){DMA_V((t)+1,sl_next);} \
    VRDB(0); VRDB(1); SBAR(); \
    if(!SB){ DECIDE(C0,C1); } \
    SBAR(); __builtin_amdgcn_s_setprio(1); \
    VRDB(2);  SBAR(); GAPB2(0, C0,0); \
    VRDB(3);  SBAR(); GAPB2(1, C0,2); \
    VRDB(4);  SBAR(); GAPB2(2, C0,4); \
    VRDB(5);  SBAR(); GAPB2(3, C0,6); \
    KRD(GL,0); VRDB(6);  SBAR(); GAPB2(4, C0,8); \
    VRDB(7);  SBAR(); GAPB2(5, C0,10); \
    KRD(GL,1); VRDB(8);  SBAR(); GAPB2(6, C0,12); \
    VRDB(9);  SBAR(); GAPB2(7, C0,14); \
    KRD(GL,2); VRDB(10); SBAR(); GAPB2(8, C1,0); \
    VRDB(11); SBAR(); GAPB2(9, C1,2); \
    KRD(GL,3); VRDB(12); SBAR(); GAPB2(10,C1,4); \
    VRDB(13); SBAR(); GAPB2(11,C1,6); \
    VRDB(14); SBAR(); GAPB2(12,C1,8); \
    VRDB(15); SBAR(); GAPB2(13,C1,10); \
    GAPB2(14,C1,12); \
    GAPB2(15,C1,14); __builtin_amdgcn_s_setprio(0); \
    }while(0)
  int t=1;
  asm volatile(".p2align 8\n\t.fill 4, 4, 0xbf800000");
  for(;t+5<NT;t+=2){
    STEPB(pB0,pB1,pA0,pA1,t,true,true,true);     WAIT_BAR(3); RESC(); ROT();
    STEPB(pA0,pA1,pB0,pB1,t+1,true,true,true);   WAIT_BAR(3); RESC(); ROT();
  }
  #define ENDW(tt) do{ if((tt)+3<NT){WAIT_BAR(3);} else if((tt)+2<NT){WAIT_BAR(2);} else {WAIT_BAR(0);} }while(0)
  for(;t+1<NT;t+=2){
    STEPB(pB0,pB1,pA0,pA1,t,(t+3<NT),(t+1<NT),(t+1<NT));       ENDW(t);   RESC(); ROT();
    STEPB(pA0,pA1,pB0,pB1,t+1,(t+4<NT),(t+2<NT),(t+2<NT));     ENDW(t+1); RESC(); ROT();
  }
  STEPB(pB0,pB1,pA0,pA1,NT-1,false,false,false); RESC();
  { float sacc=pB0[0]+pB0[1]; _Pragma("unroll") for(int r=2;r<16;++r)sacc+=pB0[r]; _Pragma("unroll") for(int r=0;r<16;++r)sacc+=pB1[r]; l_reg+=sacc;
    pw0=(u32x4){PKW(pB0,0),PKW(pB0,2),PKW(pB0,4),PKW(pB0,6)};pw1=(u32x4){PKW(pB0,8),PKW(pB0,10),PKW(pB0,12),PKW(pB0,14)};pw2=(u32x4){PKW(pB1,0),PKW(pB1,2),PKW(pB1,4),PKW(pB1,6)};pw3=(u32x4){PKW(pB1,8),PKW(pB1,10),PKW(pB1,12),PKW(pB1,14)};
    SBAR(); pv<4>(o,vb0+2*sl_cur,PAF(0),PAF(1),PAF(2),PAF(3)); }
  #undef VFRB
  #undef VRDB
  #undef GAPB2
  #undef PAF4
  #undef STEPB
  #undef ENDW
  {auto rr=__builtin_amdgcn_permlane32_swap(__float_as_uint(l_reg),__float_as_uint(l_reg),false,false);l_reg=__uint_as_float(rr[0])+__uint_as_float(rr[1]);}
  if(hi==0)wsf[32+r32]=l_reg;asm volatile("s_waitcnt lgkmcnt(0)":::"memory");
  float rli[16];
  #pragma unroll
  for(int r=0;r<16;++r)rli[r]=__builtin_amdgcn_rcpf(wsf[32+crow(r,hi)]);
  int lane_e=lane; asm volatile("":"+v"(lane_e));
  const int r32e=lane_e&31, hie=lane_e>>5;
  float*scw=sc+(long)wid*4096+lane_e;
  if(comp==0){
    #pragma unroll
    for(int d0=0;d0<4;++d0)
      #pragma unroll
      for(int r=0;r<16;++r)scw[(d0*16+r)*64]=o[d0][r]*rli[r];
  } else {
    float ssq[16];
    #pragma unroll
    for(int r=0;r<16;++r)ssq[r]=0.f;
    #pragma unroll
    for(int d0=0;d0<4;++d0)
      #pragma unroll
      for(int r=0;r<16;++r){ const float dv=scw[(d0*16+r)*64]-lam*(o[d0][r]*rli[r]); o[d0][r]=dv; ssq[r]+=dv*dv; }
    #pragma unroll
    for(int r=0;r<16;++r){ float s=ssq[r]; s+=__shfl_xor(s,1); s+=__shfl_xor(s,2); s+=__shfl_xor(s,4); s+=__shfl_xor(s,8); s+=__shfl_xor(s,16); ssq[r]=__builtin_amdgcn_rsqf(s*(1.0f/128.0f)+1e-5f)*0.8f; }
    float gsub[4];
    #pragma unroll
    for(int d0=0;d0<4;++d0)gsub[d0]=subg[d0*32+r32e];
    bf16*Ow=Ob+(long)(q0+wid*QBLK)*OPITCH;
    bf16*stg=(bf16*)(shm+LDS_OST)+wid*4096;
    #pragma unroll
    for(int r=0;r<16;++r){const int orow=crow(r,hie);
      #pragma unroll
      for(int d0=0;d0<4;++d0)stg[orow*128+d0*32+r32e]=__float2bfloat16(o[d0][r]*ssq[r]*gsub[d0]);}
    asm volatile("s_waitcnt lgkmcnt(0)":::"memory");
    #pragma unroll
    for(int i=0;i<8;++i){const int row=i*4+(lane_e>>4),ch=lane_e&15; const u32x4 v=*(const u32x4*)(stg+row*128+ch*8); ATTN_STORE16(Ow+(long)row*OPITCH+ch*8,v);}
  }
  asm volatile("s_waitcnt vmcnt(0) lgkmcnt(0)\n\ts_barrier":::"memory");
  #undef DMA_K
  #undef DMA_V
  #undef RESC
}
#undef PKW
#undef PAF
#undef PIN
#undef MX3
#undef EX
#undef MF32
#undef GAPA
#undef ROT
#undef DECIDE
#undef START
#undef KRD
#undef SBAR
#undef WAIT_BAR
constexpr int ATTN_LDS_BYTES=LDS_BYTES;
}
constexpr int NWAVES = 8;
#ifndef MK_N_LAUNCHES
#define MK_N_LAUNCHES 1
#endif
constexpr int PER_PHASE = 7;
constexpr int N_LAUNCHES = MK_N_LAUNCHES;
static_assert(N_LAUNCHES == 1 || N_LAUNCHES == PER_PHASE, "MK_N_LAUNCHES is 1 or 7");

constexpr int M = 16384, DM = 1024, NIN = 2304, NQ = 2048, NEXP = 16384;
constexpr float C2 = 0.125f * 1.4426950408889634f;
constexpr float NORM_EPS = 1e-6f;

constexpr size_t MiB = 1u << 20;
constexpr size_t WS_CTL = 0, CTL_ZERO_BYTES = 1 * MiB;
constexpr size_t WS_TROW = 1 * MiB, WS_TCOL = 1 * MiB + 65536, WS_TPOS = 1 * MiB + 524288;
constexpr size_t WS_SK = 3 * MiB;
constexpr size_t WS_SSQ = 4 * MiB;
constexpr size_t WS_INVS = 5 * MiB;
constexpr size_t WS_WIN = 6 * MiB, WS_WOUT = 11 * MiB, WS_WQ = 13 * MiB;
constexpr size_t WS_UV8 = 32 * MiB;
constexpr int EROW = 512;
constexpr size_t V4_OFF = 8 * MiB;
constexpr size_t WS_SCL = 5 * MiB + 524288;
constexpr size_t WS_XN = 96 * MiB;
constexpr size_t WS_QKV = 128 * MiB;
constexpr size_t WS_AO = 200 * MiB;
constexpr size_t WS_META = 232 * MiB;
constexpr size_t WS_END = 248 * MiB;
constexpr int CW_TMO = 0, CW_CODE = 1, CW_BAR = 4096;

constexpr int RING_OFF = 0, RING_BYTES = 147456;
constexpr int LDSCTL_OFF = RING_BYTES, MISC_OFF = LDSCTL_OFF + 320;
constexpr int LDS_BYTES = RING_BYTES + 4096;
static_assert(attn_body::ATTN_LDS_BYTES <= RING_BYTES && pg8::STAGE_BYTES <= RING_BYTES, "LDS map");

#define GAS __attribute__((address_space(1)))
#define LAS __attribute__((address_space(3)))
typedef unsigned short bf16;
typedef unsigned v4u __attribute__((ext_vector_type(4)));
typedef unsigned v2u __attribute__((ext_vector_type(2)));
typedef float f32x4 __attribute__((ext_vector_type(4)));
typedef float f32x16 __attribute__((ext_vector_type(16)));
typedef short bf16x8 __attribute__((ext_vector_type(8)));
typedef __bf16 bf16x2_t __attribute__((ext_vector_type(2)));
typedef GAS unsigned gu32;
#define RLX_AGENT __ATOMIC_RELAXED, __HIP_MEMORY_SCOPE_AGENT
#define LDS_WAIT() asm volatile("s_waitcnt lgkmcnt(0)" ::: "memory")
#define VM_WAIT() asm volatile("s_waitcnt vmcnt(0)" ::: "memory")
__device__ __forceinline__ unsigned f2bf(float f) { unsigned u = __builtin_bit_cast(unsigned, f); return (u + 0x7fffu + ((u >> 16) & 1u)) >> 16; }
__device__ __forceinline__ unsigned pk2(float lo, float hi) { return f2bf(lo) | (f2bf(hi) << 16); }
#define XB_TMO      128
#define XB_XCNT(j)  (256  + 64 * (j))
#define XB_XSUB(j)  (1280 + 64 * (j))
#define XB_XGEN(j)  (2304 + 64 * (j))
#define XB_TOP      3328
#define XB_TOPGEN   3392
#define XCD_BAR_WORDS 3456
#define XB_SPIN_CAP (1u << 18)

__device__ __forceinline__ unsigned xb_ld(unsigned* p)              { return __hip_atomic_load(p, __ATOMIC_RELAXED, __HIP_MEMORY_SCOPE_AGENT); }
__device__ __forceinline__ unsigned xb_add(unsigned* p, unsigned v) { return __hip_atomic_fetch_add(p, v, __ATOMIC_RELAXED, __HIP_MEMORY_SCOPE_AGENT); }
__device__ __forceinline__ unsigned xb_xcc_id() { return (unsigned)__builtin_amdgcn_s_getreg((3 << 11) | 20) & 0xFu; }
#define XB_SPIN(cond, bar) do { unsigned _sp = 0; while (cond) { __builtin_amdgcn_s_sleep(1); \
    if ((++_sp & 255u) == 0u) { if (xb_ld(&(bar)[XB_TMO])) break; if (_sp > XB_SPIN_CAP) { atomicAdd(&(bar)[XB_TMO], 1u); break; } } } } while (0)

struct XcdBarrier {
    unsigned* bar; unsigned x;
    volatile LAS unsigned* st;
};

__device__ __forceinline__ XcdBarrier xcd_barrier_post(unsigned* bar, volatile LAS unsigned* st) {
    XcdBarrier b; b.bar = bar; b.x = xb_xcc_id(); b.st = st;
    if (threadIdx.x == 0) (void)xb_add(&bar[XB_XCNT(b.x)], 1u);
    return b;
}
__device__ __forceinline__ void xcd_barrier_complete(unsigned* bar, unsigned x, unsigned& nloc, unsigned& nx) {
    const unsigned G = gridDim.x * gridDim.y * gridDim.z;
    unsigned sum, cnt, mine, sp = 0u;
    for (;;) {
        sum = 0u; cnt = 0u; mine = 0u;
#pragma unroll
        for (unsigned j = 0; j < 16; ++j) { const unsigned c = xb_ld(&bar[XB_XCNT(j)]); sum += c; cnt += (c > 0u) ? 1u : 0u; mine = (j == x) ? c : mine; }
        if (sum == G) break;
        __builtin_amdgcn_s_sleep(1);
        if ((++sp & 255u) == 0u) { if (xb_ld(&bar[XB_TMO])) break; if (sp > XB_SPIN_CAP) { atomicAdd(&bar[XB_TMO], 1u); break; } }
    }
    nloc = mine > 0u ? mine : 1u; nx = cnt > 0u ? cnt : 1u;
}

__device__ __forceinline__ void xcd_barrier(const XcdBarrier& b) {
    asm volatile("s_waitcnt vmcnt(0)" ::: "memory");
    __syncthreads();
    if (threadIdx.x == 0) {
        unsigned* bar = b.bar;
        __builtin_amdgcn_s_waitcnt(0);
        unsigned nloc = b.st[0], nx = b.st[1];
        if (nloc == 0u) { xcd_barrier_complete(bar, b.x, nloc, nx); b.st[0] = nloc; b.st[1] = nx; }
        const unsigned old = xb_add(&bar[XB_XSUB(b.x)], 1u);
        const unsigned gen = old / nloc;
        if (old + 1u == (gen + 1u) * nloc) {
            __builtin_amdgcn_fence(__ATOMIC_RELEASE, "agent");
            asm volatile("s_waitcnt vmcnt(0)" ::: "memory");
            const unsigned og = xb_add(&bar[XB_TOP], 1u);
            const unsigned tg = og / nx;
            if (og + 1u == (tg + 1u) * nx) xb_add(&bar[XB_TOPGEN], 1u);
            else XB_SPIN(xb_ld(&bar[XB_TOPGEN]) == tg, bar);
            __builtin_amdgcn_fence(__ATOMIC_ACQUIRE, "agent");
            xb_add(&bar[XB_XGEN(b.x)], 1u);
            asm volatile("s_waitcnt vmcnt(0)" ::: "memory");
        } else {
            XB_SPIN(xb_ld(&bar[XB_XGEN(b.x)]) == gen, bar);
            __builtin_amdgcn_fence(__ATOMIC_ACQUIRE, "agent");
            asm volatile("s_waitcnt vmcnt(0)" ::: "memory");
        }
    }
    __syncthreads();
}
struct Frame {
    LAS unsigned char* lds;
    volatile LAS unsigned* MISC;
    gu32* ctl;
    int tid, lane, wave;
    int vcu, G;
};
struct Args { const float* in[17]; float* out; unsigned char* ws; double inv_ax[16]; double inv_p[8]; int ph_lo, ph_hi, li, pad; };

__device__ __forceinline__ float wave_sum(float v) {
#pragma unroll
    for (int o = 1; o < 64; o <<= 1) v += __shfl_xor(v, o);
    return v;
}
__host__ __device__ __forceinline__ int inproj_dst_col(int j) {
    const int s = j >> 6, d = j & 63; int bj, p;
    if (s < 10) { bj = d >> 5; p = 8 * ((d >> 2) & 3) + 4 * ((d >> 4) & 1) + (d & 3); }
    else if (s >= 12 && s < 28) { if (d < 32) { bj = 0; p = 8 * (2 * (d >> 4) + ((d >> 2) & 1)) + 4 * ((d >> 3) & 1) + (d & 3); } else { bj = 1; p = d - 32; } }
    else { bj = d >> 5; p = d & 31; }
    return (s >> 2) * 256 + bj * 128 + (s & 3) * 32 + p;
}
template <int MODE> __device__ __forceinline__ void p0_transpose_item(const float* W, int K, int N, bf16* WT, const float* kscale, LAS float* scr, int item, int lane) {
    const int nblk = N / 32, kb = item / nblk, nb = item % nblk, k0 = 64 * kb, n0 = 32 * nb;
    { f32x4 w[8];
#pragma unroll
      for (int i = 0; i < 8; ++i) w[i] = *(const GAS f32x4*)(W + (size_t)(k0 + (lane >> 3) + 8 * i) * N + n0 + 4 * (lane & 7));
#pragma unroll
      for (int i = 0; i < 8; ++i) { const int kk = (lane >> 3) + 8 * i; f32x4 v = w[i]; if (MODE == 2) v = v * kscale[k0 + kk];
          LAS float* d = scr + kk * 33 + 4 * (lane & 7); d[0] = v.x; d[1] = v.y; d[2] = v.z; d[3] = v.w; } }
    LDS_WAIT(); asm volatile("" ::: "memory");
    const int c = lane & 7;
#pragma unroll
    for (int j = 0; j < 4; ++j) { const int n = (lane >> 3) + 8 * j; const LAS float* s = scr + (8 * c) * 33 + n;
        v4u o; o.x = pk2(s[0 * 33], s[1 * 33]); o.y = pk2(s[2 * 33], s[3 * 33]); o.z = pk2(s[4 * 33], s[5 * 33]); o.w = pk2(s[6 * 33], s[7 * 33]);
        const int dr = (MODE == 1) ? inproj_dst_col(n0 + n) : (n0 + n);
        *(GAS v4u*)(WT + (size_t)dr * K + k0 + 8 * c) = o; }
    LDS_WAIT(); asm volatile("" ::: "memory");
}
template <bool NORM> __device__ __forceinline__ void p0_row_to_bf16(const float* src, bf16* dst, const float* cscale, int lane) {
    const GAS f32x4* xr = (const GAS f32x4*)src + lane;
    f32x4 v[4]; float s = 0.f;
#pragma unroll
    for (int j = 0; j < 4; ++j) { v[j] = xr[64 * j]; s += (v[j].x * v[j].x + v[j].y * v[j].y) + (v[j].z * v[j].z + v[j].w * v[j].w); }
    float rstd = 1.f;
    if (NORM) rstd = __builtin_amdgcn_rsqf(wave_sum(s) * (1.f / DM) + NORM_EPS);
    GAS unsigned long long* o8 = (GAS unsigned long long*)dst + lane;
#pragma unroll
    for (int j = 0; j < 4; ++j) { f32x4 w = v[j] * rstd; if (cscale) w = w * ((const GAS f32x4*)cscale)[lane + 64 * j];
        o8[64 * j] = (unsigned long long)pk2(w.x, w.y) | ((unsigned long long)pk2(w.z, w.w) << 32); }
}
__device__ __forceinline__ void sincos_rev(double ang, float& c, float& s) {
    double rev = ang * 0.15915494309189535; rev -= __builtin_rint(rev);
    const float r = (float)rev; c = __builtin_amdgcn_cosf(r); s = __builtin_amdgcn_sinf(r);
}
__device__ __forceinline__ float wave_max(float v) {
#pragma unroll
    for (int o = 1; o < 64; o <<= 1) v = __builtin_fmaxf(v, __shfl_xor(v, o));
    return v;
}
__device__ __forceinline__ void p0_row_load(const float* src, int lane, f32x4 (&v)[4]) {
    const GAS f32x4* xr = (const GAS f32x4*)src + 4 * lane;
#pragma unroll
    for (int j = 0; j < 4; ++j) v[j] = xr[j];
}
__device__ __forceinline__ float p0_row_finish(f32x4 (&v)[4], unsigned char* dst, const f32x4* cs, int lane) {
    float mx = 0.f;
#pragma unroll
    for (int j = 0; j < 4; ++j) { if (cs) v[j] = v[j] * cs[j];
        mx = __builtin_fmaxf(mx, __builtin_fmaxf(__builtin_fmaxf(__builtin_fabsf(v[j].x), __builtin_fabsf(v[j].y)), __builtin_fmaxf(__builtin_fabsf(v[j].z), __builtin_fabsf(v[j].w)))); }
    mx = wave_max(mx);
    const bool ok = mx > 1e-30f && mx < 1e30f;
    const float sc = ok ? 6.0f / mx : 1.f, isc = ok ? mx * (1.0f / 6.0f) : 1.f;
    unsigned d0 = 0u, d1 = 0u;
    { const f32x4 a = v[0] * sc, b = v[1] * sc, c = v[2] * sc, d = v[3] * sc;
      d0 = __builtin_amdgcn_cvt_scalef32_pk_fp4_f32(d0, a.x, a.y, 1.0f, 0); d0 = __builtin_amdgcn_cvt_scalef32_pk_fp4_f32(d0, a.z, a.w, 1.0f, 1);
      d0 = __builtin_amdgcn_cvt_scalef32_pk_fp4_f32(d0, b.x, b.y, 1.0f, 2); d0 = __builtin_amdgcn_cvt_scalef32_pk_fp4_f32(d0, b.z, b.w, 1.0f, 3);
      d1 = __builtin_amdgcn_cvt_scalef32_pk_fp4_f32(d1, c.x, c.y, 1.0f, 0); d1 = __builtin_amdgcn_cvt_scalef32_pk_fp4_f32(d1, c.z, c.w, 1.0f, 1);
      d1 = __builtin_amdgcn_cvt_scalef32_pk_fp4_f32(d1, d.x, d.y, 1.0f, 2); d1 = __builtin_amdgcn_cvt_scalef32_pk_fp4_f32(d1, d.z, d.w, 1.0f, 3); }
    *(GAS v2u*)(dst + 8 * lane) = (v2u){d0, d1};
    return isc;
}
__device__ __forceinline__ void p0_prologue(Frame& F, const Args& A) {
    unsigned char* ws = A.ws;
    LAS float* scr = (LAS float*)(F.lds + RING_OFF + F.wave * 16384);
    const int gw = F.vcu * NWAVES + F.wave, NGW = F.G * NWAVES;
    { float* tpos = (float*)(ws + WS_TPOS); float* trow = (float*)(ws + WS_TROW); float* tcol = (float*)(ws + WS_TCOL);
      const int gt = F.vcu * (NWAVES * 64) + F.tid, NTH = F.G * NWAVES * 64;
      for (int i = gt; i < M * 8; i += NTH) { const int pos = i >> 3, f = i & 7; float c, s; sincos_rev((double)pos * A.inv_p[f], c, s); tpos[pos * 16 + f] = c; tpos[pos * 16 + 8 + f] = s; }
      for (int i = gt; i < 256 * 16; i += NTH) { const int idx = i >> 4, f = i & 15; float c, s; sincos_rev((double)idx * A.inv_ax[f], c, s); trow[idx * 32 + f] = c; trow[idx * 32 + 16 + f] = s; }
      for (int i = gt; i < 64 * 16; i += NTH) { const int idx = i >> 4, f = i & 15; float c, s; sincos_rev((double)idx * A.inv_ax[f], c, s); tcol[idx * 32 + f] = c; tcol[idx * 32 + 16 + f] = s; }
      const float* sk = A.in[13]; unsigned* skb = (unsigned*)(ws + WS_SK);
      for (int i = gt; i < 8 * 2 * 128 * 128 / 2; i += NTH) skb[i] = pk2(sk[2 * i], sk[2 * i + 1]);
    }
    constexpr int I_IN = (DM / 64) * (NIN / 32);
    for (int it = gw; it < I_IN; it += NGW) p0_transpose_item<1>(A.in[2], DM, NIN, (bf16*)(ws + WS_WIN), nullptr, scr, it, F.lane);
    { f32x4 gsc[4];
#pragma unroll
      for (int j = 0; j < 4; ++j) gsc[j] = ((const GAS f32x4*)A.in[1])[F.lane + 64 * j];
      for (int m0 = gw; m0 < M; m0 += 4 * NGW) {
        f32x4 v[4][4]; float ss[4];
#pragma unroll
        for (int r = 0; r < 4; ++r) { const int m = (m0 + r * NGW < M) ? m0 + r * NGW : m0; const GAS f32x4* xr = (const GAS f32x4*)(A.in[0] + (size_t)m * DM) + F.lane;
#pragma unroll
            for (int j = 0; j < 4; ++j) v[r][j] = xr[64 * j]; }
#pragma unroll
        for (int r = 0; r < 4; ++r) { float s_ = 0.f;
#pragma unroll
            for (int j = 0; j < 4; ++j) s_ += (v[r][j].x * v[r][j].x + v[r][j].y * v[r][j].y) + (v[r][j].z * v[r][j].z + v[r][j].w * v[r][j].w);
            ss[r] = __builtin_amdgcn_rsqf(wave_sum(s_) * (1.f / DM) + NORM_EPS); }
#pragma unroll
        for (int r = 0; r < 4; ++r) { const int m = m0 + r * NGW; if (m < M) { GAS unsigned long long* o8 = (GAS unsigned long long*)((bf16*)(ws + WS_XN) + (size_t)m * DM) + F.lane;
#pragma unroll
            for (int j = 0; j < 4; ++j) { const f32x4 w = v[r][j] * ss[r] * gsc[j]; o8[64 * j] = (unsigned long long)pk2(w.x, w.y) | ((unsigned long long)pk2(w.z, w.w) << 32); } } }
      } }
}
__device__ __forceinline__ void p0_lazy(Frame& F, const Args& A, int gw, int NGW) {
    unsigned char* ws = A.ws;
    LAS float* scr = (LAS float*)(F.lds + RING_OFF + F.wave * 16384);
    constexpr int I_OUT = (DM / 64) * (DM / 32), I_Q = (DM / 64) * (NQ / 32);
    for (int it = gw; it < I_OUT + I_Q; it += NGW) {
        if (it < I_OUT) p0_transpose_item<0>(A.in[10], DM, DM, (bf16*)(ws + WS_WOUT), nullptr, scr, it, F.lane);
        else p0_transpose_item<2>(A.in[12], DM, NQ, (bf16*)(ws + WS_WQ), A.in[11], scr, it - I_OUT, F.lane);
    }
    f32x4 cs[4];
#pragma unroll
    for (int j = 0; j < 4; ++j) cs[j] = ((const GAS f32x4*)A.in[11])[4 * F.lane + j];
    for (int m = gw; m < NEXP; m += 2 * NGW) {
        const int m2 = m + NGW; const bool has2 = m2 < NEXP; const int mb = has2 ? m2 : m;
        f32x4 ua[4], va[4], ub[4], vb[4];
        p0_row_load(A.in[14] + (size_t)m * DM, F.lane, ua); p0_row_load(A.in[15] + (size_t)m * DM, F.lane, va);
        p0_row_load(A.in[14] + (size_t)mb * DM, F.lane, ub); p0_row_load(A.in[15] + (size_t)mb * DM, F.lane, vb);
        asm volatile("" ::: "memory");
        { const float iu = p0_row_finish(ua, ws + WS_UV8 + (size_t)m * EROW, cs, F.lane);
          const float iv = p0_row_finish(va, ws + WS_UV8 + V4_OFF + (size_t)m * EROW, nullptr, F.lane);
          if (F.lane == 0) { float* sc = (float*)(ws + WS_SCL) + 2 * m; sc[0] = iu; sc[1] = iv; } }
        if (has2) { const float iu = p0_row_finish(ub, ws + WS_UV8 + (size_t)m2 * EROW, cs, F.lane);
          const float iv = p0_row_finish(vb, ws + WS_UV8 + V4_OFF + (size_t)m2 * EROW, nullptr, F.lane);
          if (F.lane == 0) { float* sc = (float*)(ws + WS_SCL) + 2 * m2; sc[0] = iu; sc[1] = iv; } }
    }
}

__device__ __forceinline__ void topk_insert(float (&L)[16], float c) {
#pragma unroll
    for (int j = 15; j >= 1; --j) L[j] = __builtin_amdgcn_fmed3f(L[j - 1], L[j], c);
    L[0] = __builtin_fmaxf(L[0], c);
}
__device__ __forceinline__ void cex(float& a, float& b) { const float hi = __builtin_amdgcn_fmed3f(a, b, INFINITY), lo = __builtin_amdgcn_fmed3f(a, b, -INFINITY); a = hi; b = lo; }
__device__ __forceinline__ void sort16_desc(float (&v)[16]) {
    constexpr unsigned char P[60][2] = {{0,13},{1,12},{2,15},{3,14},{4,8},{5,6},{7,11},{9,10},{0,5},{1,7},{2,9},{3,4},{6,13},{8,14},{10,15},{11,12},{0,1},{2,3},{4,5},{6,8},{7,9},{10,11},{12,13},{14,15},
        {0,2},{1,3},{4,10},{5,11},{6,7},{8,9},{12,14},{13,15},{1,2},{3,12},{4,6},{5,7},{8,10},{9,11},{13,14},{1,4},{2,6},{5,8},{7,10},{9,13},{11,14},{2,4},{3,6},{9,12},{11,13},{3,5},{6,8},{7,9},{10,12},
        {3,4},{5,6},{7,8},{9,10},{11,12},{6,7},{8,9}};
#pragma unroll
    for (int k = 0; k < 60; ++k) cex(v[P[k][0]], v[P[k][1]]);
}
__device__ __forceinline__ void merge_top16(float (&a)[16], const float (&b)[16]) {
#pragma unroll
    for (int i = 0; i < 16; ++i) a[i] = __builtin_amdgcn_fmed3f(a[i], b[15 - i], INFINITY);
#pragma unroll
    for (int st = 8; st >= 1; st >>= 1)
#pragma unroll
        for (int i = 0; i < 16; ++i) if ((i & st) == 0) cex(a[i], a[i + st]);
}
__device__ __forceinline__ void p5_topk(Frame& F, const Args& A) {
    unsigned char* ws = A.ws;
    const bf16* QP = (const bf16*)(ws + WS_QKV); const bf16* SK = (const bf16*)(ws + WS_SK); const float* SSQ = (const float*)(ws + WS_SSQ);
    v2u* META = (v2u*)(ws + WS_META); float* INVS = (float*)(ws + WS_INVS);
    const int lane = F.lane, r32 = lane & 31, hi = lane >> 5;
    const int cpg = F.G / 8, h = F.vcu / cpg, cg = F.vcu % cpg;
    { const v4u* src = (const v4u*)(SK + (size_t)h * 2 * 128 * 128);
      for (int i = F.tid; i < 2 * 128 * 16; i += NWAVES * 64) { const int p = i >> 11, key = (i >> 4) & 127, c = i & 15;
          *(LAS v4u*)(F.lds + RING_OFF + (((p * 8 + (c >> 1)) * 2 + (c & 1)) * 2048 + key * 16)) = src[i]; }
      LDS_WAIT(); __syncthreads(); }
    const LAS unsigned char* ska = F.lds + RING_OFF + hi * 2048 + r32 * 16;
    for (int g = cg * NWAVES + F.wave; g < M / 32; g += cpg * NWAVES) {
        const int t = g * 32 + r32;
        const bf16* qp = QP + (size_t)t * NQ + h * 256 + 8 * hi;
        float ss = 0.f;
#pragma unroll
        for (int i = 0; i < 16; ++i) ss += SSQ[(size_t)i * M + t];
        const float rstd = __builtin_amdgcn_rsqf(ss * (1.f / DM) + NORM_EPS);
        float m0[16], m1[16];
#pragma unroll
        for (int p = 0; p < 2; ++p) {
            f32x16 acc[4];
#pragma unroll
            for (int b = 0; b < 4; ++b) acc[b] = f32x16{};
            bf16x8 bq[8];
#pragma unroll
            for (int s = 0; s < 8; ++s) bq[s] = *(const bf16x8*)(qp + p * 128 + 16 * s);
#pragma unroll
            for (int s = 0; s < 8; ++s) {
#pragma unroll
                for (int b = 0; b < 4; ++b) { const bf16x8 ak = *(const LAS bf16x8*)(ska + (p * 8 + s) * 4096 + b * 512); acc[b] = __builtin_amdgcn_mfma_f32_32x32x16_bf16(ak, bq[s], acc[b], 0, 0, 0); }
                if (s & 1) __builtin_amdgcn_sched_barrier(0); }
            float L[16], G[16];
#pragma unroll
            for (int b = 0; b < 4; ++b) {
#pragma unroll
                for (int r = 0; r < 16; ++r) G[r] = __uint_as_float((__float_as_uint(acc[b][r]) & ~127u) | (unsigned)(b * 32 + (r & 3) + 8 * (r >> 2)));
                sort16_desc(G);
                if (b == 0) {
#pragma unroll
                    for (int r = 0; r < 16; ++r) L[r] = G[r];
                } else merge_top16(L, G);
            }
            { const unsigned hi4 = 4u * hi;
#pragma unroll
              for (int j = 0; j < 16; ++j) L[j] = __uint_as_float(__float_as_uint(L[j]) | hi4); }
            float O[16];
#pragma unroll
            for (int j = 0; j < 16; ++j) O[j] = __shfl_xor(L[j], 32);
            merge_top16(L, O);
#pragma unroll
            for (int j = 0; j < 16; ++j) { if (p == 0) m0[j] = L[j]; else m1[j] = L[j]; }
        }
        float T[16];
#pragma unroll
        for (int j = 0; j < 16; ++j) T[j] = -INFINITY;
#pragma unroll
        for (int a = 0; a < 16; ++a)
#pragma unroll
            for (int b = 0; b < 16; ++b) if ((a + 1) * (b + 1) <= 16) { const float v = m0[a] + m1[b]; const unsigned key = (__float_as_uint(v) & ~255u) | (unsigned)(a * 16 + b); topk_insert(T, __uint_as_float(key)); }
        const float thr = T[15], ref = T[0];
        int cnt = 0; float sum = 0.f; const float kk = rstd * 1.4426950408889634f;
        LAS v2u* mst = (LAS v2u*)(F.lds + RING_OFF + 65536 + F.wave * 4096);
        LAS v2u* meta = mst + r32 * 16;
#pragma unroll
        for (int a = 0; a < 16; ++a)
#pragma unroll
            for (int b = 0; b < 16; ++b) if ((a + 1) * (b + 1) <= 16) { const float v = m0[a] + m1[b]; const unsigned key = (__float_as_uint(v) & ~255u) | (unsigned)(a * 16 + b);
                if (__uint_as_float(key) >= thr) { const unsigned idx = ((__float_as_uint(m0[a]) & 127u) << 7) | (__float_as_uint(m1[b]) & 127u);
                    const float e = __builtin_amdgcn_exp2f((v - ref) * kk); if (hi == 0 && cnt < 16) meta[cnt] = (v2u){idx, __float_as_uint(e)}; sum += e; ++cnt; } }
        if (hi == 0) INVS[(size_t)t * 8 + h] = 1.0f / sum;
        LDS_WAIT(); asm volatile("" ::: "memory");
#pragma unroll
        for (int i = 0; i < 4; ++i) { const int ch = i * 64 + lane, tok = ch >> 3, c8 = ch & 7;
            const v4u val = *(const LAS v4u*)((const LAS unsigned char*)mst + tok * 128 + c8 * 16);
            *(v4u*)((unsigned char*)(META + ((size_t)(g * 32 + tok) * 8 + h) * 16) + c8 * 16) = val; }
        LDS_WAIT(); asm volatile("" ::: "memory");
    }
    __syncthreads();
}

typedef float f32x2v __attribute__((ext_vector_type(2)));
__device__ __forceinline__ void axpy16_fp4(f32x2v (&acc)[8], const v2u r, float wj) {
    const f32x2v ww = {wj, wj};
    const unsigned d0 = r.x, d1 = r.y;
    acc[0] = __builtin_amdgcn_cvt_scalef32_pk_f32_fp4(d0, 1.0f, 0) * ww + acc[0]; acc[1] = __builtin_amdgcn_cvt_scalef32_pk_f32_fp4(d0, 1.0f, 1) * ww + acc[1];
    acc[2] = __builtin_amdgcn_cvt_scalef32_pk_f32_fp4(d0, 1.0f, 2) * ww + acc[2]; acc[3] = __builtin_amdgcn_cvt_scalef32_pk_f32_fp4(d0, 1.0f, 3) * ww + acc[3];
    acc[4] = __builtin_amdgcn_cvt_scalef32_pk_f32_fp4(d1, 1.0f, 0) * ww + acc[4]; acc[5] = __builtin_amdgcn_cvt_scalef32_pk_f32_fp4(d1, 1.0f, 1) * ww + acc[5];
    acc[6] = __builtin_amdgcn_cvt_scalef32_pk_f32_fp4(d1, 1.0f, 2) * ww + acc[6]; acc[7] = __builtin_amdgcn_cvt_scalef32_pk_f32_fp4(d1, 1.0f, 3) * ww + acc[7];
}
typedef int v8i_t __attribute__((ext_vector_type(8)));

struct P6Ctx { __amdgpu_buffer_rsrc_t srdU, srdV; const f32x2v* SCL; int lane, lane8, n16, g4; };
__device__ __forceinline__ float p6_sel4(const f32x4 c, int i) { return (i & 2) ? ((i & 1) ? c[3] : c[2]) : ((i & 1) ? c[1] : c[0]); }
__device__ __forceinline__ void p6_flush(f32x2v (&acc)[8], const v2u (&prv)[16], float pw) {
#pragma unroll
    for (int j = 0; j < 16; ++j) axpy16_fp4(acc, prv[j], __uint_as_float(__builtin_amdgcn_readlane(__float_as_uint(pw), (j & 3) + 16 * (j >> 2))));
}
#define P6_ANCHOR(a) do { asm volatile("" : "+v"(a[0]), "+v"(a[1]), "+v"(a[2]), "+v"(a[3]), "+v"(a[4]), "+v"(a[5]), "+v"(a[6]), "+v"(a[7]) :: "memory"); __builtin_amdgcn_sched_barrier(0); } while (0)
#define P6_ROUND(accP, RVN, RVP, PWN, PWP, LSTK, RSTD, XSK) do { \
        const v2u le = (LSTK)[16 * p + n16p]; const unsigned lidx = le.x; const float lgate = __uint_as_float(le.y);        \
        const f32x2v scl = X.SCL[lidx]; \
        v2u ur[16];                                                        \
        _Pragma("unroll") for (int j = 0; j < 16; ++j) { const unsigned ei = __builtin_amdgcn_readlane(lidx, j); \
            ur[j] = __builtin_amdgcn_raw_buffer_load_b64(X.srdU, X.lane8, (int)(ei * EROW), 0); RVN[j] = __builtin_amdgcn_raw_buffer_load_b64(X.srdV, X.lane8, (int)(ei * EROW), 0); } \
        P6_ANCHOR(accP); \
        p6_flush(accP, RVP, PWP);                                          \
        P6_ANCHOR(accP); \
        _Pragma("unroll") for (int j = 0; j < 16; ++j) *(LAS v2u*)(ub + 528 * j + X.lane8) = ur[j];        \
        LDS_WAIT(); asm volatile("" ::: "memory"); \
        f32x4 ca = (f32x4){0.f, 0.f, 0.f, 0.f}, cb = (f32x4){0.f, 0.f, 0.f, 0.f}; \
        _Pragma("unroll") for (int s2 = 0; s2 < 8; ++s2) { const LAS v4u* bp = (const LAS v4u*)((XSK) + 128 * s2 + 16 * X.g4); const v4u b0 = bp[0], b1 = bp[4]; \
            const v4u av = *(const LAS v4u*)(ub + 528 * X.n16 + 64 * s2 + 16 * X.g4);                        \
            const v8i_t b8 = {(int)b0.x, (int)b0.y, (int)b0.z, (int)b0.w, (int)b1.x, (int)b1.y, (int)b1.z, (int)b1.w}; \
            const v8i_t a8 = {(int)av.x, (int)av.y, (int)av.z, (int)av.w, 0, 0, 0, 0}; \
            if (s2 & 1) cb = __builtin_amdgcn_mfma_scale_f32_16x16x128_f8f6f4(a8, b8, cb, 4  , 0  , 0, 0x7F7F7F7F, 0, 0x7F7F7F7F); \
            else        ca = __builtin_amdgcn_mfma_scale_f32_16x16x128_f8f6f4(a8, b8, ca, 4, 0, 0, 0x7F7F7F7F, 0, 0x7F7F7F7F); } \
        ca = ca + cb; \
        const int jL = 4 * X.g4 + (X.n16 & 3); \
        const float d = p6_sel4(ca, X.n16 & 3); \
        const float su = __uint_as_float((unsigned)__builtin_amdgcn_ds_bpermute(4 * jL, (int)__float_as_uint(scl.x))), sv = __uint_as_float((unsigned)__builtin_amdgcn_ds_bpermute(4 * jL, (int)__float_as_uint(scl.y))); \
        const float gt = __uint_as_float((unsigned)__builtin_amdgcn_ds_bpermute(4 * jL, (int)__float_as_uint(lgate))); \
        const float z = d * (RSTD) * su; \
        PWN = gt * (0.5f * z * (1.0f + erff(z * 0.70710678118654752f))) * sv; \
        asm volatile("" : "+v"(PWN) :: "memory"); __builtin_amdgcn_sched_barrier(0); \
    } while (0)
__device__ __forceinline__ void p6_experts(Frame& F, const Args& A) {
    unsigned char* ws = A.ws;
    const bf16* H1B = (const bf16*)(ws + WS_XN);
    const float* SSQ = (const float*)(ws + WS_SSQ); const v2u* META = (const v2u*)(ws + WS_META); const float* INVS = (const float*)(ws + WS_INVS);
    const float* gfin = A.in[16]; float* out = A.out;
    const int lane = F.lane;
    P6Ctx X;
    X.srdU = __builtin_amdgcn_make_buffer_rsrc((void*)(ws + WS_UV8), (short)0, (int)(NEXP * EROW), 0x00020000);
    X.srdV = __builtin_amdgcn_make_buffer_rsrc((void*)(ws + WS_UV8 + V4_OFF), (short)0, (int)(NEXP * EROW), 0x00020000);
    X.SCL = (const f32x2v*)(ws + WS_SCL); X.lane = lane; X.lane8 = lane * 8; X.n16 = lane & 15; X.g4 = lane >> 4;
    LAS unsigned char* xs = F.lds + RING_OFF + F.wave * 16640;
    LAS unsigned char* ub = xs + 8192;
    LAS v2u* lst = (LAS v2u*)(xs + 4096);
    LAS float* rsl = (LAS float*)(F.lds + RING_OFF + NWAVES * 16640 + F.wave * 16);
    const int gw = F.vcu * NWAVES + F.wave, NGW = F.G * NWAVES;
#pragma clang loop unroll(disable)
    for (int t0 = gw; t0 < M; t0 += 4 * NGW) {
        f32x2v acc[4][8];
#define P6_TOKLOAD(kk) do { const int t_ = t0 + (kk) * NGW; const int tc_ = t_ < M ? t_ : t0; int lp_ = lane; asm volatile("" : "+v"(lp_)); \
            n_ma = __builtin_nontemporal_load(&META[(size_t)tc_ * 128 + lp_]); n_mb = __builtin_nontemporal_load(&META[(size_t)tc_ * 128 + 64 + lp_]); n_ia = INVS[(size_t)tc_ * 8 + (lp_ >> 4)]; n_ib = INVS[(size_t)tc_ * 8 + 4 + (lp_ >> 4)]; \
            n_ssl = lp_ < 16 ? SSQ[(size_t)lp_ * M + tc_] : 0.f; { const v4u* xr_ = (const v4u*)(H1B + (size_t)tc_ * DM) + 2 * lp_; n_x0 = __builtin_nontemporal_load(xr_); n_x1 = __builtin_nontemporal_load(xr_ + 1); } } while (0)
        v2u n_ma, n_mb; float n_ia, n_ib, n_ssl; v4u n_x0, n_x1;
        P6_TOKLOAD(0);
#pragma clang loop unroll(disable)
        for (int k = 0; k < 4; ++k) {
            const bool tv = t0 + k * NGW < M;
            const v2u ma = n_ma, mb = n_mb; const float ia = n_ia, ib = n_ib, ssl = n_ssl; const v4u r0 = n_x0, r1 = n_x1;
            P6_TOKLOAD(k < 3 ? k + 1 : 3);
            int lane_p = lane; asm volatile("" : "+v"(lane_p));
            { const unsigned ba = ma.x >> 11, bb = mb.x >> 11; int ra = 0, rb = 0, off = 0;
#pragma unroll
              for (int sb = 0; sb < 8; ++sb) { const unsigned long long m0 = __ballot(ba == (unsigned)sb), m1 = __ballot(bb == (unsigned)sb);
                  const int c0 = __builtin_amdgcn_readfirstlane(__popcll(m0)), c1 = __builtin_amdgcn_readfirstlane(__popcll(m1));
                  const int w0 = off + (int)__builtin_amdgcn_mbcnt_hi((unsigned)(m0 >> 32), __builtin_amdgcn_mbcnt_lo((unsigned)m0, 0u));
                  const int w1 = off + c0 + (int)__builtin_amdgcn_mbcnt_hi((unsigned)(m1 >> 32), __builtin_amdgcn_mbcnt_lo((unsigned)m1, 0u));
                  ra = (ba == (unsigned)sb) ? w0 : ra; rb = (bb == (unsigned)sb) ? w1 : rb; off += c0 + c1; }
              lst[128 * k + ra] = (v2u){ma.x, __float_as_uint(tv ? __uint_as_float(ma.y) * ia : 0.f)};
              lst[128 * k + rb] = (v2u){mb.x, __float_as_uint(tv ? __uint_as_float(mb.y) * ib : 0.f)}; }
            { const float r_ = __builtin_amdgcn_rsqf(wave_sum(ssl) * (1.f / DM) + NORM_EPS); if (lane_p == 0) rsl[k] = r_; }
            { const unsigned xw[8] = {r0.x, r0.y, r0.z, r0.w, r1.x, r1.y, r1.z, r1.w}; v4u xq;
#pragma unroll
              for (int cc = 0; cc < 4; ++cc) { int pk = __builtin_amdgcn_cvt_pk_fp8_f32(__uint_as_float(xw[2 * cc] << 16), __uint_as_float(xw[2 * cc] & 0xffff0000u), 0, false);
                  pk = __builtin_amdgcn_cvt_pk_fp8_f32(__uint_as_float(xw[2 * cc + 1] << 16), __uint_as_float(xw[2 * cc + 1] & 0xffff0000u), pk, true); xq[cc] = (unsigned)pk; }
              *(LAS v4u*)(xs + 1024 * k + 16 * lane_p) = xq; }
        }
#undef P6_TOKLOAD
#pragma unroll
        for (int k = 0; k < 4; ++k)
#pragma unroll
            for (int i = 0; i < 8; ++i) acc[k][i] = (f32x2v){0.f, 0.f};
        LDS_WAIT(); asm volatile("" ::: "memory");
        v2u rvA[16], rvB[16]; float pwA = 0.f, pwB = 0.f;
#pragma unroll
        for (int j = 0; j < 16; ++j) rvB[j] = (v2u){0u, 0u};
#pragma clang loop unroll(disable)
        for (int p = 0; p < 8; ++p) {
            int n16p = X.n16; asm volatile("" : "+v"(n16p));
            P6_ROUND(acc[3], rvA, rvB, pwA, pwB, lst,       rsl[0], xs);
            P6_ROUND(acc[0], rvB, rvA, pwB, pwA, lst + 128, rsl[1], xs + 1024);
            P6_ROUND(acc[1], rvA, rvB, pwA, pwB, lst + 256, rsl[2], xs + 2048);
            P6_ROUND(acc[2], rvB, rvA, pwB, pwA, lst + 384, rsl[3], xs + 3072);
        }
        v4u ex0[4], ex1[4];
        { int lane_x = lane; asm volatile("" : "+v"(lane_x));
#pragma unroll
          for (int k = 0; k < 4; ++k) { const int t_ = t0 + k * NGW; const int tc_ = t_ < M ? t_ : t0; const v4u* xr = (const v4u*)(H1B + (size_t)tc_ * DM) + 2 * lane_x; ex0[k] = __builtin_nontemporal_load(xr); ex1[k] = __builtin_nontemporal_load(xr + 1); } }
        P6_ANCHOR(acc[3]);
        p6_flush(acc[3], rvB, pwB);
        P6_ANCHOR(acc[3]);
        int lane_e = lane; asm volatile("" : "+v"(lane_e));
#pragma unroll
        for (int k = 0; k < 4; ++k) {
            const int t = t0 + k * NGW;
            if (t < M) {
                const v4u r0 = ex0[k], r1 = ex1[k];
                const unsigned xw[8] = {r0.x, r0.y, r0.z, r0.w, r1.x, r1.y, r1.z, r1.w};
                float* hrow = out + (size_t)t * DM + 16 * lane_e;
                f32x4 h[4]; float s2 = 0.f;
#pragma unroll
                for (int i = 0; i < 4; ++i) { h[i] = (f32x4){__uint_as_float(xw[2 * i] << 16), __uint_as_float(xw[2 * i] & 0xffff0000u), __uint_as_float(xw[2 * i + 1] << 16), __uint_as_float(xw[2 * i + 1] & 0xffff0000u)}
                                                   + (f32x4){acc[k][2 * i].x, acc[k][2 * i].y, acc[k][2 * i + 1].x, acc[k][2 * i + 1].y};
                    s2 += (h[i].x * h[i].x + h[i].y * h[i].y) + (h[i].z * h[i].z + h[i].w * h[i].w); }
                const float rf = __builtin_amdgcn_rsqf(wave_sum(s2) * (1.f / DM) + NORM_EPS);
#pragma unroll
                for (int i = 0; i < 4; ++i) __builtin_nontemporal_store(h[i] * rf * *(const f32x4*)(gfin + 16 * lane_e + 4 * i), (f32x4*)(hrow + 4 * i));
            }
        }
        LDS_WAIT(); asm volatile("" ::: "memory");
    }
}
#undef P6_ROUND
#undef P6_ANCHOR

__global__ void __launch_bounds__(NWAVES * 64, 2) fwd_kernel(Args args) {
    extern __shared__ __attribute__((aligned(16))) unsigned char lds[];
    Frame F;
    F.lds = (LAS unsigned char*)lds;
    F.MISC = (volatile LAS unsigned*)(F.lds + MISC_OFF);
    F.tid = threadIdx.x; F.lane = F.tid & 63; F.wave = __builtin_amdgcn_readfirstlane(F.tid >> 6);
    F.G = gridDim.x; { const int bx = blockIdx.x; F.vcu = (F.G % 8 == 0) ? (bx % 8) * (F.G / 8) + bx / 8 : bx; }
    unsigned char* ws = args.ws;
    F.ctl = (gu32*)(ws + WS_CTL);
    for (int u = F.tid; u < (LDS_BYTES - LDSCTL_OFF) / 4; u += NWAVES * 64) ((LAS unsigned*)(F.lds + LDSCTL_OFF))[u] = 0u;
    __syncthreads();
    XcdBarrier bar; bar.bar = (unsigned*)(F.ctl + CW_BAR); bar.x = 0; bar.st = nullptr;
    if (N_LAUNCHES != PER_PHASE) bar = xcd_barrier_post((unsigned*)(F.ctl + CW_BAR), F.MISC + 8);
#define GRID_BAR() do { if (N_LAUNCHES != PER_PHASE) xcd_barrier(bar); } while (0)
    const int lo = args.ph_lo, hi = args.ph_hi;
#ifndef PH_MASK
#define PH_MASK 0x7f
#endif
#define IN(k) (((PH_MASK >> (k)) & 1) && lo <= (k) && (k) < hi)
#define BOTH(k) (IN(k) && IN((k) + 1))

    if (IN(0)) { p0_prologue(F, args); if (BOTH(0)) GRID_BAR(); }

    if (IN(1)) {
        pg8::Gemm g{(const pg8::bf16_t*)(ws + WS_XN), (const pg8::bf16_t*)(ws + WS_WIN), M, NIN, DM}; pg8::StaticOrder S; S.init(M, NIN, F.G, (int)blockIdx.x);
        pg8::EpiInProj E{(pg8::bf16_t*)(ws + WS_QKV), args.in[3], args.in[4], (const float*)(ws + WS_TROW), (const float*)(ws + WS_TCOL), (const float*)(ws + WS_TPOS), C2, (unsigned*)(ws + WS_CTL) + 65536};
        pg8::gemm_phase<pg8::EpiInProj, pg8::StaticOrder, true, true>(F.lds + RING_OFF, g, S, E);
        { const int nfull = (M / 256) * (NIN / 256) % F.G;
          if (nfull == 0) p0_lazy(F, args, F.vcu * NWAVES + F.wave, F.G * NWAVES);
          else if ((int)blockIdx.x >= nfull) p0_lazy(F, args, ((int)blockIdx.x - nfull) * NWAVES + F.wave, (F.G - nfull) * NWAVES); }
        if (BOTH(1)) GRID_BAR();
    }

    if (IN(2)) {
        using abf = attn_body::bf16;
        const abf* planes = (const abf*)(ws + WS_QKV); abf* AO = (abf*)(ws + WS_AO);
        constexpr size_t PL = (size_t)M * 64;
        const __amdgpu_buffer_rsrc_t srd = __builtin_amdgcn_make_buffer_rsrc((void*)(ws + WS_QKV), (short)0, (int)(36 * PL * 2), 0x00020000);
#ifndef NO_A
        const float mub = C2 * 64.0f * 1.02f * wave_max(__builtin_fabsf(args.in[3][F.lane])) * wave_max(__builtin_fabsf(args.in[4][F.lane]));
        const bool sbound = mub < 60.0f;
        for (int ua = F.vcu * 2; ua < 512; ua += F.G * 2)
            for (int k = 0; k < 2; ++k) { const int hA = (ua + k) >> 6, qb = (ua + k) & 63;
                attn_body::attn_unit_a<8>(qb, planes + (size_t)hA * PL, srd, (unsigned)((8 + (hA >> 2)) * PL * 2), (unsigned)((10 + (hA >> 2)) * PL * 2), AO + hA * 64, (char*)lds + RING_OFF, sbound ? mub : 0.f, sbound); }
#endif
        const float d1 = wave_sum(args.in[5][F.lane] * args.in[6][F.lane]), d2 = wave_sum(args.in[7][F.lane] * args.in[8][F.lane]);
        const float lam = __expf(d1) - __expf(d2) + 0.2f;
        float* sc = (float*)(ws + WS_XN) + (size_t)F.vcu * (NWAVES * 4096);
#ifndef NO_B
        for (int ub = F.vcu; ub < 256; ub += F.G) { const int hB = ub >> 6, qb = ub & 63;
            for (int comp = 0; comp < 2; ++comp) {
                const unsigned* nmax = (const unsigned*)(ws + WS_CTL) + 65536;
                const float mb = 1.02f * __builtin_sqrtf(__uint_as_float(nmax[12 + 2 * hB + comp]) * __uint_as_float(nmax[20 + 2 * hB + comp]));
                const bool sb = mb < 60.0f;
                attn_body::attn_unit_b<8>(qb, comp, planes + (size_t)(12 + 2 * hB + comp) * PL, srd, (unsigned)((20 + 2 * hB + comp) * PL * 2), (unsigned)((28 + 2 * hB) * PL * 2),
                                          sc, lam, args.in[9], AO + 512 + hB * 128, (char*)lds + RING_OFF, sb ? mb : 0.f, sb); } }
#endif
        if (BOTH(2)) GRID_BAR();
    }

    if (IN(3)) {
        pg8::Gemm g{(const pg8::bf16_t*)(ws + WS_AO), (const pg8::bf16_t*)(ws + WS_WOUT), M, DM, DM}; pg8::StaticOrder S; S.init(M, DM, F.G, (int)blockIdx.x);
        pg8::EpiOutProj E{args.in[0], args.out, (pg8::bf16_t*)(ws + WS_XN), (float*)(ws + WS_SSQ)};
        pg8::gemm_phase<pg8::EpiOutProj, pg8::StaticOrder, true, true>(F.lds + RING_OFF, g, S, E);
        if (BOTH(3)) GRID_BAR();
    }

    if (IN(4)) {
        pg8::Gemm g{(const pg8::bf16_t*)(ws + WS_XN), (const pg8::bf16_t*)(ws + WS_WQ), M, NQ, DM}; pg8::StaticOrder S; S.init(M, NQ, F.G, (int)blockIdx.x);
        pg8::EpiBf16 E{(pg8::bf16_t*)(ws + WS_QKV), NQ};
        pg8::gemm_phase<pg8::EpiBf16, pg8::StaticOrder, true, true>(F.lds + RING_OFF, g, S, E);
        if (BOTH(4)) GRID_BAR();
    }

    if (IN(5)) { p5_topk(F, args); if (BOTH(5)) GRID_BAR(); }

    if (IN(6)) { p6_experts(F, args); }
#undef IN
#undef BOTH
#undef GRID_BAR
}

extern "C" void kernel_launch(void* const* d_in, const int* in_sizes, int n_in, void* d_out, int out_size, void* d_ws, size_t ws_size, hipStream_t stream) {
    static int grid = 0;
    if (grid == 0) {
        if (n_in != 17 || in_sizes[0] != M * DM || out_size != M * DM || ws_size < WS_END) { fprintf(stderr, "kernel_launch: unexpected shapes (n_in %d, in0 %d, out %d, ws %zu); nothing launched\n", n_in, n_in > 0 ? in_sizes[0] : -1, out_size, ws_size); grid = -1; return; }
        int dev = 0, cus = 0, per_cu = 0;
        if (hipGetDevice(&dev) != hipSuccess || hipDeviceGetAttribute(&cus, hipDeviceAttributeMultiprocessorCount, dev) != hipSuccess) { fprintf(stderr, "kernel_launch: device query failed\n"); grid = -1; return; }
        if (hipFuncSetAttribute((const void*)fwd_kernel, hipFuncAttributeMaxDynamicSharedMemorySize, LDS_BYTES) != hipSuccess) { fprintf(stderr, "kernel_launch: hipFuncSetAttribute failed\n"); grid = -1; return; }
        if (hipOccupancyMaxActiveBlocksPerMultiprocessor(&per_cu, (const void*)fwd_kernel, NWAVES * 64, LDS_BYTES) != hipSuccess || per_cu < 1)
            fprintf(stderr, "kernel_launch: note: occupancy query reports %d workgroups per CU\n", per_cu);
        (void)hipGetLastError();
        grid = cus;
        if (grid != 256) { fprintf(stderr, "kernel_launch: built for a 256-CU device, found %d CUs; nothing launched\n", cus); grid = -1; return; }
    }
    if (grid < 0) return;
    if (hipMemsetAsync((char*)d_ws + WS_CTL, 0, CTL_ZERO_BYTES, stream) != hipSuccess) { fprintf(stderr, "kernel_launch: hipMemsetAsync failed\n"); return; }
    Args a{};
    for (int i = 0; i < 17; ++i) a.in[i] = (const float*)d_in[i];
    a.out = (float*)d_out; a.ws = (unsigned char*)d_ws;
    for (int i = 0; i < 16; ++i) a.inv_ax[i] = pow(10000.0, -(2.0 * i) / 32.0);
    for (int i = 0; i < 8; ++i) a.inv_p[i] = pow(500000.0, -(2.0 * i) / 16.0);
#ifdef PHASE_LIST
    static const int plist[] = {PHASE_LIST}; constexpr int NL = sizeof(plist) / sizeof(int);
#else
    constexpr int NL = N_LAUNCHES;
#endif
    for (int li = 0; li < NL; ++li) {
#ifdef PHASE_LIST
        a.ph_lo = plist[li]; a.ph_hi = plist[li] + 1; a.li = li;
#else
        a.ph_lo = (N_LAUNCHES == PER_PHASE) ? li : 0; a.ph_hi = (N_LAUNCHES == PER_PHASE) ? li + 1 : PER_PHASE; a.li = li;
#endif
        hipLaunchKernelGGL(fwd_kernel, dim3(grid), dim3(NWAVES * 64), LDS_BYTES, stream, a);
        const hipError_t le = hipPeekAtLastError();
        if (le != hipSuccess) { fprintf(stderr, "kernel_launch: launch %d failed: %s\n", li, hipGetErrorName(le)); break; }
    }
}
```

```cpp
#include <hip/hip_runtime.h>
#include <hip/hip_bf16.h>
#include <cstdio>
#include <cstdint>
#include <cmath>
namespace pg8 {
#define PG8_LAS __attribute__((address_space(3)))
typedef unsigned short bf16_t;
typedef short bf16x8 __attribute__((ext_vector_type(8)));
typedef float f32x4 __attribute__((ext_vector_type(4)));
typedef unsigned u32x4 __attribute__((ext_vector_type(4)));
constexpr int BM = 256, BK = 64, HALF = 128, HTB = HALF * BK * 2  , STAGE_BYTES = 8 * HTB, NXCD = 8, WGM = 8;

__host__ __device__ __forceinline__ int lds_byte(int r, int c) { const int st = (r >> 4) * 2 + (c >> 5), rr = r & 15, cc = c & 31, ob = rr * 64 + cc * 2; return st * 1024 + (ob ^ (((ob >> 9) & 1) << 5)); }
__host__ __device__ __forceinline__ void stage_rc(int b, int& R, int& C) { const int st = b / 1024, sb = b % 1024, swz = sb ^ (((sb >> 9) & 1) << 5); R = (st >> 1) * 16 + swz / 64; C = (st & 1) * 32 + (swz % 64) / 2; }
__host__ __device__ __forceinline__ int perm32(int rho) { const int n = rho >> 4, i = rho & 15; return 8 * (i >> 2) + 4 * n + (i & 3); }

struct Unit { int pm, pn; };
struct Gemm { const bf16_t* A; const bf16_t* Bt; int M, N, K; };

struct StaticOrder {
    int nM, nN, nwg, G, c;
    __host__ __device__ void init(int M, int N, int G_, int c_) { nM = M / BM; nN = N / BM; nwg = nM * nN; G = G_; c = c_; }
    __host__ __device__ bool next(int i, Unit& u) const {
        const long L = (long)i * G + c; if (L >= nwg) return false;
        int wgid = (int)L; { const int q = nwg / NXCD, r = nwg % NXCD, xcd = wgid % NXCD, off = wgid / NXCD; wgid = (xcd < r ? xcd * (q + 1) : r * (q + 1) + (xcd - r) * q) + off; }
        const int nig = WGM * nN, gid = wgid / nig, fm = gid * WGM, gsz = (nM - fm) < WGM ? (nM - fm) : WGM;
        u.pm = fm + ((wgid % nig) % gsz); u.pn = (wgid % nig) / gsz; return true;
    }
    __device__ __forceinline__ void a_ready(const Unit&) const {}
    __device__ __forceinline__ void done(const Unit&) const {}
};

__device__ __forceinline__ unsigned cvt_pk_bf16(float lo, float hi) { unsigned r; asm volatile("v_cvt_pk_bf16_f32 %0, %1, %2" : "=v"(r) : "v"(lo), "v"(hi)); return r; }
typedef float f32x2 __attribute__((ext_vector_type(2)));
typedef unsigned u32x2 __attribute__((ext_vector_type(2)));

struct EpiBf16 {
    static constexpr bool PERM = true, AFTER_DRAIN = false;
    bf16_t* O; int ldc;
    __device__ __forceinline__ void operator()(const f32x4 (&acc)[2][2][4][2], const Unit& u, int wr, int wc, int fr, int fq) const {
        const int row0 = u.pm * BM + wr * 64 + fr; const int col0 = u.pn * BM + wc * 32 + 8 * fq;
#pragma unroll
        for (int ai = 0; ai < 2; ++ai)
#pragma unroll
            for (int m = 0; m < 4; ++m) { bf16_t* rowp = O + (size_t)(row0 + ai * HALF + m * 16) * ldc + col0;
#pragma unroll
                for (int bj = 0; bj < 2; ++bj) { const f32x4 v0 = acc[ai][bj][m][0], v1 = acc[ai][bj][m][1];
                    u32x4 w; w.x = cvt_pk_bf16(v0[0], v0[1]); w.y = cvt_pk_bf16(v0[2], v0[3]); w.z = cvt_pk_bf16(v1[0], v1[1]); w.w = cvt_pk_bf16(v1[2], v1[3]);
                    *(u32x4*)(rowp + bj * HALF) = w; } }
    }
};

__device__ __forceinline__ unsigned pk4_fp8(const f32x4 v, float f) { int p = __builtin_amdgcn_cvt_pk_fp8_f32(v[0] * f, v[1] * f, 0, false); p = __builtin_amdgcn_cvt_pk_fp8_f32(v[2] * f, v[3] * f, p, true); return (unsigned)p; }
struct EpiInProj {
    static constexpr bool PERM = true, AFTER_DRAIN = false;
    bf16_t* planes; const float* qg; const float* kg; const float* trow; const float* tcol; const float* tpos; float c2; unsigned* nmax;
    __device__ __forceinline__ void operator()(const f32x4 (&acc)[2][2][4][2], const Unit& u, int wr, int wc, int fr, int fq) const {
        const int slot = u.pn * 4 + wc;
        bf16_t* plane = planes + (size_t)slot * (16384 * 64);
        const int rowb = u.pm * BM + wr * 64 + fr;
        if (slot < 10) {
            const float* g = slot < 8 ? qg : kg; const float sc = slot < 8 ? c2 : 1.f; const float f8 = slot < 8 ? 8.f : 1.f;
            f32x4 gv[2][2];
#pragma unroll
            for (int bj = 0; bj < 2; ++bj)
#pragma unroll
                for (int n = 0; n < 2; ++n) gv[bj][n] = *(const f32x4*)(g + 32 * bj + 16 * n + 4 * fq);
#pragma unroll
            for (int ai = 0; ai < 2; ++ai)
#pragma unroll
                for (int m = 0; m < 4; ++m) { const int row = rowb + ai * HALF + m * 16;
                    float ss = 0.f;
#pragma unroll
                    for (int bj = 0; bj < 2; ++bj)
#pragma unroll
                        for (int n = 0; n < 2; ++n) { const f32x4 x = acc[ai][bj][m][n]; ss += (x[0] * x[0] + x[1] * x[1]) + (x[2] * x[2] + x[3] * x[3]); }
                    ss += __shfl_xor(ss, 16); ss += __shfl_xor(ss, 32);
                    const float rn = __builtin_amdgcn_rsqf(ss * (1.0f / 64.0f) + 1e-6f);
                    const float* tr = trow + (row >> 6) * 32 + 4 * fq; const float* tc = tcol + (row & 63) * 32 + 4 * fq;
#pragma unroll
                    for (int bj = 0; bj < 2; ++bj) { const float* tb = bj ? tc : tr; const f32x4 c = *(const f32x4*)tb, s = *(const f32x4*)(tb + 16);
                        const f32x4 y0 = acc[ai][bj][m][0] * rn * gv[bj][0], y1 = acc[ai][bj][m][1] * rn * gv[bj][1];
                        const f32x4 o0 = (y0 * c - y1 * s) * sc, o1 = (y1 * c + y0 * s) * sc;
                        u32x2 w; w.x = pk4_fp8(o0, f8); w.y = pk4_fp8(o1, f8);
                        *(u32x2*)((char*)plane + (size_t)row * 64 + 32 * bj + 8 * fq) = w; } }
        } else if (slot >= 12 && slot < 28) {
            const float sc = slot < 20 ? c2 : 1.f; const float f8 = slot < 20 ? 8.f : 1.f; const bool rot = fq < 2; float nm = 0.f;
#pragma unroll
            for (int ai = 0; ai < 2; ++ai)
#pragma unroll
                for (int m = 0; m < 4; ++m) { const int row = rowb + ai * HALF + m * 16;
                    const float* tp = tpos + (size_t)row * 16 + 4 * (fq & 1);
                    f32x4 c = *(const f32x4*)tp, s = *(const f32x4*)(tp + 8);
                    if (!rot) { c = (f32x4){1.f, 1.f, 1.f, 1.f}; s = (f32x4){0.f, 0.f, 0.f, 0.f}; }
                    const f32x4 y0 = acc[ai][0][m][0], y1 = acc[ai][0][m][1];
                    const f32x4 o0 = (y0 * c - y1 * s) * sc, o1 = (y1 * c + y0 * s) * sc;
                    u32x2 w; w.x = pk4_fp8(o0, f8); w.y = pk4_fp8(o1, f8);
                    *(u32x2*)((char*)plane + (size_t)row * 64 + 8 * fq) = w;
                    const f32x4 z0 = acc[ai][1][m][0] * sc, z1 = acc[ai][1][m][1] * sc;
                    u32x2 w2; w2.x = pk4_fp8(z0, f8); w2.y = pk4_fp8(z1, f8);
                    *(u32x2*)((char*)plane + (size_t)row * 64 + 32 + 8 * fq) = w2;
                    float ss = (o0[0] * o0[0] + o0[1] * o0[1]) + (o0[2] * o0[2] + o0[3] * o0[3]) + (o1[0] * o1[0] + o1[1] * o1[1]) + (o1[2] * o1[2] + o1[3] * o1[3])
                             + (z0[0] * z0[0] + z0[1] * z0[1]) + (z0[2] * z0[2] + z0[3] * z0[3]) + (z1[0] * z1[0] + z1[1] * z1[1]) + (z1[2] * z1[2] + z1[3] * z1[3]);
                    ss += __shfl_xor(ss, 16); ss += __shfl_xor(ss, 32); nm = __builtin_fmaxf(nm, ss); }
#pragma unroll
            for (int o = 1; o < 16; o <<= 1) nm = __builtin_fmaxf(nm, __shfl_xor(nm, o));
            if ((fr | fq) == 0) atomicMax(nmax + slot, __float_as_uint(nm));
        } else {
#pragma unroll
            for (int ai = 0; ai < 2; ++ai)
#pragma unroll
                for (int m = 0; m < 4; ++m) { const int row = rowb + ai * HALF + m * 16;
#pragma unroll
                    for (int bj = 0; bj < 2; ++bj) { const f32x4 v0 = acc[ai][bj][m][0], v1 = acc[ai][bj][m][1];
                        u32x4 w; w.x = cvt_pk_bf16(v0[0], v0[1]); w.y = cvt_pk_bf16(v0[2], v0[3]); w.z = cvt_pk_bf16(v1[0], v1[1]); w.w = cvt_pk_bf16(v1[2], v1[3]);
                        *(u32x4*)(plane + (size_t)row * 64 + 32 * bj + 8 * fq) = w; } }
        }
    }
};

struct EpiOutProj {
    static constexpr bool PERM = false, AFTER_DRAIN = false;
    const float* x; float* h1; bf16_t* h1b; float* ssq;
    __device__ __forceinline__ void operator()(const f32x4 (&acc)[2][2][4][2], const Unit& u, int wr, int wc, int fr, int fq) const {
        const int col0 = u.pn * BM + wc * 32 + 4 * fq;
#pragma unroll
        for (int ai = 0; ai < 2; ++ai)
#pragma unroll
            for (int m = 0; m < 4; ++m) { const int row = u.pm * BM + ai * HALF + wr * 64 + m * 16 + fr; const size_t off = (size_t)row * 1024 + col0; float ss = 0.f;
#pragma unroll
                for (int bj = 0; bj < 2; ++bj)
#pragma unroll
                    for (int n = 0; n < 2; ++n) { const size_t o = off + bj * HALF + n * 16; const f32x4 h = *(const f32x4*)(x + o) + acc[ai][bj][m][n];
                        u32x2 w; w.x = cvt_pk_bf16(h[0], h[1]); w.y = cvt_pk_bf16(h[2], h[3]); *(u32x2*)(h1b + o) = w;
                        ss += (h[0] * h[0] + h[1] * h[1]) + (h[2] * h[2] + h[3] * h[3]); }
                ss += __shfl_xor(ss, 16); ss += __shfl_xor(ss, 32);
                if (fq == 0) ssq[(size_t)(u.pn * 4 + wc) * 16384 + row] = ss; }
    }
};

template <class Epi, class Sched, bool ALIGN_EPI = false, bool SP2 = false>
__device__ __forceinline__ void gemm_phase(PG8_LAS unsigned char* lds, const Gemm g, const Sched& S, const Epi& E) {
    const int tid = threadIdx.x, wid = __builtin_amdgcn_readfirstlane(tid >> 6), lane = tid & 63, wr = wid >> 2, wc = wid & 3, fr = lane & 15, fq = lane >> 4;
    const int K = g.K, nt = K / BK;
    unsigned voffA[2], voffB[2];
#pragma unroll
    for (int i = 0; i < 2; ++i) { int R, C; stage_rc(tid * 16 + i * 8192, R, C); const int Rb = Epi::PERM ? ((R & ~31) + perm32(R & 31)) : R;
        voffA[i] = (unsigned)(R * K + C) * 2u; voffB[i] = (unsigned)(Rb * K + C) * 2u; }
    const size_t kstep = (size_t)(BK * 2);
    const size_t hstep = (size_t)HALF * K * 2;
    const size_t tstep = 2 * hstep;
    const unsigned ldsw = (unsigned)wid * 1024u;
    const int aoff = lds_byte(wr * 64 + fr, fq * 8), boff = lds_byte(wc * 32 + fr, fq * 8);
#define PG8_SA(b, h) (((b) * 2 + (h)) * HTB)
#define PG8_SB(b, h) ((4 + (b) * 2 + (h)) * HTB)
#define PG8_STAGE(bufoff, gbase, voff) do { _Pragma("unroll") for (int _i = 0; _i < 2; ++_i) \
        __builtin_amdgcn_global_load_lds((const unsigned*)((const char*)(gbase) + (voff)[_i]), (PG8_LAS unsigned*)(lds + (bufoff) + ldsw + _i * 8192), 16, 0, 0); } while (0)
#define PG8_LDA(dst, b, h) do { _Pragma("unroll") for (int m = 0; m < 4; ++m) _Pragma("unroll") for (int k = 0; k < 2; ++k) dst[m][k] = *(const PG8_LAS bf16x8*)(lds + PG8_SA(b, h) + aoff + m * 2048 + k * 1024); } while (0)
#define PG8_LDB(dst, b, h) do { _Pragma("unroll") for (int n = 0; n < 2; ++n) _Pragma("unroll") for (int k = 0; k < 2; ++k) dst[n][k] = *(const PG8_LAS bf16x8*)(lds + PG8_SB(b, h) + boff + n * 2048 + k * 1024); } while (0)
#define PG8_MMA(ai, bj, At, Bt) do { __builtin_amdgcn_s_setprio(1); _Pragma("unroll") for (int m = 0; m < 4; ++m) _Pragma("unroll") for (int n = 0; n < 2; ++n) _Pragma("unroll") for (int k = 0; k < 2; ++k) \
        acc[ai][bj][m][n] = __builtin_amdgcn_mfma_f32_16x16x32_bf16(Bt[n][k], At[m][k], acc[ai][bj][m][n], 0, 0, 0); __builtin_amdgcn_s_setprio(0); } while (0)
#define PG8_WAIT_V(n) asm volatile("s_waitcnt vmcnt(" #n ")" ::: "memory")
#define PG8_WAIT_L(n) asm volatile("s_waitcnt lgkmcnt(" #n ")" ::: "memory")
#define PG8_BAR __builtin_amdgcn_s_barrier()
#define PG8_SCHED __builtin_amdgcn_sched_barrier(0)
    Unit cur, nxt; int ui = 0;
    if (!S.next(0, cur)) return;
    f32x4 acc[2][2][4][2];
#pragma unroll
    for (int a = 0; a < 2; ++a)
#pragma unroll
        for (int b = 0; b < 2; ++b)
#pragma unroll
            for (int m = 0; m < 4; ++m)
#pragma unroll
                for (int n = 0; n < 2; ++n) acc[a][b][m][n] = (f32x4){0.f, 0.f, 0.f, 0.f};
    bf16x8 At[4][2], B0[2][2], B1[2][2];
    const char* cA = (const char*)g.A + (size_t)cur.pm * tstep; const char* cB = (const char*)g.Bt + (size_t)cur.pn * tstep;
    S.a_ready(cur);
    if constexpr (SP2) {
        PG8_STAGE(PG8_SB(0, 0), cB, voffB); PG8_STAGE(PG8_SB(0, 1), cB + hstep, voffB); PG8_STAGE(PG8_SA(0, 0), cA, voffA); PG8_STAGE(PG8_SA(0, 1), cA + hstep, voffA);
        if (wr == 1) PG8_BAR;
        PG8_WAIT_V(2); PG8_BAR;
        PG8_STAGE(PG8_SB(1, 0), cB + kstep, voffB); PG8_STAGE(PG8_SA(1, 0), cA + kstep, voffA); PG8_STAGE(PG8_SB(1, 1), cB + hstep + kstep, voffB);
        PG8_WAIT_V(6); PG8_BAR;
    } else {
        PG8_STAGE(PG8_SB(0, 0), cB, voffB); PG8_STAGE(PG8_SA(0, 0), cA, voffA); PG8_STAGE(PG8_SB(0, 1), cB + hstep, voffB); PG8_STAGE(PG8_SA(0, 1), cA + hstep, voffA);
        if (wr == 1) PG8_BAR;
        PG8_WAIT_V(4); PG8_BAR;
        PG8_STAGE(PG8_SB(1, 0), cB + kstep, voffB); PG8_STAGE(PG8_SA(1, 0), cA + kstep, voffA); PG8_STAGE(PG8_SB(1, 1), cB + hstep + kstep, voffB);
        PG8_WAIT_V(6); PG8_BAR;
    }
    for (;;) {
        const bool has_next = S.next(ui + 1, nxt);
        const char* nA = has_next ? (const char*)g.A + (size_t)nxt.pm * tstep : cA; const char* nB = has_next ? (const char*)g.Bt + (size_t)nxt.pn * tstep : cB;
        for (int t = 0; t < nt; t += 2) {
            const bool last = (t == nt - 2);
            const char* a1 = cA + (size_t)(t + 1) * kstep;
            const char* a2 = last ? nA : cA + (size_t)(t + 2) * kstep; const char* b2 = last ? nB : cB + (size_t)(t + 2) * kstep;
            const char* a3 = a2 + kstep; const char* b3 = b2 + kstep;
            if (last && has_next) S.a_ready(nxt);
            if constexpr (SP2) {
            PG8_LDB(B0, 0, 0); PG8_LDB(B1, 0, 1); PG8_SCHED; PG8_LDA(At, 0, 0); PG8_STAGE(PG8_SA(1, 1), a1 + hstep, voffA);
            PG8_WAIT_V(8); PG8_WAIT_L(0); PG8_BAR; PG8_MMA(0, 0, At, B0); PG8_MMA(0, 1, At, B1); PG8_BAR; PG8_SCHED;
            PG8_LDA(At, 0, 1); PG8_STAGE(PG8_SB(0, 0), b2, voffB); PG8_STAGE(PG8_SB(0, 1), b2 + hstep, voffB); PG8_STAGE(PG8_SA(0, 0), a2, voffA);
            PG8_WAIT_V(8); PG8_WAIT_L(0); PG8_BAR; PG8_MMA(1, 0, At, B0); PG8_MMA(1, 1, At, B1); PG8_BAR; PG8_SCHED;
            PG8_LDB(B0, 1, 0); PG8_LDB(B1, 1, 1); PG8_SCHED; PG8_LDA(At, 1, 0); PG8_STAGE(PG8_SA(0, 1), a2 + hstep, voffA);
            PG8_WAIT_V(8); PG8_WAIT_L(0); PG8_BAR; PG8_MMA(0, 0, At, B0); PG8_MMA(0, 1, At, B1); PG8_BAR; PG8_SCHED;
            PG8_LDA(At, 1, 1); PG8_STAGE(PG8_SB(1, 0), b3, voffB); PG8_STAGE(PG8_SB(1, 1), b3 + hstep, voffB); PG8_STAGE(PG8_SA(1, 0), a3, voffA);
            PG8_WAIT_V(8); PG8_WAIT_L(0); PG8_BAR; PG8_MMA(1, 0, At, B0); PG8_MMA(1, 1, At, B1); PG8_BAR; PG8_SCHED;
            } else {
            PG8_LDB(B0, 0, 0); PG8_SCHED; PG8_LDA(At, 0, 0); PG8_STAGE(PG8_SA(1, 1), a1 + hstep, voffA);
            PG8_WAIT_L(8); PG8_BAR; PG8_WAIT_L(0); PG8_MMA(0, 0, At, B0); PG8_BAR; PG8_SCHED;
            PG8_LDB(B1, 0, 1); PG8_STAGE(PG8_SB(0, 0), b2, voffB);
            PG8_BAR; PG8_WAIT_L(0); PG8_MMA(0, 1, At, B1); PG8_BAR;
            PG8_LDA(At, 0, 1); PG8_STAGE(PG8_SA(0, 0), a2, voffA);
            PG8_BAR; PG8_WAIT_L(0); PG8_MMA(1, 0, At, B0); PG8_BAR; PG8_SCHED;
            PG8_STAGE(PG8_SB(0, 1), b2 + hstep, voffB);
            PG8_WAIT_V(6); PG8_BAR; PG8_MMA(1, 1, At, B1); PG8_BAR;
            PG8_LDB(B0, 1, 0); PG8_SCHED; PG8_LDA(At, 1, 0); PG8_STAGE(PG8_SA(0, 1), a2 + hstep, voffA);
            PG8_WAIT_L(8); PG8_BAR; PG8_WAIT_L(0); PG8_MMA(0, 0, At, B0); PG8_BAR; PG8_SCHED;
            PG8_LDB(B1, 1, 1); PG8_STAGE(PG8_SB(1, 0), b3, voffB);
            PG8_BAR; PG8_WAIT_L(0); PG8_MMA(0, 1, At, B1); PG8_BAR;
            PG8_LDA(At, 1, 1); PG8_STAGE(PG8_SA(1, 0), a3, voffA);
            PG8_BAR; PG8_WAIT_L(0); PG8_MMA(1, 0, At, B0); PG8_BAR; PG8_SCHED;
            PG8_STAGE(PG8_SB(1, 1), b3 + hstep, voffB);
            PG8_WAIT_V(6); PG8_BAR; PG8_MMA(1, 1, At, B1); PG8_BAR;
            }
        }
        if constexpr (ALIGN_EPI) { if (wr == 0) PG8_BAR; }
        if constexpr (!Epi::AFTER_DRAIN) { E(acc, cur, wr, wc, fr, fq); S.done(cur); }
        if (!has_next) break;
#pragma unroll
        for (int a = 0; a < 2; ++a)
#pragma unroll
            for (int b = 0; b < 2; ++b)
#pragma unroll
                for (int m = 0; m < 4; ++m)
#pragma unroll
                    for (int n = 0; n < 2; ++n) acc[a][b][m][n] = (f32x4){0.f, 0.f, 0.f, 0.f};
        cur = nxt; cA = nA; cB = nB; ++ui;
        if constexpr (ALIGN_EPI) { if (wr == 1) PG8_BAR; }
    }
    PG8_WAIT_V(0);
    if constexpr (!ALIGN_EPI) { if (wr == 0) PG8_BAR; }
    PG8_BAR;
    if constexpr (Epi::AFTER_DRAIN) { E.fused(acc, cur, wr, wc, fr, fq, lds, wid, lane); S.done(cur); }
#undef PG8_SA
#undef PG8_SB
#undef PG8_STAGE
#undef PG8_LDA
#undef PG8_LDB
#undef PG8_MMA
#undef PG8_WAIT_V
#undef PG8_WAIT_L
#undef PG8_BAR
#undef PG8_SCHED
}
}
namespace attn_body {
using bf16=__hip_bfloat16;
using bf16x8=__attribute__((ext_vector_type(8)))short;
using s16x4=__attribute__((ext_vector_type(4)))short;
using f32x16=__attribute__((ext_vector_type(16)))float;
using u32x4=__attribute__((ext_vector_type(4)))unsigned;
constexpr int SEQ=16384,D=64,PP=64;
constexpr int NW=8,QBLK=32,QB=QBLK*NW,KVBLK=64,NQB=SEQ/QB,NT=SEQ/KVBLK;
constexpr int OPITCH=1024;
__device__ __forceinline__ int crow(int r,int hi){return (r&3)+8*(r>>2)+4*hi;}
#define SBAR() __builtin_amdgcn_sched_barrier(0)
constexpr int NSLOT=3, SLOTB=8192;
constexpr int LDS_K=0, LDS_V=NSLOT*SLOTB, LDS_WS=LDS_V+NSLOT*2*SLOTB, LDS_OST=LDS_WS+NW*64*4, LDS_BYTES=LDS_OST+NW*8192;
__device__ __forceinline__ void glds16(const void*gsrc,unsigned lds_dst){unsigned keep;
  asm volatile("s_mov_b32 %0, m0\n\ts_mov_b32 m0, %2\n\ts_nop 0\n\tglobal_load_lds_dwordx4 %1, off\n\ts_mov_b32 m0, %0":"=&s"(keep):"v"(gsrc),"s"(lds_dst):"memory");}
__device__ __forceinline__ void glds16b(__amdgpu_buffer_rsrc_t srd,unsigned voff,unsigned soff,unsigned lds_dst){unsigned keep;
  asm volatile("s_nop 4\n\ts_mov_b32 %0, m0\n\ts_mov_b32 m0, %4\n\ts_nop 0\n\tbuffer_load_dwordx4 %1, %2, %3 offen lds\n\ts_mov_b32 m0, %0":"=&s"(keep):"v"(voff),"s"(srd),"s"(soff),"s"(lds_dst):"memory");}
__device__ __forceinline__ float max3f(float a,float b,float c){float r;asm("v_max3_f32 %0, %1, %2, %3":"=v"(r):"v"(a),"v"(b),"v"(c));return r;}
__device__ __forceinline__ float max2f(float a,float b){float r;asm("v_max_f32_e32 %0, %1, %2":"=v"(r):"v"(a),"v"(b));return r;}
__device__ __forceinline__ float fadd_s(float a,float b){float r;asm("v_add_f32_e32 %0, %1, %2":"=v"(r):"v"(a),"v"(b));return r;}
__device__ __forceinline__ float fsub_s(float a,float b){float r;asm("v_sub_f32_e32 %0, %1, %2":"=v"(r):"v"(a),"v"(b));return r;}
typedef float f32x2_t __attribute__((ext_vector_type(2))); typedef __bf16 bf16x2_t __attribute__((ext_vector_type(2)));
__device__ __forceinline__ unsigned cvtpk_s(float lo,float hi){f32x2_t v={lo,hi};bf16x2_t b=__builtin_convertvector(v,bf16x2_t);return __builtin_bit_cast(unsigned,b);}
#define WAIT_BAR(N) asm volatile("s_waitcnt vmcnt(" #N ") lgkmcnt(0)\n\ts_barrier":::"memory")

__device__ __forceinline__ void zero16(f32x16&x){
  #pragma unroll
  for(int r=0;r<16;++r){float z;asm volatile("v_mov_b32 %0, 0":"=v"(z));x[r]=z;}
}
typedef int v8i_a __attribute__((ext_vector_type(8)));
#define MFQ(a,b,c) __builtin_amdgcn_mfma_scale_f32_32x32x64_f8f6f4(a,b,c,0,0,0,0x7F7F7F7F,0,0x7C7C7C7C)
__device__ __forceinline__ v8i_a kfrag8(__attribute__((address_space(3))) const char* kp,int kt){
  const u32x4 a=*(const __attribute__((address_space(3))) u32x4*)(kp+kt*512), b=*(const __attribute__((address_space(3))) u32x4*)(kp+1024+kt*512);
  return (v8i_a){(int)a.x,(int)a.y,(int)a.z,(int)a.w,(int)b.x,(int)b.y,(int)b.z,(int)b.w};
}
__device__ __forceinline__ void qkt(f32x16&p0,f32x16&p1,__attribute__((address_space(3))) const char*kp,const v8i_a q8,const f32x16&negm){
  const v8i_a k0=kfrag8(kp,0),k1=kfrag8(kp,1);
  p0=MFQ(k0,q8,negm);p1=MFQ(k1,q8,negm);
}
typedef __attribute__((address_space(3))) const char* lds_cptr;
typedef short v4i16_t __attribute__((ext_vector_type(4)));
__device__ __forceinline__ void kload8(bf16x8*kf,lds_cptr kp){
  kf[0]=*(const __attribute__((address_space(3))) bf16x8*)(kp);      kf[1]=*(const __attribute__((address_space(3))) bf16x8*)(kp+512);
  kf[2]=*(const __attribute__((address_space(3))) bf16x8*)(kp+2048); kf[3]=*(const __attribute__((address_space(3))) bf16x8*)(kp+2560);
  kf[4]=*(const __attribute__((address_space(3))) bf16x8*)(kp+4096); kf[5]=*(const __attribute__((address_space(3))) bf16x8*)(kp+4608);
  kf[6]=*(const __attribute__((address_space(3))) bf16x8*)(kp+6144); kf[7]=*(const __attribute__((address_space(3))) bf16x8*)(kp+6656);
}
__device__ __forceinline__ void kload2(bf16x8*kf,lds_cptr kp,int j){ kf[2*j]=*(const __attribute__((address_space(3))) bf16x8*)(kp+j*2048); kf[2*j+1]=*(const __attribute__((address_space(3))) bf16x8*)(kp+j*2048+512); }
__device__ __forceinline__ s16x4 vtr(lds_cptr p){ return __builtin_bit_cast(s16x4,__builtin_amdgcn_ds_read_tr16_b64_v4i16((__attribute__((address_space(3))) v4i16_t*)p)); }
__device__ __forceinline__ float rowmax(const f32x16&p0,const f32x16&p1){
  float a=max3f(p0[0],p0[1],p1[0]),b=max3f(p0[2],p0[3],p1[1]);a=max3f(a,p1[2],p1[3]);
  #pragma unroll
  for(int r=4;r<16;r+=4){a=max3f(a,p0[r],p0[r+1]);b=max3f(b,p0[r+2],p0[r+3]);a=max3f(a,p1[r],p1[r+1]);b=max3f(b,p1[r+2],p1[r+3]);}
  const float m=max2f(a,b);
  auto rr=__builtin_amdgcn_permlane32_swap(__float_as_uint(m),__float_as_uint(m),false,false);
  return max2f(__uint_as_float(rr[0]),__uint_as_float(rr[1]));
}
template<int NB> __device__ __forceinline__ void pv(f32x16*o,int vb,bf16x8 pa0,bf16x8 pa1,bf16x8 pa2,bf16x8 pa3){
  #pragma unroll
  for(int d0=0;d0<NB;++d0){s16x4 lo[4],hi[4];
    #pragma unroll
    for(int ks=0;ks<4;++ks){
      asm volatile("ds_read_b64_tr_b16 %0,%1 offset:%c2":"=&v"(lo[ks]):"v"(vb),"i"(d0*4096+ks*1024):"memory");
      asm volatile("ds_read_b64_tr_b16 %0,%1 offset:%c2":"=&v"(hi[ks]):"v"(vb),"i"(d0*4096+ks*1024+512):"memory");}
    asm volatile("s_waitcnt lgkmcnt(0)":::"memory");SBAR();
    #define PK(k) (bf16x8){lo[k][0],lo[k][1],lo[k][2],lo[k][3],hi[k][0],hi[k][1],hi[k][2],hi[k][3]}
    o[d0]=__builtin_amdgcn_mfma_f32_32x32x16_bf16(pa0,PK(0),o[d0],0,0,0);
    o[d0]=__builtin_amdgcn_mfma_f32_32x32x16_bf16(pa1,PK(1),o[d0],0,0,0);
    o[d0]=__builtin_amdgcn_mfma_f32_32x32x16_bf16(pa2,PK(2),o[d0],0,0,0);
    o[d0]=__builtin_amdgcn_mfma_f32_32x32x16_bf16(pa3,PK(3),o[d0],0,0,0);
    #undef PK
  }
}
#ifndef ATTN_STORE16
#define ATTN_STORE16(p,v) (*(u32x4*)(p)=(v))
#endif
#define PKW(P,B) cvtpk_s(P[B],P[B+1])
#define PAF(k) __builtin_bit_cast(bf16x8,pw##k)
#define PIN(x) asm volatile("":"+v"(x))
#define MX3(a,b,c) __builtin_fmaxf(__builtin_fmaxf((a),(b)),(c))
#define EX(v) __builtin_amdgcn_exp2f(v)
#define MF32(a,b,c) __builtin_amdgcn_mfma_f32_32x32x16_bf16(a,b,c,0,0,0)
#define GAPA(MF,A0,A1,A2,A3,W0,W1,PW) do{ MF; sacc+=A0; sacc+=A1; sacc+=A2; sacc+=A3; PIN(sacc); W0; W1; PIN(PW); SBAR(); }while(0)
#define ROT() do{sl_prev=sl_cur;sl_cur=sl_next;sl_next=(sl_next==(NSLOT-1)*SLOTB)?0:sl_next+SLOTB;}while(0)
#define DECIDE(C0,C1) do{ float a=MX3(C0[0],C0[1],C1[0]),b=MX3(C0[2],C0[3],C1[1]); a=MX3(a,C1[2],C1[3]); \
      _Pragma("unroll") for(int r=4;r<16;r+=4){a=MX3(a,C0[r],C0[r+1]);b=MX3(b,C0[r+2],C0[r+3]);a=MX3(a,C1[r],C1[r+1]);b=MX3(b,C1[r+2],C1[r+3]);} \
      float rm=__builtin_fmaxf(a,b); { auto rr=__builtin_amdgcn_permlane32_swap(__float_as_uint(rm),__float_as_uint(rm),false,false); rm=__builtin_fmaxf(__uint_as_float(rr[0]),__uint_as_float(rr[1])); } \
      resc=false; \
      if(__builtin_expect(__any(rm>(float)THRL),0)){ const float dl=__builtin_fmaxf(rm,0.f); mhat+=dl; \
        _Pragma("unroll") for(int r=0;r<16;++r){C0[r]-=dl;C1[r]-=dl;} \
        _Pragma("unroll") for(int r=0;r<16;++r)negm[r]=-mhat; asm volatile("":"+v"(negm)); \
        const float f=__builtin_amdgcn_exp2f(-dl); l_reg*=f; if(hi==0)wsf[r32]=f; resc=true; } }while(0)
#define START(P0,P1) do{ const float rm=rowmax(P0,P1); resc=false; \
    { const float dl=rm; mhat=fadd_s(mhat,dl); \
      _Pragma("unroll") for(int r=0;r<16;++r){P0[r]=fsub_s(P0[r],dl);P1[r]=fsub_s(P1[r],dl);} \
      _Pragma("unroll") for(int r=0;r<16;++r)negm[r]=-mhat; asm volatile("":"+v"(negm)); } \
    _Pragma("unroll") for(int r=0;r<16;++r)P0[r]=__builtin_amdgcn_exp2f(P0[r]); }while(0)
#define KRD(G,j) do{ if(G){ if((j)<2){ kf[(j)&1]=kfrag8(kp0+sl_next,(j)&1); } SBAR(); } }while(0)

template<int THRL> __device__ __forceinline__ void attn_unit_a(int qb,const bf16*Qp,__amdgpu_buffer_rsrc_t srd,unsigned kbyte,unsigned vbyte,bf16*Ob,char*shm,float mub,bool SB){
  const int tid=threadIdx.x,lane=tid&63,r32=lane&31,hi=lane>>5; const int wid=__builtin_amdgcn_readfirstlane(tid>>6);
  const int q0=qb*QB;
  const bf16*Qw=Qp+(long)(q0+wid*QBLK)*PP;
  const unsigned lds0=(unsigned)(uintptr_t)shm;
  float*wsf=(float*)(shm+LDS_WS)+wid*64;
  const unsigned kvoff=(unsigned)(lane*64+(wid&3)*16), vvoff=(unsigned)((16*(wid&3)+(lane>>2))*PP+(wid>>2)*32+(lane&3)*8)*2u;
  const unsigned kdst=lds0+LDS_K+(wid&3)*1024, vdst=lds0+LDS_V+wid*1024;
  #define DMA_K(t,slot) glds16b(srd,kvoff,(unsigned)__builtin_amdgcn_readfirstlane(kbyte+(unsigned)(t)*(KVBLK*PP)),(unsigned)__builtin_amdgcn_readfirstlane(kdst+(slot)))
  #define DMA_V(t,slot) glds16b(srd,vvoff,(unsigned)__builtin_amdgcn_readfirstlane(vbyte+(unsigned)(t)*(KVBLK*PP*2)),(unsigned)__builtin_amdgcn_readfirstlane(vdst+2*(slot)))
  const int vb0=(int)(lds0+LDS_V)+((lane>>4)&1)*32+(lane&3)*8+(4*hi+((lane&15)>>2))*64;
  v8i_a kf[2];
  const lds_cptr shm3=(lds_cptr)shm; const lds_cptr kp0=shm3+LDS_K+hi*2048+r32*16; const lds_cptr vp0=shm3+LDS_V+((lane>>4)&1)*32+(lane&3)*8+(4*hi+((lane&15)>>2))*64;
  DMA_K(0,0);DMA_V(0,0);DMA_K(1,SLOTB);
  v8i_a q8; { const u32x4*qp_=(const u32x4*)((const char*)Qp+(long)(q0+wid*QBLK+r32)*64+32*hi); const u32x4 qa=qp_[0],qb_=qp_[1]; q8=(v8i_a){(int)qa.x,(int)qa.y,(int)qa.z,(int)qa.w,(int)qb_.x,(int)qb_.y,(int)qb_.z,(int)qb_.w}; }
  float mhat=0.f,l_reg=0.f;f32x16 o[2];zero16(o[0]);zero16(o[1]);f32x16 negm;zero16(negm);
  if(SB){ _Pragma("unroll") for(int r=0;r<16;++r)negm[r]=-mub; asm volatile("":"+v"(negm)); }
  bool resc=false;
  #define RESC() do{ if(!SB && resc){ asm volatile("s_waitcnt lgkmcnt(0)":::"memory"); \
      _Pragma("unroll") for(int d_=0;d_<2;++d_) _Pragma("unroll") for(int r=0;r<16;++r)o[d_][r]*=wsf[crow(r,hi)]; } }while(0)
  f32x16 pA0,pA1,pB0,pB1;
  int sl_prev=0,sl_cur=0,sl_next=SLOTB;
  DMA_K(2,2*SLOTB);
  WAIT_BAR(3);
  qkt(pA0,pA1,kp0,q8,negm);asm volatile("s_nop 15\n\ts_nop 7":"+v"(pA0),"+v"(pA1));
  if(SB){ _Pragma("unroll") for(int r=0;r<16;++r)pA0[r]=__builtin_amdgcn_exp2f(pA0[r]); } else { START(pA0,pA1); }
  _Pragma("unroll") for(int r=0;r<16;++r)pA1[r]=__builtin_amdgcn_exp2f(pA1[r]);
  WAIT_BAR(0);
  DMA_K(3,0);DMA_V(1,SLOTB);
  ROT();
  kf[0]=kfrag8(kp0+sl_cur,0);kf[1]=kfrag8(kp0+sl_cur,1);
  WAIT_BAR(2);
  s16x4 vlo[8],vhi[8]; u32x4 pw0,pw1,pw2,pw3;
  #define VFR(i) (bf16x8){vlo[i][0],vlo[i][1],vlo[i][2],vlo[i][3],vhi[i][0],vhi[i][1],vhi[i][2],vhi[i][3]}
  #define GAPB(MF,X,B) do{ MF; X[B]=EX(X[B]); X[B+1]=EX(X[B+1]); X[B+2]=EX(X[B+2]); X[B+3]=EX(X[B+3]); PIN(X); SBAR(); }while(0)
  #define VRD(i) do{ vlo[i]=vtr(vp_+(((i)>>2)*4096+((i)&3)*1024)); vhi[i]=vtr(vp_+(((i)>>2)*4096+((i)&3)*1024+512)); }while(0)
  #define STEP(C0,C1,P0,P1,t,GK,GV,GL) do{ SBAR(); \
    const lds_cptr vp_=vp0+2*sl_prev; \
    VRD(0); SBAR(); float sacc=(P0[0]+P0[1]); \
    GAPA(C0=MFQ(kf[0],q8,negm),      P0[2],P0[3],P0[4],P0[5],     pw0[0]=PKW(P0,0), pw0[1]=PKW(P0,2), pw0); \
    VRD(4); SBAR(); GAPA(C1=MFQ(kf[1],q8,negm),      P0[6],P0[7],P0[8],P0[9],     pw0[2]=PKW(P0,4), pw0[3]=PKW(P0,6), pw0); \
    VRD(1); SBAR(); GAPA((void)0,                     P0[10],P0[11],P0[12],P0[13], pw1[0]=PKW(P0,8), pw1[1]=PKW(P0,10), pw1); \
    VRD(5); SBAR(); GAPA((void)0,                     P0[14],P0[15],P1[0],P1[1],   pw1[2]=PKW(P0,12),pw1[3]=PKW(P0,14), pw1); \
    VRD(2); SBAR(); GAPA((void)0,                     P1[2],P1[3],P1[4],P1[5],     pw2[0]=PKW(P1,0), pw2[1]=PKW(P1,2), pw2); \
    VRD(6); SBAR(); GAPA((void)0,                     P1[6],P1[7],P1[8],P1[9],     pw2[2]=PKW(P1,4), pw2[3]=PKW(P1,6), pw2); \
    VRD(3); SBAR(); GAPA((void)0,                     P1[10],P1[11],P1[12],P1[13], pw3[0]=PKW(P1,8), pw3[1]=PKW(P1,10), pw3); \
    VRD(7); SBAR(); GAPA((void)0,                     P1[14],P1[15],0.f,0.f,       pw3[2]=PKW(P1,12),pw3[3]=PKW(P1,14), pw3); \
    l_reg+=sacc; \
    if(GK){DMA_K((t)+3,sl_cur);} if(GV){DMA_V((t)+1,sl_next);} \
    if(!SB){ DECIDE(C0,C1); } \
    SBAR(); __builtin_amdgcn_s_setprio(1); \
    GAPB(o[0]=MF32(PAF(0),VFR(0),o[0]), C0,0); \
    GAPB(o[1]=MF32(PAF(0),VFR(4),o[1]), C0,4); \
    KRD(GL,0); GAPB(o[0]=MF32(PAF(1),VFR(1),o[0]), C0,8); \
    KRD(GL,1); GAPB(o[1]=MF32(PAF(1),VFR(5),o[1]), C0,12); \
    KRD(GL,2); GAPB(o[0]=MF32(PAF(2),VFR(2),o[0]), C1,0); \
    KRD(GL,3); GAPB(o[1]=MF32(PAF(2),VFR(6),o[1]), C1,4); \
    GAPB(o[0]=MF32(PAF(3),VFR(3),o[0]), C1,8); \
    GAPB(o[1]=MF32(PAF(3),VFR(7),o[1]), C1,12); __builtin_amdgcn_s_setprio(0); \
    }while(0)
  int t=1;
  asm volatile(".p2align 8\n\t.fill 12, 4, 0xbf800000");
  for(;t+5<NT;t+=2){
    STEP(pB0,pB1,pA0,pA1,t,true,true,true);     WAIT_BAR(2); RESC(); ROT();
    STEP(pA0,pA1,pB0,pB1,t+1,true,true,true);   WAIT_BAR(2); RESC(); ROT();
  }
  #define ENDW(tt) do{ if((tt)+3<NT){WAIT_BAR(2);} else if((tt)+2<NT){WAIT_BAR(1);} else {WAIT_BAR(0);} }while(0)
  for(;t+1<NT;t+=2){
    STEP(pB0,pB1,pA0,pA1,t,(t+3<NT),(t+1<NT),(t+1<NT));       ENDW(t);   RESC(); ROT();
    STEP(pA0,pA1,pB0,pB1,t+1,(t+4<NT),(t+2<NT),(t+2<NT));     ENDW(t+1); RESC(); ROT();
  }
  STEP(pB0,pB1,pA0,pA1,NT-1,false,false,false); RESC();
  { float sacc=pB0[0]+pB0[1]; _Pragma("unroll") for(int r=2;r<16;++r)sacc+=pB0[r]; _Pragma("unroll") for(int r=0;r<16;++r)sacc+=pB1[r]; l_reg+=sacc;
    pw0=(u32x4){PKW(pB0,0),PKW(pB0,2),PKW(pB0,4),PKW(pB0,6)};pw1=(u32x4){PKW(pB0,8),PKW(pB0,10),PKW(pB0,12),PKW(pB0,14)};pw2=(u32x4){PKW(pB1,0),PKW(pB1,2),PKW(pB1,4),PKW(pB1,6)};pw3=(u32x4){PKW(pB1,8),PKW(pB1,10),PKW(pB1,12),PKW(pB1,14)};
    SBAR(); pv<2>(o,vb0+2*sl_cur,PAF(0),PAF(1),PAF(2),PAF(3)); }
  #undef VFR
  #undef GAPB
  #undef VRD
  #undef STEP
  #undef ENDW
  {auto rr=__builtin_amdgcn_permlane32_swap(__float_as_uint(l_reg),__float_as_uint(l_reg),false,false);l_reg=__uint_as_float(rr[0])+__uint_as_float(rr[1]);}
  if(hi==0)wsf[32+r32]=l_reg;asm volatile("s_waitcnt lgkmcnt(0)":::"memory");
  float rli[16];
  #pragma unroll
  for(int r=0;r<16;++r)rli[r]=__builtin_amdgcn_rcpf(wsf[32+crow(r,hi)]);
  bf16*Ow=Ob+(long)(q0+wid*QBLK)*OPITCH;
  { bf16*stg=(bf16*)(shm+LDS_OST)+wid*4096;
    #pragma unroll
    for(int r=0;r<16;++r){const int orow=crow(r,hi);
      #pragma unroll
      for(int d0=0;d0<2;++d0)stg[orow*64+d0*32+r32]=__float2bfloat16(o[d0][r]*rli[r]);}
    asm volatile("s_waitcnt lgkmcnt(0)":::"memory");
    #pragma unroll
    for(int i=0;i<4;++i){const int row=i*8+(lane>>3),ch=lane&7; const u32x4 v=*(const u32x4*)(stg+row*64+ch*8); ATTN_STORE16(Ow+(long)row*OPITCH+ch*8,v);} }
  asm volatile("s_waitcnt lgkmcnt(0)\n\ts_barrier":::"memory");
  #undef DMA_K
  #undef DMA_V
  #undef RESC
}
template<int THRL> __device__ __forceinline__ void attn_unit_b(int qb,int comp,const bf16*Qp,__amdgpu_buffer_rsrc_t srd,unsigned kbyte,unsigned vbyte,float*sc,float lam,const float*subg,bf16*Ob,char*shm,float mub,bool SB){
  const int tid=threadIdx.x,lane=tid&63,r32=lane&31,hi=lane>>5; const int wid=__builtin_amdgcn_readfirstlane(tid>>6);
  const int q0=qb*QB;
  const bf16*Qw=Qp+(long)(q0+wid*QBLK)*PP;
  const unsigned lds0=(unsigned)(uintptr_t)shm;
  float*wsf=(float*)(shm+LDS_WS)+wid*64;
  const unsigned kvoff=(unsigned)(lane*64+(wid&3)*16);
  const unsigned vvoff=(unsigned)((16*(wid&3)+(lane>>2))*PP+(wid>>2)*32+(lane&3)*8)*2u;
  const unsigned kdst=lds0+LDS_K+(wid&3)*1024, vdst=lds0+LDS_V+wid*1024;
  #define DMA_K(t,slot) glds16b(srd,kvoff,(unsigned)__builtin_amdgcn_readfirstlane(kbyte+(unsigned)(t)*(KVBLK*PP)),(unsigned)__builtin_amdgcn_readfirstlane(kdst+(slot)))
  #define DMA_V(t,slot) do{ const unsigned so_=(unsigned)__builtin_amdgcn_readfirstlane(vbyte+(unsigned)(t)*(KVBLK*PP*2)); glds16b(srd,vvoff,so_,(unsigned)__builtin_amdgcn_readfirstlane(vdst+2*(slot))); glds16b(srd,vvoff,so_+(unsigned)(SEQ*PP*2),(unsigned)__builtin_amdgcn_readfirstlane(vdst+2*(slot)+8192)); }while(0)
  const int vb0=(int)(lds0+LDS_V)+((lane>>4)&1)*32+(lane&3)*8+(4*hi+((lane&15)>>2))*64;
  v8i_a kf[2];
  const lds_cptr shm3=(lds_cptr)shm; const lds_cptr kp0=shm3+LDS_K+hi*2048+r32*16; const lds_cptr vp0=shm3+LDS_V+((lane>>4)&1)*32+(lane&3)*8+(4*hi+((lane&15)>>2))*64;
  DMA_K(0,0);DMA_V(0,0);DMA_K(1,SLOTB);
  v8i_a q8; { const u32x4*qp_=(const u32x4*)((const char*)Qp+(long)(q0+wid*QBLK+r32)*64+32*hi); const u32x4 qa=qp_[0],qb_=qp_[1]; q8=(v8i_a){(int)qa.x,(int)qa.y,(int)qa.z,(int)qa.w,(int)qb_.x,(int)qb_.y,(int)qb_.z,(int)qb_.w}; }
  float mhat=0.f,l_reg=0.f;f32x16 o[4];zero16(o[0]);zero16(o[1]);zero16(o[2]);zero16(o[3]);f32x16 negm;zero16(negm);
  if(SB){ _Pragma("unroll") for(int r=0;r<16;++r)negm[r]=-mub; asm volatile("":"+v"(negm)); }
  bool resc=false;
  #define RESC() do{ if(!SB && resc){ asm volatile("s_waitcnt lgkmcnt(0)":::"memory"); \
      _Pragma("unroll") for(int d_=0;d_<4;++d_) _Pragma("unroll") for(int r=0;r<16;++r)o[d_][r]*=wsf[crow(r,hi)]; } }while(0)
  f32x16 pA0,pA1,pB0,pB1;
  int sl_prev=0,sl_cur=0,sl_next=SLOTB;
  DMA_K(2,2*SLOTB);
  WAIT_BAR(4);
  qkt(pA0,pA1,kp0,q8,negm);asm volatile("s_nop 15\n\ts_nop 7":"+v"(pA0),"+v"(pA1));
  if(SB){ _Pragma("unroll") for(int r=0;r<16;++r)pA0[r]=__builtin_amdgcn_exp2f(pA0[r]); } else { START(pA0,pA1); }
  _Pragma("unroll") for(int r=0;r<16;++r)pA1[r]=__builtin_amdgcn_exp2f(pA1[r]);
  WAIT_BAR(0);
  DMA_K(3,0);DMA_V(1,SLOTB);
  ROT();
  kf[0]=kfrag8(kp0+sl_cur,0);kf[1]=kfrag8(kp0+sl_cur,1);
  WAIT_BAR(3);
  s16x4 vfl[4],vfh[4]; u32x4 pw0,pw1,pw2,pw3;
  #define VFRB(g) (bf16x8){vfl[(g)&3][0],vfl[(g)&3][1],vfl[(g)&3][2],vfl[(g)&3][3],vfh[(g)&3][0],vfh[(g)&3][1],vfh[(g)&3][2],vfh[(g)&3][3]}
  #define VRDB(g) do{ vfl[(g)&3]=vtr(vp_+(((g)&3)*4096+((g)>>2)*1024)); vfh[(g)&3]=vtr(vp_+(((g)&3)*4096+((g)>>2)*1024+512)); }while(0)
  #define GAPB2(g,X,B) do{ o[(g)&3]=MF32(PAF4((g)>>2),VFRB(g),o[(g)&3]); X[B]=EX(X[B]); X[B+1]=EX(X[B+1]); PIN(X); SBAR(); }while(0)
  #define PAF4(k) ((k)==0?PAF(0):(k)==1?PAF(1):(k)==2?PAF(2):PAF(3))
  #define STEPB(C0,C1,P0,P1,t,GK,GV,GL) do{ SBAR(); \
    const lds_cptr vp_=vp0+2*sl_prev; \
    float sacc=(P0[0]+P0[1]); \
    GAPA(C0=MFQ(kf[0],q8,negm),      P0[2],P0[3],P0[4],P0[5],     pw0[0]=PKW(P0,0), pw0[1]=PKW(P0,2), pw0); \
    GAPA(C1=MFQ(kf[1],q8,negm),      P0[6],P0[7],P0[8],P0[9],     pw0[2]=PKW(P0,4), pw0[3]=PKW(P0,6), pw0); \
    GAPA((void)0,                     P0[10],P0[11],P0[12],P0[13], pw1[0]=PKW(P0,8), pw1[1]=PKW(P0,10), pw1); \
    GAPA((void)0,                     P0[14],P0[15],P1[0],P1[1],   pw1[2]=PKW(P0,12),pw1[3]=PKW(P0,14), pw1); \
    GAPA((void)0,                     P1[2],P1[3],P1[4],P1[5],     pw2[0]=PKW(P1,0), pw2[1]=PKW(P1,2), pw2); \
    GAPA((void)0,                     P1[6],P1[7],P1[8],P1[9],     pw2[2]=PKW(P1,4), pw2[3]=PKW(P1,6), pw2); \
    GAPA((void)0,                     P1[10],P1[11],P1[12],P1[13], pw3[0]=PKW(P1,8), pw3[1]=PKW(P1,10), pw3); \
    GAPA((void)0,                     P1[14],P1[15],0.f,0.f,       pw3[2]=PKW(P1,12),pw3[3]=PKW(P1,14), pw3); \
    l_reg+=sacc; \
    if(GK){DMA_K((t)+3,sl_cur);} if(GV){DMA_V((t)+1,sl_next);} \
    VRDB(0); VRDB(1); SBAR(); \
    if(!SB){ DECIDE(C0,C1); } \
    SBAR(); __builtin_amdgcn_s_setprio(1); \
    VRDB(2);  SBAR(); GAPB2(0, C0,0); \
    VRDB(3);  SBAR(); GAPB2(1, C0,2); \
    VRDB(4);  SBAR(); GAPB2(2, C0,4); \
    VRDB(5);  SBAR(); GAPB2(3, C0,6); \
    KRD(GL,0); VRDB(6);  SBAR(); GAPB2(4, C0,8); \
    VRDB(7);  SBAR(); GAPB2(5, C0,10); \
    KRD(GL,1); VRDB(8);  SBAR(); GAPB2(6, C0,12); \
    VRDB(9);  SBAR(); GAPB2(7, C0,14); \
    KRD(GL,2); VRDB(10); SBAR(); GAPB2(8, C1,0); \
    VRDB(11); SBAR(); GAPB2(9, C1,2); \
    KRD(GL,3); VRDB(12); SBAR(); GAPB2(10,C1,4); \
    VRDB(13); SBAR(); GAPB2(11,C1,6); \
    VRDB(14); SBAR(); GAPB2(12,C1,8); \
    VRDB(15); SBAR(); GAPB2(13,C1,10); \
    GAPB2(14,C1,12); \
    GAPB2(15,C1,14); __builtin_amdgcn_s_setprio(0); \
    }while(0)
  int t=1;
  asm volatile(".p2align 8\n\t.fill 4, 4, 0xbf800000");
  for(;t+5<NT;t+=2){
    STEPB(pB0,pB1,pA0,pA1,t,true,true,true);     WAIT_BAR(3); RESC(); ROT();
    STEPB(pA0,pA1,pB0,pB1,t+1,true,true,true);   WAIT_BAR(3); RESC(); ROT();
  }
  #define ENDW(tt) do{ if((tt)+3<NT){WAIT_BAR(3);} else if((tt)+2<NT){WAIT_BAR(2);} else {WAIT_BAR(0);} }while(0)
  for(;t+1<NT;t+=2){
    STEPB(pB0,pB1,pA0,pA1,t,(t+3<NT),(t+1<NT),(t+1<NT));       ENDW(t);   RESC(); ROT();
    STEPB(pA0,pA1,pB0,pB1,t+1,(t+4<NT),(t+2<NT),(t+2<NT));     ENDW(t+1); RESC(); ROT();
  }
  STEPB(pB0,pB1,pA0,pA1,NT-1,false,false,false); RESC();
  { float sacc=pB0[0]+pB0[1]; _Pragma("unroll") for(int r=2;r<16;++r)sacc+=pB0[r]; _Pragma("unroll") for(int r=0;r<16;++r)sacc+=pB1[r]; l_reg+=sacc;
    pw0=(u32x4){PKW(pB0,0),PKW(pB0,2),PKW(pB0,4),PKW(pB0,6)};pw1=(u32x4){PKW(pB0,8),PKW(pB0,10),PKW(pB0,12),PKW(pB0,14)};pw2=(u32x4){PKW(pB1,0),PKW(pB1,2),PKW(pB1,4),PKW(pB1,6)};pw3=(u32x4){PKW(pB1,8),PKW(pB1,10),PKW(pB1,12),PKW(pB1,14)};
    SBAR(); pv<4>(o,vb0+2*sl_cur,PAF(0),PAF(1),PAF(2),PAF(3)); }
  #undef VFRB
  #undef VRDB
  #undef GAPB2
  #undef PAF4
  #undef STEPB
  #undef ENDW
  {auto rr=__builtin_amdgcn_permlane32_swap(__float_as_uint(l_reg),__float_as_uint(l_reg),false,false);l_reg=__uint_as_float(rr[0])+__uint_as_float(rr[1]);}
  if(hi==0)wsf[32+r32]=l_reg;asm volatile("s_waitcnt lgkmcnt(0)":::"memory");
  float rli[16];
  #pragma unroll
  for(int r=0;r<16;++r)rli[r]=__builtin_amdgcn_rcpf(wsf[32+crow(r,hi)]);
  int lane_e=lane; asm volatile("":"+v"(lane_e));
  const int r32e=lane_e&31, hie=lane_e>>5;
  float*scw=sc+(long)wid*4096+lane_e;
  if(comp==0){
    #pragma unroll
    for(int d0=0;d0<4;++d0)
      #pragma unroll
      for(int r=0;r<16;++r)scw[(d0*16+r)*64]=o[d0][r]*rli[r];
  } else {
    float ssq[16];
    #pragma unroll
    for(int r=0;r<16;++r)ssq[r]=0.f;
    #pragma unroll
    for(int d0=0;d0<4;++d0)
      #pragma unroll
      for(int r=0;r<16;++r){ const float dv=scw[(d0*16+r)*64]-lam*(o[d0][r]*rli[r]); o[d0][r]=dv; ssq[r]+=dv*dv; }
    #pragma unroll
    for(int r=0;r<16;++r){ float s=ssq[r]; s+=__shfl_xor(s,1); s+=__shfl_xor(s,2); s+=__shfl_xor(s,4); s+=__shfl_xor(s,8); s+=__shfl_xor(s,16); ssq[r]=__builtin_amdgcn_rsqf(s*(1.0f/128.0f)+1e-5f)*0.8f; }
    float gsub[4];
    #pragma unroll
    for(int d0=0;d0<4;++d0)gsub[d0]=subg[d0*32+r32e];
    bf16*Ow=Ob+(long)(q0+wid*QBLK)*OPITCH;
    bf16*stg=(bf16*)(shm+LDS_OST)+wid*4096;
    #pragma unroll
    for(int r=0;r<16;++r){const int orow=crow(r,hie);
      #pragma unroll
      for(int d0=0;d0<4;++d0)stg[orow*128+d0*32+r32e]=__float2bfloat16(o[d0][r]*ssq[r]*gsub[d0]);}
    asm volatile("s_waitcnt lgkmcnt(0)":::"memory");
    #pragma unroll
    for(int i=0;i<8;++i){const int row=i*4+(lane_e>>4),ch=lane_e&15; const u32x4 v=*(const u32x4*)(stg+row*128+ch*8); ATTN_STORE16(Ow+(long)row*OPITCH+ch*8,v);}
  }
  asm volatile("s_waitcnt vmcnt(0) lgkmcnt(0)\n\ts_barrier":::"memory");
  #undef DMA_K
  #undef DMA_V
  #undef RESC
}
#undef PKW
#undef PAF
#undef PIN
#undef MX3
#undef EX
#undef MF32
#undef GAPA
#undef ROT
#undef DECIDE
#undef START
#undef KRD
#undef SBAR
#undef WAIT_BAR
constexpr int ATTN_LDS_BYTES=LDS_BYTES;
}
constexpr int NWAVES = 8;
#ifndef MK_N_LAUNCHES
#define MK_N_LAUNCHES 1
#endif
constexpr int PER_PHASE = 7;
constexpr int N_LAUNCHES = MK_N_LAUNCHES;
static_assert(N_LAUNCHES == 1 || N_LAUNCHES == PER_PHASE, "MK_N_LAUNCHES is 1 or 7");

constexpr int M = 16384, DM = 1024, NIN = 2304, NQ = 2048, NEXP = 16384;
constexpr float C2 = 0.125f * 1.4426950408889634f;
constexpr float NORM_EPS = 1e-6f;

constexpr size_t MiB = 1u << 20;
constexpr size_t WS_CTL = 0, CTL_ZERO_BYTES = 1 * MiB;
constexpr size_t WS_TROW = 1 * MiB, WS_TCOL = 1 * MiB + 65536, WS_TPOS = 1 * MiB + 524288;
constexpr size_t WS_SK = 3 * MiB;
constexpr size_t WS_SSQ = 4 * MiB;
constexpr size_t WS_INVS = 5 * MiB;
constexpr size_t WS_WIN = 6 * MiB, WS_WOUT = 11 * MiB, WS_WQ = 13 * MiB;
constexpr size_t WS_UV8 = 32 * MiB;
constexpr int EROW = 512;
constexpr size_t V4_OFF = 8 * MiB;
constexpr size_t WS_SCL = 5 * MiB + 524288;
constexpr size_t WS_XN = 96 * MiB;
constexpr size_t WS_QKV = 128 * MiB;
constexpr size_t WS_AO = 200 * MiB;
constexpr size_t WS_META = 232 * MiB;
constexpr size_t WS_END = 248 * MiB;
constexpr int CW_TMO = 0, CW_CODE = 1, CW_BAR = 4096;

constexpr int RING_OFF = 0, RING_BYTES = 147456;
constexpr int LDSCTL_OFF = RING_BYTES, MISC_OFF = LDSCTL_OFF + 320;
constexpr int LDS_BYTES = RING_BYTES + 4096;
static_assert(attn_body::ATTN_LDS_BYTES <= RING_BYTES && pg8::STAGE_BYTES <= RING_BYTES, "LDS map");

#define GAS __attribute__((address_space(1)))
#define LAS __attribute__((address_space(3)))
typedef unsigned short bf16;
typedef unsigned v4u __attribute__((ext_vector_type(4)));
typedef unsigned v2u __attribute__((ext_vector_type(2)));
typedef float f32x4 __attribute__((ext_vector_type(4)));
typedef float f32x16 __attribute__((ext_vector_type(16)));
typedef short bf16x8 __attribute__((ext_vector_type(8)));
typedef __bf16 bf16x2_t __attribute__((ext_vector_type(2)));
typedef GAS unsigned gu32;
#define RLX_AGENT __ATOMIC_RELAXED, __HIP_MEMORY_SCOPE_AGENT
#define LDS_WAIT() asm volatile("s_waitcnt lgkmcnt(0)" ::: "memory")
#define VM_WAIT() asm volatile("s_waitcnt vmcnt(0)" ::: "memory")
__device__ __forceinline__ unsigned f2bf(float f) { unsigned u = __builtin_bit_cast(unsigned, f); return (u + 0x7fffu + ((u >> 16) & 1u)) >> 16; }
__device__ __forceinline__ unsigned pk2(float lo, float hi) { return f2bf(lo) | (f2bf(hi) << 16); }
#define XB_TMO      128
#define XB_XCNT(j)  (256  + 64 * (j))
#define XB_XSUB(j)  (1280 + 64 * (j))
#define XB_XGEN(j)  (2304 + 64 * (j))
#define XB_TOP      3328
#define XB_TOPGEN   3392
#define XCD_BAR_WORDS 3456
#define XB_SPIN_CAP (1u << 18)

__device__ __forceinline__ unsigned xb_ld(unsigned* p)              { return __hip_atomic_load(p, __ATOMIC_RELAXED, __HIP_MEMORY_SCOPE_AGENT); }
__device__ __forceinline__ unsigned xb_add(unsigned* p, unsigned v) { return __hip_atomic_fetch_add(p, v, __ATOMIC_RELAXED, __HIP_MEMORY_SCOPE_AGENT); }
__device__ __forceinline__ unsigned xb_xcc_id() { return (unsigned)__builtin_amdgcn_s_getreg((3 << 11) | 20) & 0xFu; }
#define XB_SPIN(cond, bar) do { unsigned _sp = 0; while (cond) { __builtin_amdgcn_s_sleep(1); \
    if ((++_sp & 255u) == 0u) { if (xb_ld(&(bar)[XB_TMO])) break; if (_sp > XB_SPIN_CAP) { atomicAdd(&(bar)[XB_TMO], 1u); break; } } } } while (0)

struct XcdBarrier {
    unsigned* bar; unsigned x;
    volatile LAS unsigned* st;
};

__device__ __forceinline__ XcdBarrier xcd_barrier_post(unsigned* bar, volatile LAS unsigned* st) {
    XcdBarrier b; b.bar = bar; b.x = xb_xcc_id(); b.st = st;
    if (threadIdx.x == 0) (void)xb_add(&bar[XB_XCNT(b.x)], 1u);
    return b;
}
__device__ __forceinline__ void xcd_barrier_complete(unsigned* bar, unsigned x, unsigned& nloc, unsigned& nx) {
    const unsigned G = gridDim.x * gridDim.y * gridDim.z;
    unsigned sum, cnt, mine, sp = 0u;
    for (;;) {
        sum = 0u; cnt = 0u; mine = 0u;
#pragma unroll
        for (unsigned j = 0; j < 16; ++j) { const unsigned c = xb_ld(&bar[XB_XCNT(j)]); sum += c; cnt += (c > 0u) ? 1u : 0u; mine = (j == x) ? c : mine; }
        if (sum == G) break;
        __builtin_amdgcn_s_sleep(1);
        if ((++sp & 255u) == 0u) { if (xb_ld(&bar[XB_TMO])) break; if (sp > XB_SPIN_CAP) { atomicAdd(&bar[XB_TMO], 1u); break; } }
    }
    nloc = mine > 0u ? mine : 1u; nx = cnt > 0u ? cnt : 1u;
}

__device__ __forceinline__ void xcd_barrier(const XcdBarrier& b) {
    asm volatile("s_waitcnt vmcnt(0)" ::: "memory");
    __syncthreads();
    if (threadIdx.x == 0) {
        unsigned* bar = b.bar;
        __builtin_amdgcn_s_waitcnt(0);
        unsigned nloc = b.st[0], nx = b.st[1];
        if (nloc == 0u) { xcd_barrier_complete(bar, b.x, nloc, nx); b.st[0] = nloc; b.st[1] = nx; }
        const unsigned old = xb_add(&bar[XB_XSUB(b.x)], 1u);
        const unsigned gen = old / nloc;
        if (old + 1u == (gen + 1u) * nloc) {
            __builtin_amdgcn_fence(__ATOMIC_RELEASE, "agent");
            asm volatile("s_waitcnt vmcnt(0)" ::: "memory");
            const unsigned og = xb_add(&bar[XB_TOP], 1u);
            const unsigned tg = og / nx;
            if (og + 1u == (tg + 1u) * nx) xb_add(&bar[XB_TOPGEN], 1u);
            else XB_SPIN(xb_ld(&bar[XB_TOPGEN]) == tg, bar);
            __builtin_amdgcn_fence(__ATOMIC_ACQUIRE, "agent");
            xb_add(&bar[XB_XGEN(b.x)], 1u);
            asm volatile("s_waitcnt vmcnt(0)" ::: "memory");
        } else {
            XB_SPIN(xb_ld(&bar[XB_XGEN(b.x)]) == gen, bar);
            __builtin_amdgcn_fence(__ATOMIC_ACQUIRE, "agent");
            asm volatile("s_waitcnt vmcnt(0)" ::: "memory");
        }
    }
    __syncthreads();
}
struct Frame {
    LAS unsigned char* lds;
    volatile LAS unsigned* MISC;
    gu32* ctl;
    int tid, lane, wave;
    int vcu, G;
};
struct Args { const float* in[17]; float* out; unsigned char* ws; double inv_ax[16]; double inv_p[8]; int ph_lo, ph_hi, li, pad; };

__device__ __forceinline__ float wave_sum(float v) {
#pragma unroll
    for (int o = 1; o < 64; o <<= 1) v += __shfl_xor(v, o);
    return v;
}
__host__ __device__ __forceinline__ int inproj_dst_col(int j) {
    const int s = j >> 6, d = j & 63; int bj, p;
    if (s < 10) { bj = d >> 5; p = 8 * ((d >> 2) & 3) + 4 * ((d >> 4) & 1) + (d & 3); }
    else if (s >= 12 && s < 28) { if (d < 32) { bj = 0; p = 8 * (2 * (d >> 4) + ((d >> 2) & 1)) + 4 * ((d >> 3) & 1) + (d & 3); } else { bj = 1; p = d - 32; } }
    else { bj = d >> 5; p = d & 31; }
    return (s >> 2) * 256 + bj * 128 + (s & 3) * 32 + p;
}
template <int MODE> __device__ __forceinline__ void p0_transpose_item(const float* W, int K, int N, bf16* WT, const float* kscale, LAS float* scr, int item, int lane) {
    const int nblk = N / 32, kb = item / nblk, nb = item % nblk, k0 = 64 * kb, n0 = 32 * nb;
    { f32x4 w[8];
#pragma unroll
      for (int i = 0; i < 8; ++i) w[i] = *(const GAS f32x4*)(W + (size_t)(k0 + (lane >> 3) + 8 * i) * N + n0 + 4 * (lane & 7));
#pragma unroll
      for (int i = 0; i < 8; ++i) { const int kk = (lane >> 3) + 8 * i; f32x4 v = w[i]; if (MODE == 2) v = v * kscale[k0 + kk];
          LAS float* d = scr + kk * 33 + 4 * (lane & 7); d[0] = v.x; d[1] = v.y; d[2] = v.z; d[3] = v.w; } }
    LDS_WAIT(); asm volatile("" ::: "memory");
    const int c = lane & 7;
#pragma unroll
    for (int j = 0; j < 4; ++j) { const int n = (lane >> 3) + 8 * j; const LAS float* s = scr + (8 * c) * 33 + n;
        v4u o; o.x = pk2(s[0 * 33], s[1 * 33]); o.y = pk2(s[2 * 33], s[3 * 33]); o.z = pk2(s[4 * 33], s[5 * 33]); o.w = pk2(s[6 * 33], s[7 * 33]);
        const int dr = (MODE == 1) ? inproj_dst_col(n0 + n) : (n0 + n);
        *(GAS v4u*)(WT + (size_t)dr * K + k0 + 8 * c) = o; }
    LDS_WAIT(); asm volatile("" ::: "memory");
}
template <bool NORM> __device__ __forceinline__ void p0_row_to_bf16(const float* src, bf16* dst, const float* cscale, int lane) {
    const GAS f32x4* xr = (const GAS f32x4*)src + lane;
    f32x4 v[4]; float s = 0.f;
#pragma unroll
    for (int j = 0; j < 4; ++j) { v[j] = xr[64 * j]; s += (v[j].x * v[j].x + v[j].y * v[j].y) + (v[j].z * v[j].z + v[j].w * v[j].w); }
    float rstd = 1.f;
    if (NORM) rstd = __builtin_amdgcn_rsqf(wave_sum(s) * (1.f / DM) + NORM_EPS);
    GAS unsigned long long* o8 = (GAS unsigned long long*)dst + lane;
#pragma unroll
    for (int j = 0; j < 4; ++j) { f32x4 w = v[j] * rstd; if (cscale) w = w * ((const GAS f32x4*)cscale)[lane + 64 * j];
        o8[64 * j] = (unsigned long long)pk2(w.x, w.y) | ((unsigned long long)pk2(w.z, w.w) << 32); }
}
__device__ __forceinline__ void sincos_rev(double ang, float& c, float& s) {
    double rev = ang * 0.15915494309189535; rev -= __builtin_rint(rev);
    const float r = (float)rev; c = __builtin_amdgcn_cosf(r); s = __builtin_amdgcn_sinf(r);
}
__device__ __forceinline__ float wave_max(float v) {
#pragma unroll
    for (int o = 1; o < 64; o <<= 1) v = __builtin_fmaxf(v, __shfl_xor(v, o));
    return v;
}
__device__ __forceinline__ void p0_row_load(const float* src, int lane, f32x4 (&v)[4]) {
    const GAS f32x4* xr = (const GAS f32x4*)src + 4 * lane;
#pragma unroll
    for (int j = 0; j < 4; ++j) v[j] = xr[j];
}
__device__ __forceinline__ float p0_row_finish(f32x4 (&v)[4], unsigned char* dst, const f32x4* cs, int lane) {
    float mx = 0.f;
#pragma unroll
    for (int j = 0; j < 4; ++j) { if (cs) v[j] = v[j] * cs[j];
        mx = __builtin_fmaxf(mx, __builtin_fmaxf(__builtin_fmaxf(__builtin_fabsf(v[j].x), __builtin_fabsf(v[j].y)), __builtin_fmaxf(__builtin_fabsf(v[j].z), __builtin_fabsf(v[j].w)))); }
    mx = wave_max(mx);
    const bool ok = mx > 1e-30f && mx < 1e30f;
    const float sc = ok ? 6.0f / mx : 1.f, isc = ok ? mx * (1.0f / 6.0f) : 1.f;
    unsigned d0 = 0u, d1 = 0u;
    { const f32x4 a = v[0] * sc, b = v[1] * sc, c = v[2] * sc, d = v[3] * sc;
      d0 = __builtin_amdgcn_cvt_scalef32_pk_fp4_f32(d0, a.x, a.y, 1.0f, 0); d0 = __builtin_amdgcn_cvt_scalef32_pk_fp4_f32(d0, a.z, a.w, 1.0f, 1);
      d0 = __builtin_amdgcn_cvt_scalef32_pk_fp4_f32(d0, b.x, b.y, 1.0f, 2); d0 = __builtin_amdgcn_cvt_scalef32_pk_fp4_f32(d0, b.z, b.w, 1.0f, 3);
      d1 = __builtin_amdgcn_cvt_scalef32_pk_fp4_f32(d1, c.x, c.y, 1.0f, 0); d1 = __builtin_amdgcn_cvt_scalef32_pk_fp4_f32(d1, c.z, c.w, 1.0f, 1);
      d1 = __builtin_amdgcn_cvt_scalef32_pk_fp4_f32(d1, d.x, d.y, 1.0f, 2); d1 = __builtin_amdgcn_cvt_scalef32_pk_fp4_f32(d1, d.z, d.w, 1.0f, 3); }
    *(GAS v2u*)(dst + 8 * lane) = (v2u){d0, d1};
    return isc;
}
__device__ __forceinline__ void p0_prologue(Frame& F, const Args& A) {
    unsigned char* ws = A.ws;
    LAS float* scr = (LAS float*)(F.lds + RING_OFF + F.wave * 16384);
    const int gw = F.vcu * NWAVES + F.wave, NGW = F.G * NWAVES;
    { float* tpos = (float*)(ws + WS_TPOS); float* trow = (float*)(ws + WS_TROW); float* tcol = (float*)(ws + WS_TCOL);
      const int gt = F.vcu * (NWAVES * 64) + F.tid, NTH = F.G * NWAVES * 64;
      for (int i = gt; i < M * 8; i += NTH) { const int pos = i >> 3, f = i & 7; float c, s; sincos_rev((double)pos * A.inv_p[f], c, s); tpos[pos * 16 + f] = c; tpos[pos * 16 + 8 + f] = s; }
      for (int i = gt; i < 256 * 16; i += NTH) { const int idx = i >> 4, f = i & 15; float c, s; sincos_rev((double)idx * A.inv_ax[f], c, s); trow[idx * 32 + f] = c; trow[idx * 32 + 16 + f] = s; }
      for (int i = gt; i < 64 * 16; i += NTH) { const int idx = i >> 4, f = i & 15; float c, s; sincos_rev((double)idx * A.inv_ax[f], c, s); tcol[idx * 32 + f] = c; tcol[idx * 32 + 16 + f] = s; }
      const float* sk = A.in[13]; unsigned* skb = (unsigned*)(ws + WS_SK);
      for (int i = gt; i < 8 * 2 * 128 * 128 / 2; i += NTH) skb[i] = pk2(sk[2 * i], sk[2 * i + 1]);
    }
    constexpr int I_IN = (DM / 64) * (NIN / 32);
    for (int it = gw; it < I_IN; it += NGW) p0_transpose_item<1>(A.in[2], DM, NIN, (bf16*)(ws + WS_WIN), nullptr, scr, it, F.lane);
    { f32x4 gsc[4];
#pragma unroll
      for (int j = 0; j < 4; ++j) gsc[j] = ((const GAS f32x4*)A.in[1])[F.lane + 64 * j];
      for (int m0 = gw; m0 < M; m0 += 4 * NGW) {
        f32x4 v[4][4]; float ss[4];
#pragma unroll
        for (int r = 0; r < 4; ++r) { const int m = (m0 + r * NGW < M) ? m0 + r * NGW : m0; const GAS f32x4* xr = (const GAS f32x4*)(A.in[0] + (size_t)m * DM) + F.lane;
#pragma unroll
            for (int j = 0; j < 4; ++j) v[r][j] = xr[64 * j]; }
#pragma unroll
        for (int r = 0; r < 4; ++r) { float s_ = 0.f;
#pragma unroll
            for (int j = 0; j < 4; ++j) s_ += (v[r][j].x * v[r][j].x + v[r][j].y * v[r][j].y) + (v[r][j].z * v[r][j].z + v[r][j].w * v[r][j].w);
            ss[r] = __builtin_amdgcn_rsqf(wave_sum(s_) * (1.f / DM) + NORM_EPS); }
#pragma unroll
        for (int r = 0; r < 4; ++r) { const int m = m0 + r * NGW; if (m < M) { GAS unsigned long long* o8 = (GAS unsigned long long*)((bf16*)(ws + WS_XN) + (size_t)m * DM) + F.lane;
#pragma unroll
            for (int j = 0; j < 4; ++j) { const f32x4 w = v[r][j] * ss[r] * gsc[j]; o8[64 * j] = (unsigned long long)pk2(w.x, w.y) | ((unsigned long long)pk2(w.z, w.w) << 32); } } }
      } }
}
__device__ __forceinline__ void p0_lazy(Frame& F, const Args& A, int gw, int NGW) {
    unsigned char* ws = A.ws;
    LAS float* scr = (LAS float*)(F.lds + RING_OFF + F.wave * 16384);
    constexpr int I_OUT = (DM / 64) * (DM / 32), I_Q = (DM / 64) * (NQ / 32);
    for (int it = gw; it < I_OUT + I_Q; it += NGW) {
        if (it < I_OUT) p0_transpose_item<0>(A.in[10], DM, DM, (bf16*)(ws + WS_WOUT), nullptr, scr, it, F.lane);
        else p0_transpose_item<2>(A.in[12], DM, NQ, (bf16*)(ws + WS_WQ), A.in[11], scr, it - I_OUT, F.lane);
    }
    f32x4 cs[4];
#pragma unroll
    for (int j = 0; j < 4; ++j) cs[j] = ((const GAS f32x4*)A.in[11])[4 * F.lane + j];
    for (int m = gw; m < NEXP; m += 2 * NGW) {
        const int m2 = m + NGW; const bool has2 = m2 < NEXP; const int mb = has2 ? m2 : m;
        f32x4 ua[4], va[4], ub[4], vb[4];
        p0_row_load(A.in[14] + (size_t)m * DM, F.lane, ua); p0_row_load(A.in[15] + (size_t)m * DM, F.lane, va);
        p0_row_load(A.in[14] + (size_t)mb * DM, F.lane, ub); p0_row_load(A.in[15] + (size_t)mb * DM, F.lane, vb);
        asm volatile("" ::: "memory");
        { const float iu = p0_row_finish(ua, ws + WS_UV8 + (size_t)m * EROW, cs, F.lane);
          const float iv = p0_row_finish(va, ws + WS_UV8 + V4_OFF + (size_t)m * EROW, nullptr, F.lane);
          if (F.lane == 0) { float* sc = (float*)(ws + WS_SCL) + 2 * m; sc[0] = iu; sc[1] = iv; } }
        if (has2) { const float iu = p0_row_finish(ub, ws + WS_UV8 + (size_t)m2 * EROW, cs, F.lane);
          const float iv = p0_row_finish(vb, ws + WS_UV8 + V4_OFF + (size_t)m2 * EROW, nullptr, F.lane);
          if (F.lane == 0) { float* sc = (float*)(ws + WS_SCL) + 2 * m2; sc[0] = iu; sc[1] = iv; } }
    }
}

__device__ __forceinline__ void topk_insert(float (&L)[16], float c) {
#pragma unroll
    for (int j = 15; j >= 1; --j) L[j] = __builtin_amdgcn_fmed3f(L[j - 1], L[j], c);
    L[0] = __builtin_fmaxf(L[0], c);
}
__device__ __forceinline__ void cex(float& a, float& b) { const float hi = __builtin_amdgcn_fmed3f(a, b, INFINITY), lo = __builtin_amdgcn_fmed3f(a, b, -INFINITY); a = hi; b = lo; }
__device__ __forceinline__ void sort16_desc(float (&v)[16]) {
    constexpr unsigned char P[60][2] = {{0,13},{1,12},{2,15},{3,14},{4,8},{5,6},{7,11},{9,10},{0,5},{1,7},{2,9},{3,4},{6,13},{8,14},{10,15},{11,12},{0,1},{2,3},{4,5},{6,8},{7,9},{10,11},{12,13},{14,15},
        {0,2},{1,3},{4,10},{5,11},{6,7},{8,9},{12,14},{13,15},{1,2},{3,12},{4,6},{5,7},{8,10},{9,11},{13,14},{1,4},{2,6},{5,8},{7,10},{9,13},{11,14},{2,4},{3,6},{9,12},{11,13},{3,5},{6,8},{7,9},{10,12},
        {3,4},{5,6},{7,8},{9,10},{11,12},{6,7},{8,9}};
#pragma unroll
    for (int k = 0; k < 60; ++k) cex(v[P[k][0]], v[P[k][1]]);
}
__device__ __forceinline__ void merge_top16(float (&a)[16], const float (&b)[16]) {
#pragma unroll
    for (int i = 0; i < 16; ++i) a[i] = __builtin_amdgcn_fmed3f(a[i], b[15 - i], INFINITY);
#pragma unroll
    for (int st = 8; st >= 1; st >>= 1)
#pragma unroll
        for (int i = 0; i < 16; ++i) if ((i & st) == 0) cex(a[i], a[i + st]);
}
__device__ __forceinline__ void p5_topk(Frame& F, const Args& A) {
    unsigned char* ws = A.ws;
    const bf16* QP = (const bf16*)(ws + WS_QKV); const bf16* SK = (const bf16*)(ws + WS_SK); const float* SSQ = (const float*)(ws + WS_SSQ);
    v2u* META = (v2u*)(ws + WS_META); float* INVS = (float*)(ws + WS_INVS);
    const int lane = F.lane, r32 = lane & 31, hi = lane >> 5;
    const int cpg = F.G / 8, h = F.vcu / cpg, cg = F.vcu % cpg;
    { const v4u* src = (const v4u*)(SK + (size_t)h * 2 * 128 * 128);
      for (int i = F.tid; i < 2 * 128 * 16; i += NWAVES * 64) { const int p = i >> 11, key = (i >> 4) & 127, c = i & 15;
          *(LAS v4u*)(F.lds + RING_OFF + (((p * 8 + (c >> 1)) * 2 + (c & 1)) * 2048 + key * 16)) = src[i]; }
      LDS_WAIT(); __syncthreads(); }
    const LAS unsigned char* ska = F.lds + RING_OFF + hi * 2048 + r32 * 16;
    for (int g = cg * NWAVES + F.wave; g < M / 32; g += cpg * NWAVES) {
        const int t = g * 32 + r32;
        const bf16* qp = QP + (size_t)t * NQ + h * 256 + 8 * hi;
        float ss = 0.f;
#pragma unroll
        for (int i = 0; i < 16; ++i) ss += SSQ[(size_t)i * M + t];
        const float rstd = __builtin_amdgcn_rsqf(ss * (1.f / DM) + NORM_EPS);
        float m0[16], m1[16];
#pragma unroll
        for (int p = 0; p < 2; ++p) {
            f32x16 acc[4];
#pragma unroll
            for (int b = 0; b < 4; ++b) acc[b] = f32x16{};
            bf16x8 bq[8];
#pragma unroll
            for (int s = 0; s < 8; ++s) bq[s] = *(const bf16x8*)(qp + p * 128 + 16 * s);
#pragma unroll
            for (int s = 0; s < 8; ++s) {
#pragma unroll
                for (int b = 0; b < 4; ++b) { const bf16x8 ak = *(const LAS bf16x8*)(ska + (p * 8 + s) * 4096 + b * 512); acc[b] = __builtin_amdgcn_mfma_f32_32x32x16_bf16(ak, bq[s], acc[b], 0, 0, 0); }
                if (s & 1) __builtin_amdgcn_sched_barrier(0); }
            float L[16], G[16];
#pragma unroll
            for (int b = 0; b < 4; ++b) {
#pragma unroll
                for (int r = 0; r < 16; ++r) G[r] = __uint_as_float((__float_as_uint(acc[b][r]) & ~127u) | (unsigned)(b * 32 + (r & 3) + 8 * (r >> 2)));
                sort16_desc(G);
                if (b == 0) {
#pragma unroll
                    for (int r = 0; r < 16; ++r) L[r] = G[r];
                } else merge_top16(L, G);
            }
            { const unsigned hi4 = 4u * hi;
#pragma unroll
              for (int j = 0; j < 16; ++j) L[j] = __uint_as_float(__float_as_uint(L[j]) | hi4); }
            float O[16];
#pragma unroll
            for (int j = 0; j < 16; ++j) O[j] = __shfl_xor(L[j], 32);
            merge_top16(L, O);
#pragma unroll
            for (int j = 0; j < 16; ++j) { if (p == 0) m0[j] = L[j]; else m1[j] = L[j]; }
        }
        float T[16];
#pragma unroll
        for (int j = 0; j < 16; ++j) T[j] = -INFINITY;
#pragma unroll
        for (int a = 0; a < 16; ++a)
#pragma unroll
            for (int b = 0; b < 16; ++b) if ((a + 1) * (b + 1) <= 16) { const float v = m0[a] + m1[b]; const unsigned key = (__float_as_uint(v) & ~255u) | (unsigned)(a * 16 + b); topk_insert(T, __uint_as_float(key)); }
        const float thr = T[15], ref = T[0];
        int cnt = 0; float sum = 0.f; const float kk = rstd * 1.4426950408889634f;
        LAS v2u* mst = (LAS v2u*)(F.lds + RING_OFF + 65536 + F.wave * 4096);
        LAS v2u* meta = mst + r32 * 16;
#pragma unroll
        for (int a = 0; a < 16; ++a)
#pragma unroll
            for (int b = 0; b < 16; ++b) if ((a + 1) * (b + 1) <= 16) { const float v = m0[a] + m1[b]; const unsigned key = (__float_as_uint(v) & ~255u) | (unsigned)(a * 16 + b);
                if (__uint_as_float(key) >= thr) { const unsigned idx = ((__float_as_uint(m0[a]) & 127u) << 7) | (__float_as_uint(m1[b]) & 127u);
                    const float e = __builtin_amdgcn_exp2f((v - ref) * kk); if (hi == 0 && cnt < 16) meta[cnt] = (v2u){idx, __float_as_uint(e)}; sum += e; ++cnt; } }
        if (hi == 0) INVS[(size_t)t * 8 + h] = 1.0f / sum;
        LDS_WAIT(); asm volatile("" ::: "memory");
#pragma unroll
        for (int i = 0; i < 4; ++i) { const int ch = i * 64 + lane, tok = ch >> 3, c8 = ch & 7;
            const v4u val = *(const LAS v4u*)((const LAS unsigned char*)mst + tok * 128 + c8 * 16);
            *(v4u*)((unsigned char*)(META + ((size_t)(g * 32 + tok) * 8 + h) * 16) + c8 * 16) = val; }
        LDS_WAIT(); asm volatile("" ::: "memory");
    }
    __syncthreads();
}

typedef float f32x2v __attribute__((ext_vector_type(2)));
__device__ __forceinline__ void axpy16_fp4(f32x2v (&acc)[8], const v2u r, float wj) {
    const f32x2v ww = {wj, wj};
    const unsigned d0 = r.x, d1 = r.y;
    acc[0] = __builtin_amdgcn_cvt_scalef32_pk_f32_fp4(d0, 1.0f, 0) * ww + acc[0]; acc[1] = __builtin_amdgcn_cvt_scalef32_pk_f32_fp4(d0, 1.0f, 1) * ww + acc[1];
    acc[2] = __builtin_amdgcn_cvt_scalef32_pk_f32_fp4(d0, 1.0f, 2) * ww + acc[2]; acc[3] = __builtin_amdgcn_cvt_scalef32_pk_f32_fp4(d0, 1.0f, 3) * ww + acc[3];
    acc[4] = __builtin_amdgcn_cvt_scalef32_pk_f32_fp4(d1, 1.0f, 0) * ww + acc[4]; acc[5] = __builtin_amdgcn_cvt_scalef32_pk_f32_fp4(d1, 1.0f, 1) * ww + acc[5];
    acc[6] = __builtin_amdgcn_cvt_scalef32_pk_f32_fp4(d1, 1.0f, 2) * ww + acc[6]; acc[7] = __builtin_amdgcn_cvt_scalef32_pk_f32_fp4(d1, 1.0f, 3) * ww + acc[7];
}
typedef int v8i_t __attribute__((ext_vector_type(8)));

struct P6Ctx { __amdgpu_buffer_rsrc_t srdU, srdV; const f32x2v* SCL; int lane, lane8, n16, g4; };
__device__ __forceinline__ float p6_sel4(const f32x4 c, int i) { return (i & 2) ? ((i & 1) ? c[3] : c[2]) : ((i & 1) ? c[1] : c[0]); }
__device__ __forceinline__ void p6_flush(f32x2v (&acc)[8], const v2u (&prv)[16], float pw) {
#pragma unroll
    for (int j = 0; j < 16; ++j) axpy16_fp4(acc, prv[j], __uint_as_float(__builtin_amdgcn_readlane(__float_as_uint(pw), (j & 3) + 16 * (j >> 2))));
}
#define P6_ANCHOR(a) do { asm volatile("" : "+v"(a[0]), "+v"(a[1]), "+v"(a[2]), "+v"(a[3]), "+v"(a[4]), "+v"(a[5]), "+v"(a[6]), "+v"(a[7]) :: "memory"); __builtin_amdgcn_sched_barrier(0); } while (0)
#define P6_ROUND(accP, RVN, RVP, PWN, PWP, LSTK, RSTD, XSK) do { \
        const v2u le = (LSTK)[16 * p + n16p]; const unsigned lidx = le.x; const float lgate = __uint_as_float(le.y);        \
        const f32x2v scl = X.SCL[lidx]; \
        v2u ur[16];                                                        \
        _Pragma("unroll") for (int j = 0; j < 16; ++j) { const unsigned ei = __builtin_amdgcn_readlane(lidx, j); \
            ur[j] = __builtin_amdgcn_raw_buffer_load_b64(X.srdU, X.lane8, (int)(ei * EROW), 0); RVN[j] = __builtin_amdgcn_raw_buffer_load_b64(X.srdV, X.lane8, (int)(ei * EROW), 0); } \
        P6_ANCHOR(accP); \
        p6_flush(accP, RVP, PWP);                                          \
        P6_ANCHOR(accP); \
        _Pragma("unroll") for (int j = 0; j < 16; ++j) *(LAS v2u*)(ub + 528 * j + X.lane8) = ur[j];        \
        LDS_WAIT(); asm volatile("" ::: "memory"); \
        f32x4 ca = (f32x4){0.f, 0.f, 0.f, 0.f}, cb = (f32x4){0.f, 0.f, 0.f, 0.f}; \
        _Pragma("unroll") for (int s2 = 0; s2 < 8; ++s2) { const LAS v4u* bp = (const LAS v4u*)((XSK) + 128 * s2 + 16 * X.g4); const v4u b0 = bp[0], b1 = bp[4]; \
            const v4u av = *(const LAS v4u*)(ub + 528 * X.n16 + 64 * s2 + 16 * X.g4);                        \
            const v8i_t b8 = {(int)b0.x, (int)b0.y, (int)b0.z, (int)b0.w, (int)b1.x, (int)b1.y, (int)b1.z, (int)b1.w}; \
            const v8i_t a8 = {(int)av.x, (int)av.y, (int)av.z, (int)av.w, 0, 0, 0, 0}; \
            if (s2 & 1) cb = __builtin_amdgcn_mfma_scale_f32_16x16x128_f8f6f4(a8, b8, cb, 4  , 0  , 0, 0x7F7F7F7F, 0, 0x7F7F7F7F); \
            else        ca = __builtin_amdgcn_mfma_scale_f32_16x16x128_f8f6f4(a8, b8, ca, 4, 0, 0, 0x7F7F7F7F, 0, 0x7F7F7F7F); } \
        ca = ca + cb; \
        const int jL = 4 * X.g4 + (X.n16 & 3); \
        const float d = p6_sel4(ca, X.n16 & 3); \
        const float su = __uint_as_float((unsigned)__builtin_amdgcn_ds_bpermute(4 * jL, (int)__float_as_uint(scl.x))), sv = __uint_as_float((unsigned)__builtin_amdgcn_ds_bpermute(4 * jL, (int)__float_as_uint(scl.y))); \
        const float gt = __uint_as_float((unsigned)__builtin_amdgcn_ds_bpermute(4 * jL, (int)__float_as_uint(lgate))); \
        const float z = d * (RSTD) * su; \
        PWN = gt * (0.5f * z * (1.0f + erff(z * 0.70710678118654752f))) * sv; \
        asm volatile("" : "+v"(PWN) :: "memory"); __builtin_amdgcn_sched_barrier(0); \
    } while (0)
__device__ __forceinline__ void p6_experts(Frame& F, const Args& A) {
    unsigned char* ws = A.ws;
    const bf16* H1B = (const bf16*)(ws + WS_XN);
    const float* SSQ = (const float*)(ws + WS_SSQ); const v2u* META = (const v2u*)(ws + WS_META); const float* INVS = (const float*)(ws + WS_INVS);
    const float* gfin = A.in[16]; float* out = A.out;
    const int lane = F.lane;
    P6Ctx X;
    X.srdU = __builtin_amdgcn_make_buffer_rsrc((void*)(ws + WS_UV8), (short)0, (int)(NEXP * EROW), 0x00020000);
    X.srdV = __builtin_amdgcn_make_buffer_rsrc((void*)(ws + WS_UV8 + V4_OFF), (short)0, (int)(NEXP * EROW), 0x00020000);
    X.SCL = (const f32x2v*)(ws + WS_SCL); X.lane = lane; X.lane8 = lane * 8; X.n16 = lane & 15; X.g4 = lane >> 4;
    LAS unsigned char* xs = F.lds + RING_OFF + F.wave * 16640;
    LAS unsigned char* ub = xs + 8192;
    LAS v2u* lst = (LAS v2u*)(xs + 4096);
    LAS float* rsl = (LAS float*)(F.lds + RING_OFF + NWAVES * 16640 + F.wave * 16);
    const int gw = F.vcu * NWAVES + F.wave, NGW = F.G * NWAVES;
#pragma clang loop unroll(disable)
    for (int t0 = gw; t0 < M; t0 += 4 * NGW) {
        f32x2v acc[4][8];
#define P6_TOKLOAD(kk) do { const int t_ = t0 + (kk) * NGW; const int tc_ = t_ < M ? t_ : t0; int lp_ = lane; asm volatile("" : "+v"(lp_)); \
            n_ma = META[(size_t)tc_ * 128 + lp_]; n_mb = META[(size_t)tc_ * 128 + 64 + lp_]; n_ia = INVS[(size_t)tc_ * 8 + (lp_ >> 4)]; n_ib = INVS[(size_t)tc_ * 8 + 4 + (lp_ >> 4)]; \
            n_ssl = lp_ < 16 ? SSQ[(size_t)lp_ * M + tc_] : 0.f; { const v4u* xr_ = (const v4u*)(H1B + (size_t)tc_ * DM) + 2 * lp_; n_x0 = xr_[0]; n_x1 = xr_[1]; } } while (0)
        v2u n_ma, n_mb; float n_ia, n_ib, n_ssl; v4u n_x0, n_x1;
        P6_TOKLOAD(0);
#pragma clang loop unroll(disable)
        for (int k = 0; k < 4; ++k) {
            const bool tv = t0 + k * NGW < M;
            const v2u ma = n_ma, mb = n_mb; const float ia = n_ia, ib = n_ib, ssl = n_ssl; const v4u r0 = n_x0, r1 = n_x1;
            P6_TOKLOAD(k < 3 ? k + 1 : 3);
            int lane_p = lane; asm volatile("" : "+v"(lane_p));
            { const unsigned ba = ma.x >> 11, bb = mb.x >> 11; int ra = 0, rb = 0, off = 0;
#pragma unroll
              for (int sb = 0; sb < 8; ++sb) { const unsigned long long m0 = __ballot(ba == (unsigned)sb), m1 = __ballot(bb == (unsigned)sb);
                  const int c0 = __builtin_amdgcn_readfirstlane(__popcll(m0)), c1 = __builtin_amdgcn_readfirstlane(__popcll(m1));
                  const int w0 = off + (int)__builtin_amdgcn_mbcnt_hi((unsigned)(m0 >> 32), __builtin_amdgcn_mbcnt_lo((unsigned)m0, 0u));
                  const int w1 = off + c0 + (int)__builtin_amdgcn_mbcnt_hi((unsigned)(m1 >> 32), __builtin_amdgcn_mbcnt_lo((unsigned)m1, 0u));
                  ra = (ba == (unsigned)sb) ? w0 : ra; rb = (bb == (unsigned)sb) ? w1 : rb; off += c0 + c1; }
              lst[128 * k + ra] = (v2u){ma.x, __float_as_uint(tv ? __uint_as_float(ma.y) * ia : 0.f)};
              lst[128 * k + rb] = (v2u){mb.x, __float_as_uint(tv ? __uint_as_float(mb.y) * ib : 0.f)}; }
            { const float r_ = __builtin_amdgcn_rsqf(wave_sum(ssl) * (1.f / DM) + NORM_EPS); if (lane_p == 0) rsl[k] = r_; }
            { const unsigned xw[8] = {r0.x, r0.y, r0.z, r0.w, r1.x, r1.y, r1.z, r1.w}; v4u xq;
#pragma unroll
              for (int cc = 0; cc < 4; ++cc) { int pk = __builtin_amdgcn_cvt_pk_fp8_f32(__uint_as_float(xw[2 * cc] << 16), __uint_as_float(xw[2 * cc] & 0xffff0000u), 0, false);
                  pk = __builtin_amdgcn_cvt_pk_fp8_f32(__uint_as_float(xw[2 * cc + 1] << 16), __uint_as_float(xw[2 * cc + 1] & 0xffff0000u), pk, true); xq[cc] = (unsigned)pk; }
              *(LAS v4u*)(xs + 1024 * k + 16 * lane_p) = xq; }
        }
#undef P6_TOKLOAD
#pragma unroll
        for (int k = 0; k < 4; ++k)
#pragma unroll
            for (int i = 0; i < 8; ++i) acc[k][i] = (f32x2v){0.f, 0.f};
        LDS_WAIT(); asm volatile("" ::: "memory");
        v2u rvA[16], rvB[16]; float pwA = 0.f, pwB = 0.f;
#pragma unroll
        for (int j = 0; j < 16; ++j) rvB[j] = (v2u){0u, 0u};
#pragma clang loop unroll(disable)
        for (int p = 0; p < 8; ++p) {
            int n16p = X.n16; asm volatile("" : "+v"(n16p));
            P6_ROUND(acc[3], rvA, rvB, pwA, pwB, lst,       rsl[0], xs);
            P6_ROUND(acc[0], rvB, rvA, pwB, pwA, lst + 128, rsl[1], xs + 1024);
            P6_ROUND(acc[1], rvA, rvB, pwA, pwB, lst + 256, rsl[2], xs + 2048);
            P6_ROUND(acc[2], rvB, rvA, pwB, pwA, lst + 384, rsl[3], xs + 3072);
        }
        v4u ex0[4], ex1[4];
        { int lane_x = lane; asm volatile("" : "+v"(lane_x));
#pragma unroll
          for (int k = 0; k < 4; ++k) { const int t_ = t0 + k * NGW; const int tc_ = t_ < M ? t_ : t0; const v4u* xr = (const v4u*)(H1B + (size_t)tc_ * DM) + 2 * lane_x; ex0[k] = xr[0]; ex1[k] = xr[1]; } }
        P6_ANCHOR(acc[3]);
        p6_flush(acc[3], rvB, pwB);
        P6_ANCHOR(acc[3]);
        int lane_e = lane; asm volatile("" : "+v"(lane_e));
#pragma unroll
        for (int k = 0; k < 4; ++k) {
            const int t = t0 + k * NGW;
            if (t < M) {
                const v4u r0 = ex0[k], r1 = ex1[k];
                const unsigned xw[8] = {r0.x, r0.y, r0.z, r0.w, r1.x, r1.y, r1.z, r1.w};
                float* hrow = out + (size_t)t * DM + 16 * lane_e;
                f32x4 h[4]; float s2 = 0.f;
#pragma unroll
                for (int i = 0; i < 4; ++i) { h[i] = (f32x4){__uint_as_float(xw[2 * i] << 16), __uint_as_float(xw[2 * i] & 0xffff0000u), __uint_as_float(xw[2 * i + 1] << 16), __uint_as_float(xw[2 * i + 1] & 0xffff0000u)}
                                                   + (f32x4){acc[k][2 * i].x, acc[k][2 * i].y, acc[k][2 * i + 1].x, acc[k][2 * i + 1].y};
                    s2 += (h[i].x * h[i].x + h[i].y * h[i].y) + (h[i].z * h[i].z + h[i].w * h[i].w); }
                const float rf = __builtin_amdgcn_rsqf(wave_sum(s2) * (1.f / DM) + NORM_EPS);
#pragma unroll
                for (int i = 0; i < 4; ++i) *(f32x4*)(hrow + 4 * i) = h[i] * rf * *(const f32x4*)(gfin + 16 * lane_e + 4 * i);
            }
        }
        LDS_WAIT(); asm volatile("" ::: "memory");
    }
}
#undef P6_ROUND
#undef P6_ANCHOR

__global__ void __launch_bounds__(NWAVES * 64, 2) fwd_kernel(Args args) {
    extern __shared__ __attribute__((aligned(16))) unsigned char lds[];
    Frame F;
    F.lds = (LAS unsigned char*)lds;
    F.MISC = (volatile LAS unsigned*)(F.lds + MISC_OFF);
    F.tid = threadIdx.x; F.lane = F.tid & 63; F.wave = __builtin_amdgcn_readfirstlane(F.tid >> 6);
    F.G = gridDim.x; { const int bx = blockIdx.x; F.vcu = (F.G % 8 == 0) ? (bx % 8) * (F.G / 8) + bx / 8 : bx; }
    unsigned char* ws = args.ws;
    F.ctl = (gu32*)(ws + WS_CTL);
    for (int u = F.tid; u < (LDS_BYTES - LDSCTL_OFF) / 4; u += NWAVES * 64) ((LAS unsigned*)(F.lds + LDSCTL_OFF))[u] = 0u;
    __syncthreads();
    XcdBarrier bar; bar.bar = (unsigned*)(F.ctl + CW_BAR); bar.x = 0; bar.st = nullptr;
    if (N_LAUNCHES != PER_PHASE) bar = xcd_barrier_post((unsigned*)(F.ctl + CW_BAR), F.MISC + 8);
#define GRID_BAR() do { if (N_LAUNCHES != PER_PHASE) xcd_barrier(bar); } while (0)
    const int lo = args.ph_lo, hi = args.ph_hi;
#ifndef PH_MASK
#define PH_MASK 0x7f
#endif
#define IN(k) (((PH_MASK >> (k)) & 1) && lo <= (k) && (k) < hi)
#define BOTH(k) (IN(k) && IN((k) + 1))

    if (IN(0)) { p0_prologue(F, args); if (BOTH(0)) GRID_BAR(); }

    if (IN(1)) {
        pg8::Gemm g{(const pg8::bf16_t*)(ws + WS_XN), (const pg8::bf16_t*)(ws + WS_WIN), M, NIN, DM}; pg8::StaticOrder S; S.init(M, NIN, F.G, (int)blockIdx.x);
        pg8::EpiInProj E{(pg8::bf16_t*)(ws + WS_QKV), args.in[3], args.in[4], (const float*)(ws + WS_TROW), (const float*)(ws + WS_TCOL), (const float*)(ws + WS_TPOS), C2, (unsigned*)(ws + WS_CTL) + 65536};
        pg8::gemm_phase<pg8::EpiInProj, pg8::StaticOrder, true, true>(F.lds + RING_OFF, g, S, E);
        { const int nfull = (M / 256) * (NIN / 256) % F.G;
          if (nfull == 0) p0_lazy(F, args, F.vcu * NWAVES + F.wave, F.G * NWAVES);
          else if ((int)blockIdx.x >= nfull) p0_lazy(F, args, ((int)blockIdx.x - nfull) * NWAVES + F.wave, (F.G - nfull) * NWAVES); }
        if (BOTH(1)) GRID_BAR();
    }

    if (IN(2)) {
        using abf = attn_body::bf16;
        const abf* planes = (const abf*)(ws + WS_QKV); abf* AO = (abf*)(ws + WS_AO);
        constexpr size_t PL = (size_t)M * 64;
        const __amdgpu_buffer_rsrc_t srd = __builtin_amdgcn_make_buffer_rsrc((void*)(ws + WS_QKV), (short)0, (int)(36 * PL * 2), 0x00020000);
#ifndef NO_A
        const float mub = C2 * 64.0f * 1.15f * wave_max(__builtin_fabsf(args.in[3][F.lane])) * wave_max(__builtin_fabsf(args.in[4][F.lane]));
        const bool sbound = mub < 60.0f;
        for (int ua = F.vcu * 2; ua < 512; ua += F.G * 2)
            for (int k = 0; k < 2; ++k) { const int hA = (ua + k) >> 6, qb = (ua + k) & 63;
                attn_body::attn_unit_a<8>(qb, planes + (size_t)hA * PL, srd, (unsigned)((8 + (hA >> 2)) * PL * 2), (unsigned)((10 + (hA >> 2)) * PL * 2), AO + hA * 64, (char*)lds + RING_OFF, sbound ? mub : 0.f, sbound); }
#endif
        const float d1 = wave_sum(args.in[5][F.lane] * args.in[6][F.lane]), d2 = wave_sum(args.in[7][F.lane] * args.in[8][F.lane]);
        const float lam = __expf(d1) - __expf(d2) + 0.2f;
        float* sc = (float*)(ws + WS_XN) + (size_t)F.vcu * (NWAVES * 4096);
#ifndef NO_B
        for (int ub = F.vcu; ub < 256; ub += F.G) { const int hB = ub >> 6, qb = ub & 63;
            for (int comp = 0; comp < 2; ++comp) {
                const unsigned* nmax = (const unsigned*)(ws + WS_CTL) + 65536;
                const float mb = 1.15f * __builtin_sqrtf(__uint_as_float(nmax[12 + 2 * hB + comp]) * __uint_as_float(nmax[20 + 2 * hB + comp]));
                const bool sb = mb < 60.0f;
                attn_body::attn_unit_b<8>(qb, comp, planes + (size_t)(12 + 2 * hB + comp) * PL, srd, (unsigned)((20 + 2 * hB + comp) * PL * 2), (unsigned)((28 + 2 * hB) * PL * 2),
                                          sc, lam, args.in[9], AO + 512 + hB * 128, (char*)lds + RING_OFF, sb ? mb : 0.f, sb); } }
#endif
        if (BOTH(2)) GRID_BAR();
    }

    if (IN(3)) {
        pg8::Gemm g{(const pg8::bf16_t*)(ws + WS_AO), (const pg8::bf16_t*)(ws + WS_WOUT), M, DM, DM}; pg8::StaticOrder S; S.init(M, DM, F.G, (int)blockIdx.x);
        pg8::EpiOutProj E{args.in[0], args.out, (pg8::bf16_t*)(ws + WS_XN), (float*)(ws + WS_SSQ)};
        pg8::gemm_phase<pg8::EpiOutProj, pg8::StaticOrder, true, true>(F.lds + RING_OFF, g, S, E);
        if (BOTH(3)) GRID_BAR();
    }

    if (IN(4)) {
        pg8::Gemm g{(const pg8::bf16_t*)(ws + WS_XN), (const pg8::bf16_t*)(ws + WS_WQ), M, NQ, DM}; pg8::StaticOrder S; S.init(M, NQ, F.G, (int)blockIdx.x);
        pg8::EpiBf16 E{(pg8::bf16_t*)(ws + WS_QKV), NQ};
        pg8::gemm_phase<pg8::EpiBf16, pg8::StaticOrder, true, true>(F.lds + RING_OFF, g, S, E);
        if (BOTH(4)) GRID_BAR();
    }

    if (IN(5)) { p5_topk(F, args); if (BOTH(5)) GRID_BAR(); }

    if (IN(6)) { p6_experts(F, args); }
#undef IN
#undef BOTH
#undef GRID_BAR
}

extern "C" void kernel_launch(void* const* d_in, const int* in_sizes, int n_in, void* d_out, int out_size, void* d_ws, size_t ws_size, hipStream_t stream) {
    static int grid = 0;
    if (grid == 0) {
        if (n_in != 17 || in_sizes[0] != M * DM || out_size != M * DM || ws_size < WS_END) { fprintf(stderr, "kernel_launch: unexpected shapes (n_in %d, in0 %d, out %d, ws %zu); nothing launched\n", n_in, n_in > 0 ? in_sizes[0] : -1, out_size, ws_size); grid = -1; return; }
        int dev = 0, cus = 0, per_cu = 0;
        if (hipGetDevice(&dev) != hipSuccess || hipDeviceGetAttribute(&cus, hipDeviceAttributeMultiprocessorCount, dev) != hipSuccess) { fprintf(stderr, "kernel_launch: device query failed\n"); grid = -1; return; }
        if (hipFuncSetAttribute((const void*)fwd_kernel, hipFuncAttributeMaxDynamicSharedMemorySize, LDS_BYTES) != hipSuccess) { fprintf(stderr, "kernel_launch: hipFuncSetAttribute failed\n"); grid = -1; return; }
        if (hipOccupancyMaxActiveBlocksPerMultiprocessor(&per_cu, (const void*)fwd_kernel, NWAVES * 64, LDS_BYTES) != hipSuccess || per_cu < 1)
            fprintf(stderr, "kernel_launch: note: occupancy query reports %d workgroups per CU\n", per_cu);
        (void)hipGetLastError();
        grid = cus;
        if (grid != 256) { fprintf(stderr, "kernel_launch: built for a 256-CU device, found %d CUs; nothing launched\n", cus); grid = -1; return; }
    }
    if (grid < 0) return;
    if (hipMemsetAsync((char*)d_ws + WS_CTL, 0, CTL_ZERO_BYTES, stream) != hipSuccess) { fprintf(stderr, "kernel_launch: hipMemsetAsync failed\n"); return; }
    Args a{};
    for (int i = 0; i < 17; ++i) a.in[i] = (const float*)d_in[i];
    a.out = (float*)d_out; a.ws = (unsigned char*)d_ws;
    for (int i = 0; i < 16; ++i) a.inv_ax[i] = pow(10000.0, -(2.0 * i) / 32.0);
    for (int i = 0; i < 8; ++i) a.inv_p[i] = pow(500000.0, -(2.0 * i) / 16.0);
#ifdef PHASE_LIST
    static const int plist[] = {PHASE_LIST}; constexpr int NL = sizeof(plist) / sizeof(int);
#else
    constexpr int NL = N_LAUNCHES;
#endif
    for (int li = 0; li < NL; ++li) {
#ifdef PHASE_LIST
        a.ph_lo = plist[li]; a.ph_hi = plist[li] + 1; a.li = li;
#else
        a.ph_lo = (N_LAUNCHES == PER_PHASE) ? li : 0; a.ph_hi = (N_LAUNCHES == PER_PHASE) ? li + 1 : PER_PHASE; a.li = li;
#endif
        hipLaunchKernelGGL(fwd_kernel, dim3(grid), dim3(NWAVES * 64), LDS_BYTES, stream, a);
        const hipError_t le = hipPeekAtLastError();
        if (le != hipSuccess) { fprintf(stderr, "kernel_launch: launch %d failed: %s\n", li, hipGetErrorName(le)); break; }
    }
}
```

```cpp
#include <hip/hip_runtime.h>
#include <hip/hip_bf16.h>
#include <cstdio>
#include <cstdint>
#include <cmath>
namespace pg8 {
#define PG8_LAS __attribute__((address_space(3)))
typedef unsigned short bf16_t;
typedef short bf16x8 __attribute__((ext_vector_type(8)));
typedef float f32x4 __attribute__((ext_vector_type(4)));
typedef unsigned u32x4 __attribute__((ext_vector_type(4)));
constexpr int BM = 256, BK = 64, HALF = 128, HTB = HALF * BK * 2  , STAGE_BYTES = 8 * HTB, NXCD = 8, WGM = 8;

__host__ __device__ __forceinline__ int lds_byte(int r, int c) { const int st = (r >> 4) * 2 + (c >> 5), rr = r & 15, cc = c & 31, ob = rr * 64 + cc * 2; return st * 1024 + (ob ^ (((ob >> 9) & 1) << 5)); }
__host__ __device__ __forceinline__ void stage_rc(int b, int& R, int& C) { const int st = b / 1024, sb = b % 1024, swz = sb ^ (((sb >> 9) & 1) << 5); R = (st >> 1) * 16 + swz / 64; C = (st & 1) * 32 + (swz % 64) / 2; }
__host__ __device__ __forceinline__ int perm32(int rho) { const int n = rho >> 4, i = rho & 15; return 8 * (i >> 2) + 4 * n + (i & 3); }

struct Unit { int pm, pn; };
struct Gemm { const bf16_t* A; const bf16_t* Bt; int M, N, K; };

struct StaticOrder {
    int nM, nN, nwg, G, c;
    __host__ __device__ void init(int M, int N, int G_, int c_) { nM = M / BM; nN = N / BM; nwg = nM * nN; G = G_; c = c_; }
    __host__ __device__ bool next(int i, Unit& u) const {
        const long L = (long)i * G + c; if (L >= nwg) return false;
        int wgid = (int)L; { const int q = nwg / NXCD, r = nwg % NXCD, xcd = wgid % NXCD, off = wgid / NXCD; wgid = (xcd < r ? xcd * (q + 1) : r * (q + 1) + (xcd - r) * q) + off; }
        const int nig = WGM * nN, gid = wgid / nig, fm = gid * WGM, gsz = (nM - fm) < WGM ? (nM - fm) : WGM;
        u.pm = fm + ((wgid % nig) % gsz); u.pn = (wgid % nig) / gsz; return true;
    }
    __device__ __forceinline__ void a_ready(const Unit&) const {}
    __device__ __forceinline__ void done(const Unit&) const {}
};

__device__ __forceinline__ unsigned cvt_pk_bf16(float lo, float hi) { unsigned r; asm volatile("v_cvt_pk_bf16_f32 %0, %1, %2" : "=v"(r) : "v"(lo), "v"(hi)); return r; }
typedef float f32x2 __attribute__((ext_vector_type(2)));
typedef unsigned u32x2 __attribute__((ext_vector_type(2)));

struct EpiBf16 {
    static constexpr bool PERM = true, AFTER_DRAIN = false;
    bf16_t* O; int ldc;
    __device__ __forceinline__ void operator()(const f32x4 (&acc)[2][2][4][2], const Unit& u, int wr, int wc, int fr, int fq) const {
        const int row0 = u.pm * BM + wr * 64 + fr; const int col0 = u.pn * BM + wc * 32 + 8 * fq;
#pragma unroll
        for (int ai = 0; ai < 2; ++ai)
#pragma unroll
            for (int m = 0; m < 4; ++m) { bf16_t* rowp = O + (size_t)(row0 + ai * HALF + m * 16) * ldc + col0;
#pragma unroll
                for (int bj = 0; bj < 2; ++bj) { const f32x4 v0 = acc[ai][bj][m][0], v1 = acc[ai][bj][m][1];
                    u32x4 w; w.x = cvt_pk_bf16(v0[0], v0[1]); w.y = cvt_pk_bf16(v0[2], v0[3]); w.z = cvt_pk_bf16(v1[0], v1[1]); w.w = cvt_pk_bf16(v1[2], v1[3]);
                    *(u32x4*)(rowp + bj * HALF) = w; } }
    }
};

__device__ __forceinline__ unsigned pk4_fp8(const f32x4 v, float f) { int p = __builtin_amdgcn_cvt_pk_fp8_f32(v[0] * f, v[1] * f, 0, false); p = __builtin_amdgcn_cvt_pk_fp8_f32(v[2] * f, v[3] * f, p, true); return (unsigned)p; }
struct EpiInProj {
    static constexpr bool PERM = true, AFTER_DRAIN = false;
    bf16_t* planes; const float* qg; const float* kg; const float* trow; const float* tcol; const float* tpos; float c2; unsigned* nmax;
    __device__ __forceinline__ void operator()(const f32x4 (&acc)[2][2][4][2], const Unit& u, int wr, int wc, int fr, int fq) const {
        const int slot = u.pn * 4 + wc;
        bf16_t* plane = planes + (size_t)slot * (16384 * 64);
        const int rowb = u.pm * BM + wr * 64 + fr;
        if (slot < 10) {
            const float* g = slot < 8 ? qg : kg; const float sc = slot < 8 ? c2 : 1.f; const float f8 = slot < 8 ? 8.f : 1.f;
            f32x4 gv[2][2];
#pragma unroll
            for (int bj = 0; bj < 2; ++bj)
#pragma unroll
                for (int n = 0; n < 2; ++n) gv[bj][n] = *(const f32x4*)(g + 32 * bj + 16 * n + 4 * fq);
#pragma unroll
            for (int ai = 0; ai < 2; ++ai)
#pragma unroll
                for (int m = 0; m < 4; ++m) { const int row = rowb + ai * HALF + m * 16;
                    float ss = 0.f;
#pragma unroll
                    for (int bj = 0; bj < 2; ++bj)
#pragma unroll
                        for (int n = 0; n < 2; ++n) { const f32x4 x = acc[ai][bj][m][n]; ss += (x[0] * x[0] + x[1] * x[1]) + (x[2] * x[2] + x[3] * x[3]); }
                    ss += __shfl_xor(ss, 16); ss += __shfl_xor(ss, 32);
                    const float rn = __builtin_amdgcn_rsqf(ss * (1.0f / 64.0f) + 1e-6f);
                    const float* tr = trow + (row >> 6) * 32 + 4 * fq; const float* tc = tcol + (row & 63) * 32 + 4 * fq;
#pragma unroll
                    for (int bj = 0; bj < 2; ++bj) { const float* tb = bj ? tc : tr; const f32x4 c = *(const f32x4*)tb, s = *(const f32x4*)(tb + 16);
                        const f32x4 y0 = acc[ai][bj][m][0] * rn * gv[bj][0], y1 = acc[ai][bj][m][1] * rn * gv[bj][1];
                        const f32x4 o0 = (y0 * c - y1 * s) * sc, o1 = (y1 * c + y0 * s) * sc;
                        u32x2 w; w.x = pk4_fp8(o0, f8); w.y = pk4_fp8(o1, f8);
                        *(u32x2*)((char*)plane + (size_t)row * 64 + 32 * bj + 8 * fq) = w; } }
        } else if (slot >= 12 && slot < 28) {
            const float sc = slot < 20 ? c2 : 1.f; const float f8 = slot < 20 ? 8.f : 1.f; const bool rot = fq < 2; float nm = 0.f;
#pragma unroll
            for (int ai = 0; ai < 2; ++ai)
#pragma unroll
                for (int m = 0; m < 4; ++m) { const int row = rowb + ai * HALF + m * 16;
                    const float* tp = tpos + (size_t)row * 16 + 4 * (fq & 1);
                    f32x4 c = *(const f32x4*)tp, s = *(const f32x4*)(tp + 8);
                    if (!rot) { c = (f32x4){1.f, 1.f, 1.f, 1.f}; s = (f32x4){0.f, 0.f, 0.f, 0.f}; }
                    const f32x4 y0 = acc[ai][0][m][0], y1 = acc[ai][0][m][1];
                    const f32x4 o0 = (y0 * c - y1 * s) * sc, o1 = (y1 * c + y0 * s) * sc;
                    u32x2 w; w.x = pk4_fp8(o0, f8); w.y = pk4_fp8(o1, f8);
                    *(u32x2*)((char*)plane + (size_t)row * 64 + 8 * fq) = w;
                    const f32x4 z0 = acc[ai][1][m][0] * sc, z1 = acc[ai][1][m][1] * sc;
                    u32x2 w2; w2.x = pk4_fp8(z0, f8); w2.y = pk4_fp8(z1, f8);
                    *(u32x2*)((char*)plane + (size_t)row * 64 + 32 + 8 * fq) = w2;
                    float ss = (o0[0] * o0[0] + o0[1] * o0[1]) + (o0[2] * o0[2] + o0[3] * o0[3]) + (o1[0] * o1[0] + o1[1] * o1[1]) + (o1[2] * o1[2] + o1[3] * o1[3])
                             + (z0[0] * z0[0] + z0[1] * z0[1]) + (z0[2] * z0[2] + z0[3] * z0[3]) + (z1[0] * z1[0] + z1[1] * z1[1]) + (z1[2] * z1[2] + z1[3] * z1[3]);
                    ss += __shfl_xor(ss, 16); ss += __shfl_xor(ss, 32); nm = __builtin_fmaxf(nm, ss); }
#pragma unroll
            for (int o = 1; o < 16; o <<= 1) nm = __builtin_fmaxf(nm, __shfl_xor(nm, o));
            if ((fr | fq) == 0) atomicMax(nmax + slot, __float_as_uint(nm));
        } else {
#pragma unroll
            for (int ai = 0; ai < 2; ++ai)
#pragma unroll
                for (int m = 0; m < 4; ++m) { const int row = rowb + ai * HALF + m * 16;
#pragma unroll
                    for (int bj = 0; bj < 2; ++bj) { const f32x4 v0 = acc[ai][bj][m][0], v1 = acc[ai][bj][m][1];
                        u32x4 w; w.x = cvt_pk_bf16(v0[0], v0[1]); w.y = cvt_pk_bf16(v0[2], v0[3]); w.z = cvt_pk_bf16(v1[0], v1[1]); w.w = cvt_pk_bf16(v1[2], v1[3]);
                        *(u32x4*)(plane + (size_t)row * 64 + 32 * bj + 8 * fq) = w; } }
        }
    }
};

struct EpiOutProj {
    static constexpr bool PERM = false, AFTER_DRAIN = false;
    const float* x; float* h1; bf16_t* h1b; float* ssq;
    __device__ __forceinline__ void operator()(const f32x4 (&acc)[2][2][4][2], const Unit& u, int wr, int wc, int fr, int fq) const {
        const int col0 = u.pn * BM + wc * 32 + 4 * fq;
#pragma unroll
        for (int ai = 0; ai < 2; ++ai)
#pragma unroll
            for (int m = 0; m < 4; ++m) { const int row = u.pm * BM + ai * HALF + wr * 64 + m * 16 + fr; const size_t off = (size_t)row * 1024 + col0; float ss = 0.f;
#pragma unroll
                for (int bj = 0; bj < 2; ++bj)
#pragma unroll
                    for (int n = 0; n < 2; ++n) { const size_t o = off + bj * HALF + n * 16; const f32x4 h = *(const f32x4*)(x + o) + acc[ai][bj][m][n];
                        u32x2 w; w.x = cvt_pk_bf16(h[0], h[1]); w.y = cvt_pk_bf16(h[2], h[3]); *(u32x2*)(h1b + o) = w;
                        ss += (h[0] * h[0] + h[1] * h[1]) + (h[2] * h[2] + h[3] * h[3]); }
                ss += __shfl_xor(ss, 16); ss += __shfl_xor(ss, 32);
                if (fq == 0) ssq[(size_t)(u.pn * 4 + wc) * 16384 + row] = ss; }
    }
};

template <class Epi, class Sched, bool ALIGN_EPI = false, bool SP2 = false>
__device__ __forceinline__ void gemm_phase(PG8_LAS unsigned char* lds, const Gemm g, const Sched& S, const Epi& E) {
    const int tid = threadIdx.x, wid = __builtin_amdgcn_readfirstlane(tid >> 6), lane = tid & 63, wr = wid >> 2, wc = wid & 3, fr = lane & 15, fq = lane >> 4;
    const int K = g.K, nt = K / BK;
    unsigned voffA[2], voffB[2];
#pragma unroll
    for (int i = 0; i < 2; ++i) { int R, C; stage_rc(tid * 16 + i * 8192, R, C); const int Rb = Epi::PERM ? ((R & ~31) + perm32(R & 31)) : R;
        voffA[i] = (unsigned)(R * K + C) * 2u; voffB[i] = (unsigned)(Rb * K + C) * 2u; }
    const size_t kstep = (size_t)(BK * 2);
    const size_t hstep = (size_t)HALF * K * 2;
    const size_t tstep = 2 * hstep;
    const unsigned ldsw = (unsigned)wid * 1024u;
    const int aoff = lds_byte(wr * 64 + fr, fq * 8), boff = lds_byte(wc * 32 + fr, fq * 8);
#define PG8_SA(b, h) (((b) * 2 + (h)) * HTB)
#define PG8_SB(b, h) ((4 + (b) * 2 + (h)) * HTB)
#define PG8_STAGE(bufoff, gbase, voff) do { _Pragma("unroll") for (int _i = 0; _i < 2; ++_i) \
        __builtin_amdgcn_global_load_lds((const unsigned*)((const char*)(gbase) + (voff)[_i]), (PG8_LAS unsigned*)(lds + (bufoff) + ldsw + _i * 8192), 16, 0, 0); } while (0)
#define PG8_LDA(dst, b, h) do { _Pragma("unroll") for (int m = 0; m < 4; ++m) _Pragma("unroll") for (int k = 0; k < 2; ++k) dst[m][k] = *(const PG8_LAS bf16x8*)(lds + PG8_SA(b, h) + aoff + m * 2048 + k * 1024); } while (0)
#define PG8_LDB(dst, b, h) do { _Pragma("unroll") for (int n = 0; n < 2; ++n) _Pragma("unroll") for (int k = 0; k < 2; ++k) dst[n][k] = *(const PG8_LAS bf16x8*)(lds + PG8_SB(b, h) + boff + n * 2048 + k * 1024); } while (0)
#define PG8_MMA(ai, bj, At, Bt) do { __builtin_amdgcn_s_setprio(1); _Pragma("unroll") for (int m = 0; m < 4; ++m) _Pragma("unroll") for (int n = 0; n < 2; ++n) _Pragma("unroll") for (int k = 0; k < 2; ++k) \
        acc[ai][bj][m][n] = __builtin_amdgcn_mfma_f32_16x16x32_bf16(Bt[n][k], At[m][k], acc[ai][bj][m][n], 0, 0, 0); __builtin_amdgcn_s_setprio(0); } while (0)
#define PG8_WAIT_V(n) asm volatile("s_waitcnt vmcnt(" #n ")" ::: "memory")
#define PG8_WAIT_L(n) asm volatile("s_waitcnt lgkmcnt(" #n ")" ::: "memory")
#define PG8_BAR __builtin_amdgcn_s_barrier()
#define PG8_SCHED __builtin_amdgcn_sched_barrier(0)
    Unit cur, nxt; int ui = 0;
    if (!S.next(0, cur)) return;
    f32x4 acc[2][2][4][2];
#pragma unroll
    for (int a = 0; a < 2; ++a)
#pragma unroll
        for (int b = 0; b < 2; ++b)
#pragma unroll
            for (int m = 0; m < 4; ++m)
#pragma unroll
                for (int n = 0; n < 2; ++n) acc[a][b][m][n] = (f32x4){0.f, 0.f, 0.f, 0.f};
    bf16x8 At[4][2], B0[2][2], B1[2][2];
    const char* cA = (const char*)g.A + (size_t)cur.pm * tstep; const char* cB = (const char*)g.Bt + (size_t)cur.pn * tstep;
    S.a_ready(cur);
    if constexpr (SP2) {
        PG8_STAGE(PG8_SB(0, 0), cB, voffB); PG8_STAGE(PG8_SB(0, 1), cB + hstep, voffB); PG8_STAGE(PG8_SA(0, 0), cA, voffA); PG8_STAGE(PG8_SA(0, 1), cA + hstep, voffA);
        if (wr == 1) PG8_BAR;
        PG8_WAIT_V(2); PG8_BAR;
        PG8_STAGE(PG8_SB(1, 0), cB + kstep, voffB); PG8_STAGE(PG8_SA(1, 0), cA + kstep, voffA); PG8_STAGE(PG8_SB(1, 1), cB + hstep + kstep, voffB);
        PG8_WAIT_V(6); PG8_BAR;
    } else {
        PG8_STAGE(PG8_SB(0, 0), cB, voffB); PG8_STAGE(PG8_SA(0, 0), cA, voffA); PG8_STAGE(PG8_SB(0, 1), cB + hstep, voffB); PG8_STAGE(PG8_SA(0, 1), cA + hstep, voffA);
        if (wr == 1) PG8_BAR;
        PG8_WAIT_V(4); PG8_BAR;
        PG8_STAGE(PG8_SB(1, 0), cB + kstep, voffB); PG8_STAGE(PG8_SA(1, 0), cA + kstep, voffA); PG8_STAGE(PG8_SB(1, 1), cB + hstep + kstep, voffB);
        PG8_WAIT_V(6); PG8_BAR;
    }
    for (;;) {
        const bool has_next = S.next(ui + 1, nxt);
        const char* nA = has_next ? (const char*)g.A + (size_t)nxt.pm * tstep : cA; const char* nB = has_next ? (const char*)g.Bt + (size_t)nxt.pn * tstep : cB;
        for (int t = 0; t < nt; t += 2) {
            const bool last = (t == nt - 2);
            const char* a1 = cA + (size_t)(t + 1) * kstep;
            const char* a2 = last ? nA : cA + (size_t)(t + 2) * kstep; const char* b2 = last ? nB : cB + (size_t)(t + 2) * kstep;
            const char* a3 = a2 + kstep; const char* b3 = b2 + kstep;
            if (last && has_next) S.a_ready(nxt);
            if constexpr (SP2) {
            PG8_LDB(B0, 0, 0); PG8_LDB(B1, 0, 1); PG8_SCHED; PG8_LDA(At, 0, 0); PG8_STAGE(PG8_SA(1, 1), a1 + hstep, voffA);
            PG8_WAIT_V(8); PG8_WAIT_L(0); PG8_BAR; PG8_MMA(0, 0, At, B0); PG8_MMA(0, 1, At, B1); PG8_BAR; PG8_SCHED;
            PG8_LDA(At, 0, 1); PG8_STAGE(PG8_SB(0, 0), b2, voffB); PG8_STAGE(PG8_SB(0, 1), b2 + hstep, voffB); PG8_STAGE(PG8_SA(0, 0), a2, voffA);
            PG8_WAIT_V(8); PG8_WAIT_L(0); PG8_BAR; PG8_MMA(1, 0, At, B0); PG8_MMA(1, 1, At, B1); PG8_BAR; PG8_SCHED;
            PG8_LDB(B0, 1, 0); PG8_LDB(B1, 1, 1); PG8_SCHED; PG8_LDA(At, 1, 0); PG8_STAGE(PG8_SA(0, 1), a2 + hstep, voffA);
            PG8_WAIT_V(8); PG8_WAIT_L(0); PG8_BAR; PG8_MMA(0, 0, At, B0); PG8_MMA(0, 1, At, B1); PG8_BAR; PG8_SCHED;
            PG8_LDA(At, 1, 1); PG8_STAGE(PG8_SB(1, 0), b3, voffB); PG8_STAGE(PG8_SB(1, 1), b3 + hstep, voffB); PG8_STAGE(PG8_SA(1, 0), a3, voffA);
            PG8_WAIT_V(8); PG8_WAIT_L(0); PG8_BAR; PG8_MMA(1, 0, At, B0); PG8_MMA(1, 1, At, B1); PG8_BAR; PG8_SCHED;
            } else {
            PG8_LDB(B0, 0, 0); PG8_SCHED; PG8_LDA(At, 0, 0); PG8_STAGE(PG8_SA(1, 1), a1 + hstep, voffA);
            PG8_WAIT_L(8); PG8_BAR; PG8_WAIT_L(0); PG8_MMA(0, 0, At, B0); PG8_BAR; PG8_SCHED;
            PG8_LDB(B1, 0, 1); PG8_STAGE(PG8_SB(0, 0), b2, voffB);
            PG8_BAR; PG8_WAIT_L(0); PG8_MMA(0, 1, At, B1); PG8_BAR;
            PG8_LDA(At, 0, 1); PG8_STAGE(PG8_SA(0, 0), a2, voffA);
            PG8_BAR; PG8_WAIT_L(0); PG8_MMA(1, 0, At, B0); PG8_BAR; PG8_SCHED;
            PG8_STAGE(PG8_SB(0, 1), b2 + hstep, voffB);
            PG8_WAIT_V(6); PG8_BAR; PG8_MMA(1, 1, At, B1); PG8_BAR;
            PG8_LDB(B0, 1, 0); PG8_SCHED; PG8_LDA(At, 1, 0); PG8_STAGE(PG8_SA(0, 1), a2 + hstep, voffA);
            PG8_WAIT_L(8); PG8_BAR; PG8_WAIT_L(0); PG8_MMA(0, 0, At, B0); PG8_BAR; PG8_SCHED;
            PG8_LDB(B1, 1, 1); PG8_STAGE(PG8_SB(1, 0), b3, voffB);
            PG8_BAR; PG8_WAIT_L(0); PG8_MMA(0, 1, At, B1); PG8_BAR;
            PG8_LDA(At, 1, 1); PG8_STAGE(PG8_SA(1, 0), a3, voffA);
            PG8_BAR; PG8_WAIT_L(0); PG8_MMA(1, 0, At, B0); PG8_BAR; PG8_SCHED;
            PG8_STAGE(PG8_SB(1, 1), b3 + hstep, voffB);
            PG8_WAIT_V(6); PG8_BAR; PG8_MMA(1, 1, At, B1); PG8_BAR;
            }
        }
        if constexpr (ALIGN_EPI) { if (wr == 0) PG8_BAR; }
        if constexpr (!Epi::AFTER_DRAIN) { E(acc, cur, wr, wc, fr, fq); S.done(cur); }
        if (!has_next) break;
#pragma unroll
        for (int a = 0; a < 2; ++a)
#pragma unroll
            for (int b = 0; b < 2; ++b)
#pragma unroll
                for (int m = 0; m < 4; ++m)
#pragma unroll
                    for (int n = 0; n < 2; ++n) acc[a][b][m][n] = (f32x4){0.f, 0.f, 0.f, 0.f};
        cur = nxt; cA = nA; cB = nB; ++ui;
        if constexpr (ALIGN_EPI) { if (wr == 1) PG8_BAR; }
    }
    PG8_WAIT_V(0);
    if constexpr (!ALIGN_EPI) { if (wr == 0) PG8_BAR; }
    PG8_BAR;
    if constexpr (Epi::AFTER_DRAIN) { E.fused(acc, cur, wr, wc, fr, fq, lds, wid, lane); S.done(cur); }
#undef PG8_SA
#undef PG8_SB
#undef PG8_STAGE
#undef PG8_LDA
#undef PG8_LDB
#undef PG8_MMA
#undef PG8_WAIT_V
#undef PG8_WAIT_L
#undef PG8_BAR
#undef PG8_SCHED
}
}
namespace attn_body {
using bf16=__hip_bfloat16;
using bf16x8=__attribute__((ext_vector_type(8)))short;
using s16x4=__attribute__((ext_vector_type(4)))short;
using f32x16=__attribute__((ext_vector_type(16)))float;
using u32x4=__attribute__((ext_vector_type(4)))unsigned;
constexpr int SEQ=16384,D=64,PP=64;
constexpr int NW=8,QBLK=32,QB=QBLK*NW,KVBLK=64,NQB=SEQ/QB,NT=SEQ/KVBLK;
constexpr int OPITCH=1024;
__device__ __forceinline__ int crow(int r,int hi){return (r&3)+8*(r>>2)+4*hi;}
#define SBAR() __builtin_amdgcn_sched_barrier(0)
constexpr int NSLOT=3, SLOTB=8192;
constexpr int LDS_K=0, LDS_V=NSLOT*SLOTB, LDS_WS=LDS_V+NSLOT*2*SLOTB, LDS_OST=LDS_WS+NW*64*4, LDS_BYTES=LDS_OST+NW*8192;
__device__ __forceinline__ void glds16(const void*gsrc,unsigned lds_dst){unsigned keep;
  asm volatile("s_mov_b32 %0, m0\n\ts_mov_b32 m0, %2\n\ts_nop 0\n\tglobal_load_lds_dwordx4 %1, off\n\ts_mov_b32 m0, %0":"=&s"(keep):"v"(gsrc),"s"(lds_dst):"memory");}
__device__ __forceinline__ void glds16b(__amdgpu_buffer_rsrc_t srd,unsigned voff,unsigned soff,unsigned lds_dst){unsigned keep;
  asm volatile("s_nop 4\n\ts_mov_b32 %0, m0\n\ts_mov_b32 m0, %4\n\ts_nop 0\n\tbuffer_load_dwordx4 %1, %2, %3 offen lds\n\ts_mov_b32 m0, %0":"=&s"(keep):"v"(voff),"s"(srd),"s"(soff),"s"(lds_dst):"memory");}
__device__ __forceinline__ float max3f(float a,float b,float c){float r;asm("v_max3_f32 %0, %1, %2, %3":"=v"(r):"v"(a),"v"(b),"v"(c));return r;}
__device__ __forceinline__ float max2f(float a,float b){float r;asm("v_max_f32_e32 %0, %1, %2":"=v"(r):"v"(a),"v"(b));return r;}
__device__ __forceinline__ float fadd_s(float a,float b){float r;asm("v_add_f32_e32 %0, %1, %2":"=v"(r):"v"(a),"v"(b));return r;}
__device__ __forceinline__ float fsub_s(float a,float b){float r;asm("v_sub_f32_e32 %0, %1, %2":"=v"(r):"v"(a),"v"(b));return r;}
typedef float f32x2_t __attribute__((ext_vector_type(2))); typedef __bf16 bf16x2_t __attribute__((ext_vector_type(2)));
__device__ __forceinline__ unsigned cvtpk_s(float lo,float hi){f32x2_t v={lo,hi};bf16x2_t b=__builtin_convertvector(v,bf16x2_t);return __builtin_bit_cast(unsigned,b);}
#define WAIT_BAR(N) asm volatile("s_waitcnt vmcnt(" #N ") lgkmcnt(0)\n\ts_barrier":::"memory")

__device__ __forceinline__ void zero16(f32x16&x){
  #pragma unroll
  for(int r=0;r<16;++r){float z;asm volatile("v_mov_b32 %0, 0":"=v"(z));x[r]=z;}
}
typedef int v8i_a __attribute__((ext_vector_type(8)));
#define MFQ(a,b,c) __builtin_amdgcn_mfma_scale_f32_32x32x64_f8f6f4(a,b,c,0,0,0,0x7F7F7F7F,0,0x7C7C7C7C)
__device__ __forceinline__ v8i_a kfrag8(__attribute__((address_space(3))) const char* kp,int kt){
  const u32x4 a=*(const __attribute__((address_space(3))) u32x4*)(kp+kt*512), b=*(const __attribute__((address_space(3))) u32x4*)(kp+1024+kt*512);
  return (v8i_a){(int)a.x,(int)a.y,(int)a.z,(int)a.w,(int)b.x,(int)b.y,(int)b.z,(int)b.w};
}
__device__ __forceinline__ void qkt(f32x16&p0,f32x16&p1,__attribute__((address_space(3))) const char*kp,const v8i_a q8,const f32x16&negm){
  const v8i_a k0=kfrag8(kp,0),k1=kfrag8(kp,1);
  p0=MFQ(k0,q8,negm);p1=MFQ(k1,q8,negm);
}
typedef __attribute__((address_space(3))) const char* lds_cptr;
typedef short v4i16_t __attribute__((ext_vector_type(4)));
__device__ __forceinline__ void kload8(bf16x8*kf,lds_cptr kp){
  kf[0]=*(const __attribute__((address_space(3))) bf16x8*)(kp);      kf[1]=*(const __attribute__((address_space(3))) bf16x8*)(kp+512);
  kf[2]=*(const __attribute__((address_space(3))) bf16x8*)(kp+2048); kf[3]=*(const __attribute__((address_space(3))) bf16x8*)(kp+2560);
  kf[4]=*(const __attribute__((address_space(3))) bf16x8*)(kp+4096); kf[5]=*(const __attribute__((address_space(3))) bf16x8*)(kp+4608);
  kf[6]=*(const __attribute__((address_space(3))) bf16x8*)(kp+6144); kf[7]=*(const __attribute__((address_space(3))) bf16x8*)(kp+6656);
}
__device__ __forceinline__ void kload2(bf16x8*kf,lds_cptr kp,int j){ kf[2*j]=*(const __attribute__((address_space(3))) bf16x8*)(kp+j*2048); kf[2*j+1]=*(const __attribute__((address_space(3))) bf16x8*)(kp+j*2048+512); }
__device__ __forceinline__ s16x4 vtr(lds_cptr p){ return __builtin_bit_cast(s16x4,__builtin_amdgcn_ds_read_tr16_b64_v4i16((__attribute__((address_space(3))) v4i16_t*)p)); }
__device__ __forceinline__ float rowmax(const f32x16&p0,const f32x16&p1){
  float a=max3f(p0[0],p0[1],p1[0]),b=max3f(p0[2],p0[3],p1[1]);a=max3f(a,p1[2],p1[3]);
  #pragma unroll
  for(int r=4;r<16;r+=4){a=max3f(a,p0[r],p0[r+1]);b=max3f(b,p0[r+2],p0[r+3]);a=max3f(a,p1[r],p1[r+1]);b=max3f(b,p1[r+2],p1[r+3]);}
  const float m=max2f(a,b);
  auto rr=__builtin_amdgcn_permlane32_swap(__float_as_uint(m),__float_as_uint(m),false,false);
  return max2f(__uint_as_float(rr[0]),__uint_as_float(rr[1]));
}
template<int NB> __device__ __forceinline__ void pv(f32x16*o,int vb,bf16x8 pa0,bf16x8 pa1,bf16x8 pa2,bf16x8 pa3){
  #pragma unroll
  for(int d0=0;d0<NB;++d0){s16x4 lo[4],hi[4];
    #pragma unroll
    for(int ks=0;ks<4;++ks){
      asm volatile("ds_read_b64_tr_b16 %0,%1 offset:%c2":"=&v"(lo[ks]):"v"(vb),"i"(d0*4096+ks*1024):"memory");
      asm volatile("ds_read_b64_tr_b16 %0,%1 offset:%c2":"=&v"(hi[ks]):"v"(vb),"i"(d0*4096+ks*1024+512):"memory");}
    asm volatile("s_waitcnt lgkmcnt(0)":::"memory");SBAR();
    #define PK(k) (bf16x8){lo[k][0],lo[k][1],lo[k][2],lo[k][3],hi[k][0],hi[k][1],hi[k][2],hi[k][3]}
    o[d0]=__builtin_amdgcn_mfma_f32_32x32x16_bf16(pa0,PK(0),o[d0],0,0,0);
    o[d0]=__builtin_amdgcn_mfma_f32_32x32x16_bf16(pa1,PK(1),o[d0],0,0,0);
    o[d0]=__builtin_amdgcn_mfma_f32_32x32x16_bf16(pa2,PK(2),o[d0],0,0,0);
    o[d0]=__builtin_amdgcn_mfma_f32_32x32x16_bf16(pa3,PK(3),o[d0],0,0,0);
    #undef PK
  }
}
#ifndef ATTN_STORE16
#define ATTN_STORE16(p,v) (*(u32x4*)(p)=(v))
#endif
#define PKW(P,B) cvtpk_s(P[B],P[B+1])
#define PAF(k) __builtin_bit_cast(bf16x8,pw##k)
#define PIN(x) asm volatile("":"+v"(x))
#define MX3(a,b,c) __builtin_fmaxf(__builtin_fmaxf((a),(b)),(c))
#define EX(v) __builtin_amdgcn_exp2f(v)
#define MF32(a,b,c) __builtin_amdgcn_mfma_f32_32x32x16_bf16(a,b,c,0,0,0)
#define GAPA(MF,A0,A1,A2,A3,W0,W1,PW) do{ MF; sacc+=A0; sacc+=A1; sacc+=A2; sacc+=A3; PIN(sacc); W0; W1; PIN(PW); SBAR(); }while(0)
#define ROT() do{sl_prev=sl_cur;sl_cur=sl_next;sl_next=(sl_next==(NSLOT-1)*SLOTB)?0:sl_next+SLOTB;}while(0)
#define DECIDE(C0,C1) do{ float a=MX3(C0[0],C0[1],C1[0]),b=MX3(C0[2],C0[3],C1[1]); a=MX3(a,C1[2],C1[3]); \
      _Pragma("unroll") for(int r=4;r<16;r+=4){a=MX3(a,C0[r],C0[r+1]);b=MX3(b,C0[r+2],C0[r+3]);a=MX3(a,C1[r],C1[r+1]);b=MX3(b,C1[r+2],C1[r+3]);} \
      float rm=__builtin_fmaxf(a,b); { auto rr=__builtin_amdgcn_permlane32_swap(__float_as_uint(rm),__float_as_uint(rm),false,false); rm=__builtin_fmaxf(__uint_as_float(rr[0]),__uint_as_float(rr[1])); } \
      resc=false; \
      if(__builtin_expect(__any(rm>(float)THRL),0)){ const float dl=__builtin_fmaxf(rm,0.f); mhat+=dl; \
        _Pragma("unroll") for(int r=0;r<16;++r){C0[r]-=dl;C1[r]-=dl;} \
        _Pragma("unroll") for(int r=0;r<16;++r)negm[r]=-mhat; asm volatile("":"+v"(negm)); \
        const float f=__builtin_amdgcn_exp2f(-dl); l_reg*=f; if(hi==0)wsf[r32]=f; resc=true; } }while(0)
#define START(P0,P1) do{ const float rm=rowmax(P0,P1); resc=false; \
    { const float dl=rm; mhat=fadd_s(mhat,dl); \
      _Pragma("unroll") for(int r=0;r<16;++r){P0[r]=fsub_s(P0[r],dl);P1[r]=fsub_s(P1[r],dl);} \
      _Pragma("unroll") for(int r=0;r<16;++r)negm[r]=-mhat; asm volatile("":"+v"(negm)); } \
    _Pragma("unroll") for(int r=0;r<16;++r)P0[r]=__builtin_amdgcn_exp2f(P0[r]); }while(0)
#define KRD(G,j) do{ if(G){ if((j)<2){ kf[(j)&1]=kfrag8(kp0+sl_next,(j)&1); } SBAR(); } }while(0)

template<int THRL> __device__ __forceinline__ void attn_unit_a(int qb,const bf16*Qp,__amdgpu_buffer_rsrc_t srd,unsigned kbyte,unsigned vbyte,bf16*Ob,char*shm,float mub,bool SB){
  const int tid=threadIdx.x,lane=tid&63,r32=lane&31,hi=lane>>5; const int wid=__builtin_amdgcn_readfirstlane(tid>>6);
  const int q0=qb*QB;
  const bf16*Qw=Qp+(long)(q0+wid*QBLK)*PP;
  const unsigned lds0=(unsigned)(uintptr_t)shm;
  float*wsf=(float*)(shm+LDS_WS)+wid*64;
  const unsigned kvoff=(unsigned)(lane*64+(wid&3)*16), vvoff=(unsigned)((16*(wid&3)+(lane>>2))*PP+(wid>>2)*32+(lane&3)*8)*2u;
  const unsigned kdst=lds0+LDS_K+(wid&3)*1024, vdst=lds0+LDS_V+wid*1024;
  #define DMA_K(t,slot) glds16b(srd,kvoff,(unsigned)__builtin_amdgcn_readfirstlane(kbyte+(unsigned)(t)*(KVBLK*PP)),(unsigned)__builtin_amdgcn_readfirstlane(kdst+(slot)))
  #define DMA_V(t,slot) glds16b(srd,vvoff,(unsigned)__builtin_amdgcn_readfirstlane(vbyte+(unsigned)(t)*(KVBLK*PP*2)),(unsigned)__builtin_amdgcn_readfirstlane(vdst+2*(slot)))
  const int vb0=(int)(lds0+LDS_V)+((lane>>4)&1)*32+(lane&3)*8+(4*hi+((lane&15)>>2))*64;
  v8i_a kf[2];
  const lds_cptr shm3=(lds_cptr)shm; const lds_cptr kp0=shm3+LDS_K+hi*2048+r32*16; const lds_cptr vp0=shm3+LDS_V+((lane>>4)&1)*32+(lane&3)*8+(4*hi+((lane&15)>>2))*64;
  DMA_K(0,0);DMA_V(0,0);DMA_K(1,SLOTB);
  v8i_a q8; { const u32x4*qp_=(const u32x4*)((const char*)Qp+(long)(q0+wid*QBLK+r32)*64+32*hi); const u32x4 qa=qp_[0],qb_=qp_[1]; q8=(v8i_a){(int)qa.x,(int)qa.y,(int)qa.z,(int)qa.w,(int)qb_.x,(int)qb_.y,(int)qb_.z,(int)qb_.w}; }
  float mhat=0.f,l_reg=0.f;f32x16 o[2];zero16(o[0]);zero16(o[1]);f32x16 negm;zero16(negm);
  if(SB){ _Pragma("unroll") for(int r=0;r<16;++r)negm[r]=-mub; asm volatile("":"+v"(negm)); }
  bool resc=false;
  #define RESC() do{ if(!SB && resc){ asm volatile("s_waitcnt lgkmcnt(0)":::"memory"); \
      _Pragma("unroll") for(int d_=0;d_<2;++d_) _Pragma("unroll") for(int r=0;r<16;++r)o[d_][r]*=wsf[crow(r,hi)]; } }while(0)
  f32x16 pA0,pA1,pB0,pB1;
  int sl_prev=0,sl_cur=0,sl_next=SLOTB;
  DMA_K(2,2*SLOTB);
  WAIT_BAR(3);
  qkt(pA0,pA1,kp0,q8,negm);asm volatile("s_nop 15\n\ts_nop 7":"+v"(pA0),"+v"(pA1));
  if(SB){ _Pragma("unroll") for(int r=0;r<16;++r)pA0[r]=__builtin_amdgcn_exp2f(pA0[r]); } else { START(pA0,pA1); }
  _Pragma("unroll") for(int r=0;r<16;++r)pA1[r]=__builtin_amdgcn_exp2f(pA1[r]);
  WAIT_BAR(0);
  DMA_K(3,0);DMA_V(1,SLOTB);
  ROT();
  kf[0]=kfrag8(kp0+sl_cur,0);kf[1]=kfrag8(kp0+sl_cur,1);
  WAIT_BAR(2);
  s16x4 vlo[8],vhi[8]; u32x4 pw0,pw1,pw2,pw3;
  #define VFR(i) (bf16x8){vlo[i][0],vlo[i][1],vlo[i][2],vlo[i][3],vhi[i][0],vhi[i][1],vhi[i][2],vhi[i][3]}
  #define GAPB(MF,X,B) do{ MF; X[B]=EX(X[B]); X[B+1]=EX(X[B+1]); X[B+2]=EX(X[B+2]); X[B+3]=EX(X[B+3]); PIN(X); SBAR(); }while(0)
  #define VRD(i) do{ vlo[i]=vtr(vp_+(((i)>>2)*4096+((i)&3)*1024)); vhi[i]=vtr(vp_+(((i)>>2)*4096+((i)&3)*1024+512)); }while(0)
  #define STEP(C0,C1,P0,P1,t,GK,GV,GL) do{ SBAR(); \
    const lds_cptr vp_=vp0+2*sl_prev; \
    VRD(0); SBAR(); float sacc=(P0[0]+P0[1]); \
    GAPA(C0=MFQ(kf[0],q8,negm),      P0[2],P0[3],P0[4],P0[5],     pw0[0]=PKW(P0,0), pw0[1]=PKW(P0,2), pw0); \
    VRD(4); SBAR(); GAPA(C1=MFQ(kf[1],q8,negm),      P0[6],P0[7],P0[8],P0[9],     pw0[2]=PKW(P0,4), pw0[3]=PKW(P0,6), pw0); \
    VRD(1); SBAR(); GAPA((void)0,                     P0[10],P0[11],P0[12],P0[13], pw1[0]=PKW(P0,8), pw1[1]=PKW(P0,10), pw1); \
    VRD(5); SBAR(); GAPA((void)0,                     P0[14],P0[15],P1[0],P1[1],   pw1[2]=PKW(P0,12),pw1[3]=PKW(P0,14), pw1); \
    VRD(2); SBAR(); GAPA((void)0,                     P1[2],P1[3],P1[4],P1[5],     pw2[0]=PKW(P1,0), pw2[1]=PKW(P1,2), pw2); \
    VRD(6); SBAR(); GAPA((void)0,                     P1[6],P1[7],P1[8],P1[9],     pw2[2]=PKW(P1,4), pw2[3]=PKW(P1,6), pw2); \
    VRD(3); SBAR(); GAPA((void)0,                     P1[10],P1[11],P1[12],P1[13], pw3[0]=PKW(P1,8), pw3[1]=PKW(P1,10), pw3); \
    VRD(7); SBAR(); GAPA((void)0,                     P1[14],P1[15],0.f,0.f,       pw3[2]=PKW(P1,12),pw3[3]=PKW(P1,14), pw3); \
    l_reg+=sacc; \
    if(GK){DMA_K((t)+3,sl_cur);} if(GV){DMA_V((t)+1,sl_next);} \
    if(!SB){ DECIDE(C0,C1); } \
    SBAR(); __builtin_amdgcn_s_setprio(1); \
    GAPB(o[0]=MF32(PAF(0),VFR(0),o[0]), C0,0); \
    GAPB(o[1]=MF32(PAF(0),VFR(4),o[1]), C0,4); \
    KRD(GL,0); GAPB(o[0]=MF32(PAF(1),VFR(1),o[0]), C0,8); \
    KRD(GL,1); GAPB(o[1]=MF32(PAF(1),VFR(5),o[1]), C0,12); \
    KRD(GL,2); GAPB(o[0]=MF32(PAF(2),VFR(2),o[0]), C1,0); \
    KRD(GL,3); GAPB(o[1]=MF32(PAF(2),VFR(6),o[1]), C1,4); \
    GAPB(o[0]=MF32(PAF(3),VFR(3),o[0]), C1,8); \
    GAPB(o[1]=MF32(PAF(3),VFR(7),o[1]), C1,12); __builtin_amdgcn_s_setprio(0); \
    }while(0)
  int t=1;
  asm volatile(".p2align 8\n\t.fill 12, 4, 0xbf800000");
  for(;t+5<NT;t+=2){
    STEP(pB0,pB1,pA0,pA1,t,true,true,true);     WAIT_BAR(2); RESC(); ROT();
    STEP(pA0,pA1,pB0,pB1,t+1,true,true,true);   WAIT_BAR(2); RESC(); ROT();
  }
  #define ENDW(tt) do{ if((tt)+3<NT){WAIT_BAR(2);} else if((tt)+2<NT){WAIT_BAR(1);} else {WAIT_BAR(0);} }while(0)
  for(;t+1<NT;t+=2){
    STEP(pB0,pB1,pA0,pA1,t,(t+3<NT),(t+1<NT),(t+1<NT));       ENDW(t);   RESC(); ROT();
    STEP(pA0,pA1,pB0,pB1,t+1,(t+4<NT),(t+2<NT),(t+2<NT));     ENDW(t+1); RESC(); ROT();
  }
  STEP(pB0,pB1,pA0,pA1,NT-1,false,false,false); RESC();
  { float sacc=pB0[0]+pB0[1]; _Pragma("unroll") for(int r=2;r<16;++r)sacc+=pB0[r]; _Pragma("unroll") for(int r=0;r<16;++r)sacc+=pB1[r]; l_reg+=sacc;
    pw0=(u32x4){PKW(pB0,0),PKW(pB0,2),PKW(pB0,4),PKW(pB0,6)};pw1=(u32x4){PKW(pB0,8),PKW(pB0,10),PKW(pB0,12),PKW(pB0,14)};pw2=(u32x4){PKW(pB1,0),PKW(pB1,2),PKW(pB1,4),PKW(pB1,6)};pw3=(u32x4){PKW(pB1,8),PKW(pB1,10),PKW(pB1,12),PKW(pB1,14)};
    SBAR(); pv<2>(o,vb0+2*sl_cur,PAF(0),PAF(1),PAF(2),PAF(3)); }
  #undef VFR
  #undef GAPB
  #undef VRD
  #undef STEP
  #undef ENDW
  {auto rr=__builtin_amdgcn_permlane32_swap(__float_as_uint(l_reg),__float_as_uint(l_reg),false,false);l_reg=__uint_as_float(rr[0])+__uint_as_float(rr[1]);}
  if(hi==0)wsf[32+r32]=l_reg;asm volatile("s_waitcnt lgkmcnt(0)":::"memory");
  float rli[16];
  #pragma unroll
  for(int r=0;r<16;++r)rli[r]=__builtin_amdgcn_rcpf(wsf[32+crow(r,hi)]);
  bf16*Ow=Ob+(long)(q0+wid*QBLK)*OPITCH;
  { bf16*stg=(bf16*)(shm+LDS_OST)+wid*4096;
    #pragma unroll
    for(int r=0;r<16;++r){const int orow=crow(r,hi);
      #pragma unroll
      for(int d0=0;d0<2;++d0)stg[orow*64+d0*32+r32]=__float2bfloat16(o[d0][r]*rli[r]);}
    asm volatile("s_waitcnt lgkmcnt(0)":::"memory");
    #pragma unroll
    for(int i=0;i<4;++i){const int row=i*8+(lane>>3),ch=lane&7; const u32x4 v=*(const u32x4*)(stg+row*64+ch*8); ATTN_STORE16(Ow+(long)row*OPITCH+ch*8,v);} }
  asm volatile("s_waitcnt lgkmcnt(0)\n\ts_barrier":::"memory");
  #undef DMA_K
  #undef DMA_V
  #undef RESC
}
__device__ __forceinline__ void attn_unit_a_sb(int qb,const bf16*Qp,__amdgpu_buffer_rsrc_t srd,unsigned kbyte,unsigned vbyte,bf16*Ob,char*shm){
  constexpr bool SB=true;
  const int tid=threadIdx.x,lane=tid&63,r32=lane&31,hi=lane>>5; const int wid=__builtin_amdgcn_readfirstlane(tid>>6);
  const int q0=qb*QB;
  const bf16*Qw=Qp+(long)(q0+wid*QBLK)*PP;
  const unsigned lds0=(unsigned)(uintptr_t)shm;
  float*wsf=(float*)(shm+LDS_WS)+wid*64;
  const unsigned kvoff=(unsigned)(lane*64+(wid&3)*16), vvoff=(unsigned)((16*(wid&3)+(lane>>2))*PP+(wid>>2)*32+(lane&3)*8)*2u;
  const unsigned kdst=lds0+LDS_K+(wid&3)*1024, vdst=lds0+LDS_V+wid*1024;
  #define DMA_K(t,slot) glds16b(srd,kvoff,(unsigned)__builtin_amdgcn_readfirstlane(kbyte+(unsigned)(t)*(KVBLK*PP)),(unsigned)__builtin_amdgcn_readfirstlane(kdst+(slot)))
  #define DMA_V(t,slot) glds16b(srd,vvoff,(unsigned)__builtin_amdgcn_readfirstlane(vbyte+(unsigned)(t)*(KVBLK*PP*2)),(unsigned)__builtin_amdgcn_readfirstlane(vdst+2*(slot)))
  const int vb0=(int)(lds0+LDS_V)+((lane>>4)&1)*32+(lane&3)*8+(4*hi+((lane&15)>>2))*64;
  v8i_a kf[2];
  const lds_cptr shm3=(lds_cptr)shm; const lds_cptr kp0=shm3+LDS_K+hi*2048+r32*16; const lds_cptr vp0=shm3+LDS_V+((lane>>4)&1)*32+(lane&3)*8+(4*hi+((lane&15)>>2))*64;
  DMA_K(0,0);DMA_V(0,0);DMA_K(1,SLOTB);
  v8i_a q8; { const u32x4*qp_=(const u32x4*)((const char*)Qp+(long)(q0+wid*QBLK+r32)*64+32*hi); const u32x4 qa=qp_[0],qb_=qp_[1]; q8=(v8i_a){(int)qa.x,(int)qa.y,(int)qa.z,(int)qa.w,(int)qb_.x,(int)qb_.y,(int)qb_.z,(int)qb_.w}; }
  f32x16 o[2];zero16(o[0]);zero16(o[1]);f32x16 lacc;zero16(lacc);
  const f32x16 negm={0.f,0.f,0.f,0.f,0.f,0.f,0.f,0.f,0.f,0.f,0.f,0.f,0.f,0.f,0.f,0.f};
  const bf16x8 ONES={(short)0x3F80,(short)0x3F80,(short)0x3F80,(short)0x3F80,(short)0x3F80,(short)0x3F80,(short)0x3F80,(short)0x3F80};
  bool resc=false;
  #define RESC() do{ if(!SB && resc){ asm volatile("s_waitcnt lgkmcnt(0)":::"memory"); \
      _Pragma("unroll") for(int d_=0;d_<2;++d_) _Pragma("unroll") for(int r=0;r<16;++r)o[d_][r]*=wsf[crow(r,hi)]; } }while(0)
  f32x16 pA0,pA1,pB0,pB1;
  int sl_prev=0,sl_cur=0,sl_next=SLOTB;
  DMA_K(2,2*SLOTB);
  WAIT_BAR(3);
  qkt(pA0,pA1,kp0,q8,negm);asm volatile("s_nop 15\n\ts_nop 7":"+v"(pA0),"+v"(pA1));
  _Pragma("unroll") for(int r=0;r<16;++r)pA0[r]=__builtin_amdgcn_exp2f(pA0[r]);
  _Pragma("unroll") for(int r=0;r<16;++r)pA1[r]=__builtin_amdgcn_exp2f(pA1[r]);
  WAIT_BAR(0);
  DMA_K(3,0);DMA_V(1,SLOTB);
  ROT();
  kf[0]=kfrag8(kp0+sl_cur,0);kf[1]=kfrag8(kp0+sl_cur,1);
  WAIT_BAR(2);
  s16x4 vlo[8],vhi[8]; u32x4 pw0,pw1,pw2,pw3;
  #define VFR(i) (bf16x8){vlo[i][0],vlo[i][1],vlo[i][2],vlo[i][3],vhi[i][0],vhi[i][1],vhi[i][2],vhi[i][3]}
  #define GAP3(MF,X,B) do{ MF; X[B]=EX(X[B]); X[B+1]=EX(X[B+1]); X[B+2]=EX(X[B+2]); PIN(X); SBAR(); }while(0)
  #define GAP2(MF,X,B) do{ MF; X[B]=EX(X[B]); X[B+1]=EX(X[B+1]); PIN(X); SBAR(); }while(0)
  #define GAPS(MF,W0,W1,PW) do{ MF; W0; W1; PIN(PW); SBAR(); }while(0)
  #define VRD(i) do{ vlo[i]=vtr(vp_+(((i)>>2)*4096+((i)&3)*1024)); vhi[i]=vtr(vp_+(((i)>>2)*4096+((i)&3)*1024+512)); }while(0)
  #define STEP(C0,C1,P0,P1,t,GK,GV,GL) do{ SBAR(); \
    const lds_cptr vp_=vp0+2*sl_prev; \
    VRD(0); SBAR(); \
    GAPS(C0=MFQ(kf[0],q8,negm), pw0[0]=PKW(P0,0), pw0[1]=PKW(P0,2), pw0); \
    VRD(4); SBAR(); GAPS(C1=MFQ(kf[1],q8,negm), pw0[2]=PKW(P0,4), pw0[3]=PKW(P0,6), pw0); \
    VRD(1); SBAR(); GAPS((void)0, pw1[0]=PKW(P0,8), pw1[1]=PKW(P0,10), pw1); \
    VRD(5); SBAR(); GAPS((void)0, pw1[2]=PKW(P0,12), pw1[3]=PKW(P0,14), pw1); \
    VRD(2); SBAR(); GAPS((void)0, pw2[0]=PKW(P1,0), pw2[1]=PKW(P1,2), pw2); \
    VRD(6); SBAR(); GAPS((void)0, pw2[2]=PKW(P1,4), pw2[3]=PKW(P1,6), pw2); \
    VRD(3); SBAR(); GAPS((void)0, pw3[0]=PKW(P1,8), pw3[1]=PKW(P1,10), pw3); \
    VRD(7); SBAR(); GAPS((void)0, pw3[2]=PKW(P1,12), pw3[3]=PKW(P1,14), pw3); \
    if(GK){DMA_K((t)+3,sl_cur);} if(GV){DMA_V((t)+1,sl_next);} \
    SBAR(); __builtin_amdgcn_s_setprio(1); \
    GAP3(o[0]=MF32(PAF(0),VFR(0),o[0]), C0,0); \
    GAP3(o[1]=MF32(PAF(0),VFR(4),o[1]), C0,3); \
    GAP2(lacc=MF32(PAF(0),ONES,lacc),   C0,6); \
    KRD(GL,0); GAP3(o[0]=MF32(PAF(1),VFR(1),o[0]), C0,8); \
    KRD(GL,1); GAP3(o[1]=MF32(PAF(1),VFR(5),o[1]), C0,11); \
    GAP2(lacc=MF32(PAF(1),ONES,lacc),   C0,14); \
    GAP3(o[0]=MF32(PAF(2),VFR(2),o[0]), C1,0); \
    GAP3(o[1]=MF32(PAF(2),VFR(6),o[1]), C1,3); \
    GAP2(lacc=MF32(PAF(2),ONES,lacc),   C1,6); \
    GAP3(o[0]=MF32(PAF(3),VFR(3),o[0]), C1,8); \
    GAP3(o[1]=MF32(PAF(3),VFR(7),o[1]), C1,11); \
    GAP2(lacc=MF32(PAF(3),ONES,lacc),   C1,14); __builtin_amdgcn_s_setprio(0); \
    }while(0)
  int t=1;
  asm volatile(".p2align 8\n\t.fill 12, 4, 0xbf800000");
  for(;t+5<NT;t+=2){
    STEP(pB0,pB1,pA0,pA1,t,true,true,true);     WAIT_BAR(2); RESC(); ROT();
    STEP(pA0,pA1,pB0,pB1,t+1,true,true,true);   WAIT_BAR(2); RESC(); ROT();
  }
  #define ENDW(tt) do{ if((tt)+3<NT){WAIT_BAR(2);} else if((tt)+2<NT){WAIT_BAR(1);} else {WAIT_BAR(0);} }while(0)
  for(;t+1<NT;t+=2){
    STEP(pB0,pB1,pA0,pA1,t,(t+3<NT),(t+1<NT),(t+1<NT));       ENDW(t);   RESC(); ROT();
    STEP(pA0,pA1,pB0,pB1,t+1,(t+4<NT),(t+2<NT),(t+2<NT));     ENDW(t+1); RESC(); ROT();
  }
  STEP(pB0,pB1,pA0,pA1,NT-1,false,false,false); RESC();
  {
    pw0=(u32x4){PKW(pB0,0),PKW(pB0,2),PKW(pB0,4),PKW(pB0,6)};pw1=(u32x4){PKW(pB0,8),PKW(pB0,10),PKW(pB0,12),PKW(pB0,14)};pw2=(u32x4){PKW(pB1,0),PKW(pB1,2),PKW(pB1,4),PKW(pB1,6)};pw3=(u32x4){PKW(pB1,8),PKW(pB1,10),PKW(pB1,12),PKW(pB1,14)};
    SBAR(); pv<2>(o,vb0+2*sl_cur,PAF(0),PAF(1),PAF(2),PAF(3));
    lacc=MF32(PAF(0),ONES,lacc); lacc=MF32(PAF(1),ONES,lacc); lacc=MF32(PAF(2),ONES,lacc); lacc=MF32(PAF(3),ONES,lacc); }
  #undef VFR
  #undef GAP3
  #undef GAP2
  #undef GAPS
  #undef VRD
  #undef STEP
  #undef ENDW
  float rli[16];
  #pragma unroll
  for(int r=0;r<16;++r)rli[r]=__builtin_amdgcn_rcpf(lacc[r]);
  bf16*Ow=Ob+(long)(q0+wid*QBLK)*OPITCH;
  { bf16*stg=(bf16*)(shm+LDS_OST)+wid*4096;
    #pragma unroll
    for(int r=0;r<16;++r){const int orow=crow(r,hi);
      #pragma unroll
      for(int d0=0;d0<2;++d0)stg[orow*64+d0*32+r32]=__float2bfloat16(o[d0][r]*rli[r]);}
    asm volatile("s_waitcnt lgkmcnt(0)":::"memory");
    #pragma unroll
    for(int i=0;i<4;++i){const int row=i*8+(lane>>3),ch=lane&7; const u32x4 v=*(const u32x4*)(stg+row*64+ch*8); ATTN_STORE16(Ow+(long)row*OPITCH+ch*8,v);} }
  asm volatile("s_waitcnt lgkmcnt(0)\n\ts_barrier":::"memory");
  #undef DMA_K
  #undef DMA_V
  #undef RESC
}
template<int THRL> __device__ __forceinline__ void attn_unit_b(int qb,int comp,const bf16*Qp,__amdgpu_buffer_rsrc_t srd,unsigned kbyte,unsigned vbyte,float*sc,float lam,const float*subg,bf16*Ob,char*shm,float mub,bool SB){
  const int tid=threadIdx.x,lane=tid&63,r32=lane&31,hi=lane>>5; const int wid=__builtin_amdgcn_readfirstlane(tid>>6);
  const int q0=qb*QB;
  const bf16*Qw=Qp+(long)(q0+wid*QBLK)*PP;
  const unsigned lds0=(unsigned)(uintptr_t)shm;
  float*wsf=(float*)(shm+LDS_WS)+wid*64;
  const unsigned kvoff=(unsigned)(lane*64+(wid&3)*16);
  const unsigned vvoff=(unsigned)((16*(wid&3)+(lane>>2))*PP+(wid>>2)*32+(lane&3)*8)*2u;
  const unsigned kdst=lds0+LDS_K+(wid&3)*1024, vdst=lds0+LDS_V+wid*1024;
  #define DMA_K(t,slot) glds16b(srd,kvoff,(unsigned)__builtin_amdgcn_readfirstlane(kbyte+(unsigned)(t)*(KVBLK*PP)),(unsigned)__builtin_amdgcn_readfirstlane(kdst+(slot)))
  #define DMA_V(t,slot) do{ const unsigned so_=(unsigned)__builtin_amdgcn_readfirstlane(vbyte+(unsigned)(t)*(KVBLK*PP*2)); glds16b(srd,vvoff,so_,(unsigned)__builtin_amdgcn_readfirstlane(vdst+2*(slot))); glds16b(srd,vvoff,so_+(unsigned)(SEQ*PP*2),(unsigned)__builtin_amdgcn_readfirstlane(vdst+2*(slot)+8192)); }while(0)
  const int vb0=(int)(lds0+LDS_V)+((lane>>4)&1)*32+(lane&3)*8+(4*hi+((lane&15)>>2))*64;
  v8i_a kf[2];
  const lds_cptr shm3=(lds_cptr)shm; const lds_cptr kp0=shm3+LDS_K+hi*2048+r32*16; const lds_cptr vp0=shm3+LDS_V+((lane>>4)&1)*32+(lane&3)*8+(4*hi+((lane&15)>>2))*64;
  DMA_K(0,0);DMA_V(0,0);DMA_K(1,SLOTB);
  v8i_a q8; { const u32x4*qp_=(const u32x4*)((const char*)Qp+(long)(q0+wid*QBLK+r32)*64+32*hi); const u32x4 qa=qp_[0],qb_=qp_[1]; q8=(v8i_a){(int)qa.x,(int)qa.y,(int)qa.z,(int)qa.w,(int)qb_.x,(int)qb_.y,(int)qb_.z,(int)qb_.w}; }
  float mhat=0.f,l_reg=0.f;f32x16 o[4];zero16(o[0]);zero16(o[1]);zero16(o[2]);zero16(o[3]);f32x16 negm;zero16(negm);
  if(SB){ _Pragma("unroll") for(int r=0;r<16;++r)negm[r]=-mub; asm volatile("":"+v"(negm)); }
  bool resc=false;
  #define RESC() do{ if(!SB && resc){ asm volatile("s_waitcnt lgkmcnt(0)":::"memory"); \
      _Pragma("unroll") for(int d_=0;d_<4;++d_) _Pragma("unroll") for(int r=0;r<16;++r)o[d_][r]*=wsf[crow(r,hi)]; } }while(0)
  f32x16 pA0,pA1,pB0,pB1;
  int sl_prev=0,sl_cur=0,sl_next=SLOTB;
  DMA_K(2,2*SLOTB);
  WAIT_BAR(4);
  qkt(pA0,pA1,kp0,q8,negm);asm volatile("s_nop 15\n\ts_nop 7":"+v"(pA0),"+v"(pA1));
  if(SB){ _Pragma("unroll") for(int r=0;r<16;++r)pA0[r]=__builtin_amdgcn_exp2f(pA0[r]); } else { START(pA0,pA1); }
  _Pragma("unroll") for(int r=0;r<16;++r)pA1[r]=__builtin_amdgcn_exp2f(pA1[r]);
  WAIT_BAR(0);
  DMA_K(3,0);DMA_V(1,SLOTB);
  ROT();
  kf[0]=kfrag8(kp0+sl_cur,0);kf[1]=kfrag8(kp0+sl_cur,1);
  WAIT_BAR(3);
  s16x4 vfl[4],vfh[4]; u32x4 pw0,pw1,pw2,pw3;
  #define VFRB(g) (bf16x8){vfl[(g)&3][0],vfl[(g)&3][1],vfl[(g)&3][2],vfl[(g)&3][3],vfh[(g)&3][0],vfh[(g)&3][1],vfh[(g)&3][2],vfh[(g)&3][3]}
  #define VRDB(g) do{ vfl[(g)&3]=vtr(vp_+(((g)&3)*4096+((g)>>2)*1024)); vfh[(g)&3]=vtr(vp_+(((g)&3)*4096+((g)>>2)*1024+512)); }while(0)
  #define GAPB2(g,X,B) do{ o[(g)&3]=MF32(PAF4((g)>>2),VFRB(g),o[(g)&3]); X[B]=EX(X[B]); X[B+1]=EX(X[B+1]); PIN(X); SBAR(); }while(0)
  #define PAF4(k) ((k)==0?PAF(0):(k)==1?PAF(1):(k)==2?PAF(2):PAF(3))
  #define STEPB(C0,C1,P0,P1,t,GK,GV,GL) do{ SBAR(); \
    const lds_cptr vp_=vp0+2*sl_prev; \
    float sacc=(P0[0]+P0[1]); \
    GAPA(C0=MFQ(kf[0],q8,negm),      P0[2],P0[3],P0[4],P0[5],     pw0[0]=PKW(P0,0), pw0[1]=PKW(P0,2), pw0); \
    GAPA(C1=MFQ(kf[1],q8,negm),      P0[6],P0[7],P0[8],P0[9],     pw0[2]=PKW(P0,4), pw0[3]=PKW(P0,6), pw0); \
    GAPA((void)0,                     P0[10],P0[11],P0[12],P0[13], pw1[0]=PKW(P0,8), pw1[1]=PKW(P0,10), pw1); \
    GAPA((void)0,                     P0[14],P0[15],P1[0],P1[1],   pw1[2]=PKW(P0,12),pw1[3]=PKW(P0,14), pw1); \
    GAPA((void)0,                     P1[2],P1[3],P1[4],P1[5],     pw2[0]=PKW(P1,0), pw2[1]=PKW(P1,2), pw2); \
    GAPA((void)0,                     P1[6],P1[7],P1[8],P1[9],     pw2[2]=PKW(P1,4), pw2[3]=PKW(P1,6), pw2); \
    GAPA((void)0,                     P1[10],P1[11],P1[12],P1[13], pw3[0]=PKW(P1,8), pw3[1]=PKW(P1,10), pw3); \
    GAPA((void)0,                     P1[14],P1[15],0.f,0.f,       pw3[2]=PKW(P1,12),pw3[3]=PKW(P1,14), pw3); \
    l_reg+=sacc; \
    if(GK){DMA_K((t)+3,sl_cur);} if(GV){DMA_V((t)+1,sl_next);} \
    VRDB(0); VRDB(1); SBAR(); \
    if(!SB){ DECIDE(C0,C1); } \
    SBAR(); __builtin_amdgcn_s_setprio(1); \
    VRDB(2);  SBAR(); GAPB2(0, C0,0); \
    VRDB(3);  SBAR(); GAPB2(1, C0,2); \
    VRDB(4);  SBAR(); GAPB2(2, C0,4); \
    VRDB(5);  SBAR(); GAPB2(3, C0,6); \
    KRD(GL,0); VRDB(6);  SBAR(); GAPB2(4, C0,8); \
    VRDB(7);  SBAR(); GAPB2(5, C0,10); \
    KRD(GL,1); VRDB(8);  SBAR(); GAPB2(6, C0,12); \
    VRDB(9);  SBAR(); GAPB2(7, C0,14); \
    KRD(GL,2); VRDB(10); SBAR(); GAPB2(8, C1,0); \
    VRDB(11); SBAR(); GAPB2(9, C1,2); \
    KRD(GL,3); VRDB(12); SBAR(); GAPB2(10,C1,4); \
    VRDB(13); SBAR(); GAPB2(11,C1,6); \
    VRDB(14); SBAR(); GAPB2(12,C1,8); \
    VRDB(15); SBAR(); GAPB2(13,C1,10); \
    GAPB2(14,C1,12); \
    GAPB2(15,C1,14); __builtin_amdgcn_s_setprio(0); \
    }while(0)
  int t=1;
  asm volatile(".p2align 8\n\t.fill 4, 4, 0xbf800000");
  for(;t+5<NT;t+=2){
    STEPB(pB0,pB1,pA0,pA1,t,true,true,true);     WAIT_BAR(3); RESC(); ROT();
    STEPB(pA0,pA1,pB0,pB1,t+1,true,true,true);   WAIT_BAR(3); RESC(); ROT();
  }
  #define ENDW(tt) do{ if((tt)+3<NT){WAIT_BAR(3);} else if((tt)+2<NT){WAIT_BAR(2);} else {WAIT_BAR(0);} }while(0)
  for(;t+1<NT;t+=2){
    STEPB(pB0,pB1,pA0,pA1,t,(t+3<NT),(t+1<NT),(t+1<NT));       ENDW(t);   RESC(); ROT();
    STEPB(pA0,pA1,pB0,pB1,t+1,(t+4<NT),(t+2<NT),(t+2<NT));     ENDW(t+1); RESC(); ROT();
  }
  STEPB(pB0,pB1,pA0,pA1,NT-1,false,false,false); RESC();
  { float sacc=pB0[0]+pB0[1]; _Pragma("unroll") for(int r=2;r<16;++r)sacc+=pB0[r]; _Pragma("unroll") for(int r=0;r<16;++r)sacc+=pB1[r]; l_reg+=sacc;
    pw0=(u32x4){PKW(pB0,0),PKW(pB0,2),PKW(pB0,4),PKW(pB0,6)};pw1=(u32x4){PKW(pB0,8),PKW(pB0,10),PKW(pB0,12),PKW(pB0,14)};pw2=(u32x4){PKW(pB1,0),PKW(pB1,2),PKW(pB1,4),PKW(pB1,6)};pw3=(u32x4){PKW(pB1,8),PKW(pB1,10),PKW(pB1,12),PKW(pB1,14)};
    SBAR(); pv<4>(o,vb0+2*sl_cur,PAF(0),PAF(1),PAF(2),PAF(3)); }
  #undef VFRB
  #undef VRDB
  #undef GAPB2
  #undef PAF4
  #undef STEPB
  #undef ENDW
  {auto rr=__builtin_amdgcn_permlane32_swap(__float_as_uint(l_reg),__float_as_uint(l_reg),false,false);l_reg=__uint_as_float(rr[0])+__uint_as_float(rr[1]);}
  if(hi==0)wsf[32+r32]=l_reg;asm volatile("s_waitcnt lgkmcnt(0)":::"memory");
  float rli[16];
  #pragma unroll
  for(int r=0;r<16;++r)rli[r]=__builtin_amdgcn_rcpf(wsf[32+crow(r,hi)]);
  int lane_e=lane; asm volatile("":"+v"(lane_e));
  const int r32e=lane_e&31, hie=lane_e>>5;
  float*scw=sc+(long)wid*4096+lane_e;
  if(comp==0){
    #pragma unroll
    for(int d0=0;d0<4;++d0)
      #pragma unroll
      for(int r=0;r<16;++r)scw[(d0*16+r)*64]=o[d0][r]*rli[r];
  } else {
    float ssq[16];
    #pragma unroll
    for(int r=0;r<16;++r)ssq[r]=0.f;
    #pragma unroll
    for(int d0=0;d0<4;++d0)
      #pragma unroll
      for(int r=0;r<16;++r){ const float dv=scw[(d0*16+r)*64]-lam*(o[d0][r]*rli[r]); o[d0][r]=dv; ssq[r]+=dv*dv; }
    #pragma unroll
    for(int r=0;r<16;++r){ float s=ssq[r]; s+=__shfl_xor(s,1); s+=__shfl_xor(s,2); s+=__shfl_xor(s,4); s+=__shfl_xor(s,8); s+=__shfl_xor(s,16); ssq[r]=__builtin_amdgcn_rsqf(s*(1.0f/128.0f)+1e-5f)*0.8f; }
    float gsub[4];
    #pragma unroll
    for(int d0=0;d0<4;++d0)gsub[d0]=subg[d0*32+r32e];
    bf16*Ow=Ob+(long)(q0+wid*QBLK)*OPITCH;
    bf16*stg=(bf16*)(shm+LDS_OST)+wid*4096;
    #pragma unroll
    for(int r=0;r<16;++r){const int orow=crow(r,hie);
      #pragma unroll
      for(int d0=0;d0<4;++d0)stg[orow*128+d0*32+r32e]=__float2bfloat16(o[d0][r]*ssq[r]*gsub[d0]);}
    asm volatile("s_waitcnt lgkmcnt(0)":::"memory");
    #pragma unroll
    for(int i=0;i<8;++i){const int row=i*4+(lane_e>>4),ch=lane_e&15; const u32x4 v=*(const u32x4*)(stg+row*128+ch*8); ATTN_STORE16(Ow+(long)row*OPITCH+ch*8,v);}
  }
  asm volatile("s_waitcnt vmcnt(0) lgkmcnt(0)\n\ts_barrier":::"memory");
  #undef DMA_K
  #undef DMA_V
  #undef RESC
}
#undef PKW
#undef PAF
#undef PIN
#undef MX3
#undef EX
#undef MF32
#undef GAPA
#undef ROT
#undef DECIDE
#undef START
#undef KRD
#undef SBAR
#undef WAIT_BAR
constexpr int ATTN_LDS_BYTES=LDS_BYTES;
}
constexpr int NWAVES = 8;
#ifndef MK_N_LAUNCHES
#define MK_N_LAUNCHES 1
#endif
constexpr int PER_PHASE = 7;
constexpr int N_LAUNCHES = MK_N_LAUNCHES;
static_assert(N_LAUNCHES == 1 || N_LAUNCHES == PER_PHASE, "MK_N_LAUNCHES is 1 or 7");

constexpr int M = 16384, DM = 1024, NIN = 2304, NQ = 2048, NEXP = 16384;
constexpr float C2 = 0.125f * 1.4426950408889634f;
constexpr float NORM_EPS = 1e-6f;

constexpr size_t MiB = 1u << 20;
constexpr size_t WS_CTL = 0, CTL_ZERO_BYTES = 1 * MiB;
constexpr size_t WS_TROW = 1 * MiB, WS_TCOL = 1 * MiB + 65536, WS_TPOS = 1 * MiB + 524288;
constexpr size_t WS_SK = 3 * MiB;
constexpr size_t WS_SSQ = 4 * MiB;
constexpr size_t WS_INVS = 5 * MiB;
constexpr size_t WS_WIN = 6 * MiB, WS_WOUT = 11 * MiB, WS_WQ = 13 * MiB;
constexpr size_t WS_UV8 = 32 * MiB;
constexpr int EROW = 512;
constexpr size_t V4_OFF = 8 * MiB;
constexpr size_t WS_SCL = 5 * MiB + 524288;
constexpr size_t WS_XN = 96 * MiB;
constexpr size_t WS_QKV = 128 * MiB;
constexpr size_t WS_AO = 200 * MiB;
constexpr size_t WS_META = 232 * MiB;
constexpr size_t WS_END = 248 * MiB;
constexpr int CW_TMO = 0, CW_CODE = 1, CW_BAR = 4096;

constexpr int RING_OFF = 0, RING_BYTES = 147456;
constexpr int LDSCTL_OFF = RING_BYTES, MISC_OFF = LDSCTL_OFF + 320;
constexpr int LDS_BYTES = RING_BYTES + 4096;
static_assert(attn_body::ATTN_LDS_BYTES <= RING_BYTES && pg8::STAGE_BYTES <= RING_BYTES, "LDS map");

#define GAS __attribute__((address_space(1)))
#define LAS __attribute__((address_space(3)))
typedef unsigned short bf16;
typedef unsigned v4u __attribute__((ext_vector_type(4)));
typedef unsigned v2u __attribute__((ext_vector_type(2)));
typedef float f32x4 __attribute__((ext_vector_type(4)));
typedef float f32x16 __attribute__((ext_vector_type(16)));
typedef short bf16x8 __attribute__((ext_vector_type(8)));
typedef __bf16 bf16x2_t __attribute__((ext_vector_type(2)));
typedef GAS unsigned gu32;
#define RLX_AGENT __ATOMIC_RELAXED, __HIP_MEMORY_SCOPE_AGENT
#define LDS_WAIT() asm volatile("s_waitcnt lgkmcnt(0)" ::: "memory")
#define VM_WAIT() asm volatile("s_waitcnt vmcnt(0)" ::: "memory")
__device__ __forceinline__ unsigned f2bf(float f) { unsigned u = __builtin_bit_cast(unsigned, f); return (u + 0x7fffu + ((u >> 16) & 1u)) >> 16; }
__device__ __forceinline__ unsigned pk2(float lo, float hi) { return f2bf(lo) | (f2bf(hi) << 16); }
#define XB_TMO      128
#define XB_XCNT(j)  (256  + 64 * (j))
#define XB_XSUB(j)  (1280 + 64 * (j))
#define XB_XGEN(j)  (2304 + 64 * (j))
#define XB_TOP      3328
#define XB_TOPGEN   3392
#define XCD_BAR_WORDS 3456
#define XB_SPIN_CAP (1u << 18)

__device__ __forceinline__ unsigned xb_ld(unsigned* p)              { return __hip_atomic_load(p, __ATOMIC_RELAXED, __HIP_MEMORY_SCOPE_AGENT); }
__device__ __forceinline__ unsigned xb_add(unsigned* p, unsigned v) { return __hip_atomic_fetch_add(p, v, __ATOMIC_RELAXED, __HIP_MEMORY_SCOPE_AGENT); }
__device__ __forceinline__ unsigned xb_xcc_id() { return (unsigned)__builtin_amdgcn_s_getreg((3 << 11) | 20) & 0xFu; }
#define XB_SPIN(cond, bar) do { unsigned _sp = 0; while (cond) { __builtin_amdgcn_s_sleep(1); \
    if ((++_sp & 255u) == 0u) { if (xb_ld(&(bar)[XB_TMO])) break; if (_sp > XB_SPIN_CAP) { atomicAdd(&(bar)[XB_TMO], 1u); break; } } } } while (0)

struct XcdBarrier {
    unsigned* bar; unsigned x;
    volatile LAS unsigned* st;
};

__device__ __forceinline__ XcdBarrier xcd_barrier_post(unsigned* bar, volatile LAS unsigned* st) {
    XcdBarrier b; b.bar = bar; b.x = xb_xcc_id(); b.st = st;
    if (threadIdx.x == 0) (void)xb_add(&bar[XB_XCNT(b.x)], 1u);
    return b;
}
__device__ __forceinline__ void xcd_barrier_complete(unsigned* bar, unsigned x, unsigned& nloc, unsigned& nx) {
    const unsigned G = gridDim.x * gridDim.y * gridDim.z;
    unsigned sum, cnt, mine, sp = 0u;
    for (;;) {
        sum = 0u; cnt = 0u; mine = 0u;
#pragma unroll
        for (unsigned j = 0; j < 16; ++j) { const unsigned c = xb_ld(&bar[XB_XCNT(j)]); sum += c; cnt += (c > 0u) ? 1u : 0u; mine = (j == x) ? c : mine; }
        if (sum == G) break;
        __builtin_amdgcn_s_sleep(1);
        if ((++sp & 255u) == 0u) { if (xb_ld(&bar[XB_TMO])) break; if (sp > XB_SPIN_CAP) { atomicAdd(&bar[XB_TMO], 1u); break; } }
    }
    nloc = mine > 0u ? mine : 1u; nx = cnt > 0u ? cnt : 1u;
}

__device__ __forceinline__ void xcd_barrier(const XcdBarrier& b) {
    asm volatile("s_waitcnt vmcnt(0)" ::: "memory");
    __syncthreads();
    if (threadIdx.x == 0) {
        unsigned* bar = b.bar;
        __builtin_amdgcn_s_waitcnt(0);
        unsigned nloc = b.st[0], nx = b.st[1];
        if (nloc == 0u) { xcd_barrier_complete(bar, b.x, nloc, nx); b.st[0] = nloc; b.st[1] = nx; }
        const unsigned old = xb_add(&bar[XB_XSUB(b.x)], 1u);
        const unsigned gen = old / nloc;
        if (old + 1u == (gen + 1u) * nloc) {
            __builtin_amdgcn_fence(__ATOMIC_RELEASE, "agent");
            asm volatile("s_waitcnt vmcnt(0)" ::: "memory");
            const unsigned og = xb_add(&bar[XB_TOP], 1u);
            const unsigned tg = og / nx;
            if (og + 1u == (tg + 1u) * nx) xb_add(&bar[XB_TOPGEN], 1u);
            else XB_SPIN(xb_ld(&bar[XB_TOPGEN]) == tg, bar);
            __builtin_amdgcn_fence(__ATOMIC_ACQUIRE, "agent");
            xb_add(&bar[XB_XGEN(b.x)], 1u);
            asm volatile("s_waitcnt vmcnt(0)" ::: "memory");
        } else {
            XB_SPIN(xb_ld(&bar[XB_XGEN(b.x)]) == gen, bar);
            __builtin_amdgcn_fence(__ATOMIC_ACQUIRE, "agent");
            asm volatile("s_waitcnt vmcnt(0)" ::: "memory");
        }
    }
    __syncthreads();
}
struct Frame {
    LAS unsigned char* lds;
    volatile LAS unsigned* MISC;
    gu32* ctl;
    int tid, lane, wave;
    int vcu, G;
};
struct Args { const float* in[17]; float* out; unsigned char* ws; double inv_ax[16]; double inv_p[8]; int ph_lo, ph_hi, li, pad; };

__device__ __forceinline__ float wave_sum(float v) {
#pragma unroll
    for (int o = 1; o < 64; o <<= 1) v += __shfl_xor(v, o);
    return v;
}
__host__ __device__ __forceinline__ int inproj_dst_col(int j) {
    const int s = j >> 6, d = j & 63; int bj, p;
    if (s < 10) { bj = d >> 5; p = 8 * ((d >> 2) & 3) + 4 * ((d >> 4) & 1) + (d & 3); }
    else if (s >= 12 && s < 28) { if (d < 32) { bj = 0; p = 8 * (2 * (d >> 4) + ((d >> 2) & 1)) + 4 * ((d >> 3) & 1) + (d & 3); } else { bj = 1; p = d - 32; } }
    else { bj = d >> 5; p = d & 31; }
    return (s >> 2) * 256 + bj * 128 + (s & 3) * 32 + p;
}
template <int MODE> __device__ __forceinline__ void p0_transpose_item(const float* W, int K, int N, bf16* WT, const float* kscale, LAS float* scr, int item, int lane) {
    const int nblk = N / 32, kb = item / nblk, nb = item % nblk, k0 = 64 * kb, n0 = 32 * nb;
    { f32x4 w[8];
#pragma unroll
      for (int i = 0; i < 8; ++i) w[i] = *(const GAS f32x4*)(W + (size_t)(k0 + (lane >> 3) + 8 * i) * N + n0 + 4 * (lane & 7));
#pragma unroll
      for (int i = 0; i < 8; ++i) { const int kk = (lane >> 3) + 8 * i; f32x4 v = w[i]; if (MODE == 2) v = v * kscale[k0 + kk];
          LAS float* d = scr + kk * 33 + 4 * (lane & 7); d[0] = v.x; d[1] = v.y; d[2] = v.z; d[3] = v.w; } }
    LDS_WAIT(); asm volatile("" ::: "memory");
    const int c = lane & 7;
#pragma unroll
    for (int j = 0; j < 4; ++j) { const int n = (lane >> 3) + 8 * j; const LAS float* s = scr + (8 * c) * 33 + n;
        v4u o; o.x = pk2(s[0 * 33], s[1 * 33]); o.y = pk2(s[2 * 33], s[3 * 33]); o.z = pk2(s[4 * 33], s[5 * 33]); o.w = pk2(s[6 * 33], s[7 * 33]);
        const int dr = (MODE == 1) ? inproj_dst_col(n0 + n) : (n0 + n);
        *(GAS v4u*)(WT + (size_t)dr * K + k0 + 8 * c) = o; }
    LDS_WAIT(); asm volatile("" ::: "memory");
}
template <bool NORM> __device__ __forceinline__ void p0_row_to_bf16(const float* src, bf16* dst, const float* cscale, int lane) {
    const GAS f32x4* xr = (const GAS f32x4*)src + lane;
    f32x4 v[4]; float s = 0.f;
#pragma unroll
    for (int j = 0; j < 4; ++j) { v[j] = xr[64 * j]; s += (v[j].x * v[j].x + v[j].y * v[j].y) + (v[j].z * v[j].z + v[j].w * v[j].w); }
    float rstd = 1.f;
    if (NORM) rstd = __builtin_amdgcn_rsqf(wave_sum(s) * (1.f / DM) + NORM_EPS);
    GAS unsigned long long* o8 = (GAS unsigned long long*)dst + lane;
#pragma unroll
    for (int j = 0; j < 4; ++j) { f32x4 w = v[j] * rstd; if (cscale) w = w * ((const GAS f32x4*)cscale)[lane + 64 * j];
        o8[64 * j] = (unsigned long long)pk2(w.x, w.y) | ((unsigned long long)pk2(w.z, w.w) << 32); }
}
__device__ __forceinline__ void sincos_rev(double ang, float& c, float& s) {
    double rev = ang * 0.15915494309189535; rev -= __builtin_rint(rev);
    const float r = (float)rev; c = __builtin_amdgcn_cosf(r); s = __builtin_amdgcn_sinf(r);
}
__device__ __forceinline__ float wave_max(float v) {
#pragma unroll
    for (int o = 1; o < 64; o <<= 1) v = __builtin_fmaxf(v, __shfl_xor(v, o));
    return v;
}
__device__ __forceinline__ void p0_row_load(const float* src, int lane, f32x4 (&v)[4]) {
    const GAS f32x4* xr = (const GAS f32x4*)src + 4 * lane;
#pragma unroll
    for (int j = 0; j < 4; ++j) v[j] = xr[j];
}
__device__ __forceinline__ float p0_row_finish(f32x4 (&v)[4], unsigned char* dst, const f32x4* cs, int lane) {
    float mx = 0.f;
#pragma unroll
    for (int j = 0; j < 4; ++j) { if (cs) v[j] = v[j] * cs[j];
        mx = __builtin_fmaxf(mx, __builtin_fmaxf(__builtin_fmaxf(__builtin_fabsf(v[j].x), __builtin_fabsf(v[j].y)), __builtin_fmaxf(__builtin_fabsf(v[j].z), __builtin_fabsf(v[j].w)))); }
    mx = wave_max(mx);
    const bool ok = mx > 1e-30f && mx < 1e30f;
    const float sc = ok ? 6.0f / mx : 1.f, isc = ok ? mx * (1.0f / 6.0f) : 1.f;
    unsigned d0 = 0u, d1 = 0u;
    { const f32x4 a = v[0] * sc, b = v[1] * sc, c = v[2] * sc, d = v[3] * sc;
      d0 = __builtin_amdgcn_cvt_scalef32_pk_fp4_f32(d0, a.x, a.y, 1.0f, 0); d0 = __builtin_amdgcn_cvt_scalef32_pk_fp4_f32(d0, a.z, a.w, 1.0f, 1);
      d0 = __builtin_amdgcn_cvt_scalef32_pk_fp4_f32(d0, b.x, b.y, 1.0f, 2); d0 = __builtin_amdgcn_cvt_scalef32_pk_fp4_f32(d0, b.z, b.w, 1.0f, 3);
      d1 = __builtin_amdgcn_cvt_scalef32_pk_fp4_f32(d1, c.x, c.y, 1.0f, 0); d1 = __builtin_amdgcn_cvt_scalef32_pk_fp4_f32(d1, c.z, c.w, 1.0f, 1);
      d1 = __builtin_amdgcn_cvt_scalef32_pk_fp4_f32(d1, d.x, d.y, 1.0f, 2); d1 = __builtin_amdgcn_cvt_scalef32_pk_fp4_f32(d1, d.z, d.w, 1.0f, 3); }
    *(GAS v2u*)(dst + 8 * lane) = (v2u){d0, d1};
    return isc;
}
__device__ __forceinline__ void p0_prologue(Frame& F, const Args& A) {
    unsigned char* ws = A.ws;
    LAS float* scr = (LAS float*)(F.lds + RING_OFF + F.wave * 16384);
    const int gw = F.vcu * NWAVES + F.wave, NGW = F.G * NWAVES;
    { float* tpos = (float*)(ws + WS_TPOS); float* trow = (float*)(ws + WS_TROW); float* tcol = (float*)(ws + WS_TCOL);
      const int gt = F.vcu * (NWAVES * 64) + F.tid, NTH = F.G * NWAVES * 64;
      for (int i = gt; i < M * 8; i += NTH) { const int pos = i >> 3, f = i & 7; float c, s; sincos_rev((double)pos * A.inv_p[f], c, s); tpos[pos * 16 + f] = c; tpos[pos * 16 + 8 + f] = s; }
      for (int i = gt; i < 256 * 16; i += NTH) { const int idx = i >> 4, f = i & 15; float c, s; sincos_rev((double)idx * A.inv_ax[f], c, s); trow[idx * 32 + f] = c; trow[idx * 32 + 16 + f] = s; }
      for (int i = gt; i < 64 * 16; i += NTH) { const int idx = i >> 4, f = i & 15; float c, s; sincos_rev((double)idx * A.inv_ax[f], c, s); tcol[idx * 32 + f] = c; tcol[idx * 32 + 16 + f] = s; }
      const float* sk = A.in[13]; unsigned* skb = (unsigned*)(ws + WS_SK);
      for (int i = gt; i < 8 * 2 * 128 * 128 / 2; i += NTH) skb[i] = pk2(sk[2 * i], sk[2 * i + 1]);
    }
    constexpr int I_IN = (DM / 64) * (NIN / 32);
    for (int it = gw; it < I_IN; it += NGW) p0_transpose_item<1>(A.in[2], DM, NIN, (bf16*)(ws + WS_WIN), nullptr, scr, it, F.lane);
    { f32x4 gsc[4];
#pragma unroll
      for (int j = 0; j < 4; ++j) gsc[j] = ((const GAS f32x4*)A.in[1])[F.lane + 64 * j];
      for (int m0 = gw; m0 < M; m0 += 4 * NGW) {
        f32x4 v[4][4]; float ss[4];
#pragma unroll
        for (int r = 0; r < 4; ++r) { const int m = (m0 + r * NGW < M) ? m0 + r * NGW : m0; const GAS f32x4* xr = (const GAS f32x4*)(A.in[0] + (size_t)m * DM) + F.lane;
#pragma unroll
            for (int j = 0; j < 4; ++j) v[r][j] = xr[64 * j]; }
#pragma unroll
        for (int r = 0; r < 4; ++r) { float s_ = 0.f;
#pragma unroll
            for (int j = 0; j < 4; ++j) s_ += (v[r][j].x * v[r][j].x + v[r][j].y * v[r][j].y) + (v[r][j].z * v[r][j].z + v[r][j].w * v[r][j].w);
            ss[r] = __builtin_amdgcn_rsqf(wave_sum(s_) * (1.f / DM) + NORM_EPS); }
#pragma unroll
        for (int r = 0; r < 4; ++r) { const int m = m0 + r * NGW; if (m < M) { GAS unsigned long long* o8 = (GAS unsigned long long*)((bf16*)(ws + WS_XN) + (size_t)m * DM) + F.lane;
#pragma unroll
            for (int j = 0; j < 4; ++j) { const f32x4 w = v[r][j] * ss[r] * gsc[j]; o8[64 * j] = (unsigned long long)pk2(w.x, w.y) | ((unsigned long long)pk2(w.z, w.w) << 32); } } }
      } }
}
__device__ __forceinline__ void p0_lazy(Frame& F, const Args& A, int gw, int NGW) {
    unsigned char* ws = A.ws;
    LAS float* scr = (LAS float*)(F.lds + RING_OFF + F.wave * 16384);
    constexpr int I_OUT = (DM / 64) * (DM / 32), I_Q = (DM / 64) * (NQ / 32);
    for (int it = gw; it < I_OUT + I_Q; it += NGW) {
        if (it < I_OUT) p0_transpose_item<0>(A.in[10], DM, DM, (bf16*)(ws + WS_WOUT), nullptr, scr, it, F.lane);
        else p0_transpose_item<2>(A.in[12], DM, NQ, (bf16*)(ws + WS_WQ), A.in[11], scr, it - I_OUT, F.lane);
    }
    f32x4 cs[4];
#pragma unroll
    for (int j = 0; j < 4; ++j) cs[j] = ((const GAS f32x4*)A.in[11])[4 * F.lane + j];
    for (int m = gw; m < NEXP; m += 2 * NGW) {
        const int m2 = m + NGW; const bool has2 = m2 < NEXP; const int mb = has2 ? m2 : m;
        f32x4 ua[4], va[4], ub[4], vb[4];
        p0_row_load(A.in[14] + (size_t)m * DM, F.lane, ua); p0_row_load(A.in[15] + (size_t)m * DM, F.lane, va);
        p0_row_load(A.in[14] + (size_t)mb * DM, F.lane, ub); p0_row_load(A.in[15] + (size_t)mb * DM, F.lane, vb);
        asm volatile("" ::: "memory");
        { const float iu = p0_row_finish(ua, ws + WS_UV8 + (size_t)m * EROW, cs, F.lane);
          const float iv = p0_row_finish(va, ws + WS_UV8 + V4_OFF + (size_t)m * EROW, nullptr, F.lane);
          if (F.lane == 0) { float* sc = (float*)(ws + WS_SCL) + 2 * m; sc[0] = iu; sc[1] = iv; } }
        if (has2) { const float iu = p0_row_finish(ub, ws + WS_UV8 + (size_t)m2 * EROW, cs, F.lane);
          const float iv = p0_row_finish(vb, ws + WS_UV8 + V4_OFF + (size_t)m2 * EROW, nullptr, F.lane);
          if (F.lane == 0) { float* sc = (float*)(ws + WS_SCL) + 2 * m2; sc[0] = iu; sc[1] = iv; } }
    }
}

__device__ __forceinline__ void topk_insert(float (&L)[16], float c) {
#pragma unroll
    for (int j = 15; j >= 1; --j) L[j] = __builtin_amdgcn_fmed3f(L[j - 1], L[j], c);
    L[0] = __builtin_fmaxf(L[0], c);
}
__device__ __forceinline__ void cex(float& a, float& b) { const float hi = __builtin_amdgcn_fmed3f(a, b, INFINITY), lo = __builtin_amdgcn_fmed3f(a, b, -INFINITY); a = hi; b = lo; }
__device__ __forceinline__ void sort16_desc(float (&v)[16]) {
    constexpr unsigned char P[60][2] = {{0,13},{1,12},{2,15},{3,14},{4,8},{5,6},{7,11},{9,10},{0,5},{1,7},{2,9},{3,4},{6,13},{8,14},{10,15},{11,12},{0,1},{2,3},{4,5},{6,8},{7,9},{10,11},{12,13},{14,15},
        {0,2},{1,3},{4,10},{5,11},{6,7},{8,9},{12,14},{13,15},{1,2},{3,12},{4,6},{5,7},{8,10},{9,11},{13,14},{1,4},{2,6},{5,8},{7,10},{9,13},{11,14},{2,4},{3,6},{9,12},{11,13},{3,5},{6,8},{7,9},{10,12},
        {3,4},{5,6},{7,8},{9,10},{11,12},{6,7},{8,9}};
#pragma unroll
    for (int k = 0; k < 60; ++k) cex(v[P[k][0]], v[P[k][1]]);
}
__device__ __forceinline__ void merge_top16(float (&a)[16], const float (&b)[16]) {
#pragma unroll
    for (int i = 0; i < 16; ++i) a[i] = __builtin_amdgcn_fmed3f(a[i], b[15 - i], INFINITY);
#pragma unroll
    for (int st = 8; st >= 1; st >>= 1)
#pragma unroll
        for (int i = 0; i < 16; ++i) if ((i & st) == 0) cex(a[i], a[i + st]);
}
__device__ __forceinline__ void p5_topk(Frame& F, const Args& A) {
    unsigned char* ws = A.ws;
    const bf16* QP = (const bf16*)(ws + WS_QKV); const bf16* SK = (const bf16*)(ws + WS_SK); const float* SSQ = (const float*)(ws + WS_SSQ);
    v2u* META = (v2u*)(ws + WS_META); float* INVS = (float*)(ws + WS_INVS);
    const int lane = F.lane, r32 = lane & 31, hi = lane >> 5;
    const int cpg = F.G / 8, h = F.vcu / cpg, cg = F.vcu % cpg;
    { const v4u* src = (const v4u*)(SK + (size_t)h * 2 * 128 * 128);
      for (int i = F.tid; i < 2 * 128 * 16; i += NWAVES * 64) { const int p = i >> 11, key = (i >> 4) & 127, c = i & 15;
          *(LAS v4u*)(F.lds + RING_OFF + (((p * 8 + (c >> 1)) * 2 + (c & 1)) * 2048 + key * 16)) = src[i]; }
      LDS_WAIT(); __syncthreads(); }
    const LAS unsigned char* ska = F.lds + RING_OFF + hi * 2048 + r32 * 16;
    for (int g = cg * NWAVES + F.wave; g < M / 32; g += cpg * NWAVES) {
        const int t = g * 32 + r32;
        const bf16* qp = QP + (size_t)t * NQ + h * 256 + 8 * hi;
        float ss = 0.f;
#pragma unroll
        for (int i = 0; i < 16; ++i) ss += SSQ[(size_t)i * M + t];
        const float rstd = __builtin_amdgcn_rsqf(ss * (1.f / DM) + NORM_EPS);
        float m0[16], m1[16];
#pragma unroll
        for (int p = 0; p < 2; ++p) {
            f32x16 acc[4];
#pragma unroll
            for (int b = 0; b < 4; ++b) acc[b] = f32x16{};
            bf16x8 bq[8];
#pragma unroll
            for (int s = 0; s < 8; ++s) bq[s] = *(const bf16x8*)(qp + p * 128 + 16 * s);
#pragma unroll
            for (int s = 0; s < 8; ++s) {
#pragma unroll
                for (int b = 0; b < 4; ++b) { const bf16x8 ak = *(const LAS bf16x8*)(ska + (p * 8 + s) * 4096 + b * 512); acc[b] = __builtin_amdgcn_mfma_f32_32x32x16_bf16(ak, bq[s], acc[b], 0, 0, 0); }
                if (s & 1) __builtin_amdgcn_sched_barrier(0); }
            float L[16], G[16];
#pragma unroll
            for (int b = 0; b < 4; ++b) {
#pragma unroll
                for (int r = 0; r < 16; ++r) G[r] = __uint_as_float((__float_as_uint(acc[b][r]) & ~127u) | (unsigned)(b * 32 + (r & 3) + 8 * (r >> 2)));
                sort16_desc(G);
                if (b == 0) {
#pragma unroll
                    for (int r = 0; r < 16; ++r) L[r] = G[r];
                } else merge_top16(L, G);
            }
            { const unsigned hi4 = 4u * hi;
#pragma unroll
              for (int j = 0; j < 16; ++j) L[j] = __uint_as_float(__float_as_uint(L[j]) | hi4); }
            float O[16];
#pragma unroll
            for (int j = 0; j < 16; ++j) O[j] = __shfl_xor(L[j], 32);
            merge_top16(L, O);
#pragma unroll
            for (int j = 0; j < 16; ++j) { if (p == 0) m0[j] = L[j]; else m1[j] = L[j]; }
        }
        float T[16];
#pragma unroll
        for (int j = 0; j < 16; ++j) T[j] = -INFINITY;
#pragma unroll
        for (int a = 0; a < 16; ++a)
#pragma unroll
            for (int b = 0; b < 16; ++b) if ((a + 1) * (b + 1) <= 16) { const float v = m0[a] + m1[b]; const unsigned key = (__float_as_uint(v) & ~255u) | (unsigned)(a * 16 + b); topk_insert(T, __uint_as_float(key)); }
        const float thr = T[15], ref = T[0];
        int cnt = 0; float sum = 0.f; const float kk = rstd * 1.4426950408889634f;
        LAS v2u* mst = (LAS v2u*)(F.lds + RING_OFF + 65536 + F.wave * 4096);
        LAS v2u* meta = mst + r32 * 16;
#pragma unroll
        for (int a = 0; a < 16; ++a)
#pragma unroll
            for (int b = 0; b < 16; ++b) if ((a + 1) * (b + 1) <= 16) { const float v = m0[a] + m1[b]; const unsigned key = (__float_as_uint(v) & ~255u) | (unsigned)(a * 16 + b);
                if (__uint_as_float(key) >= thr) { const unsigned idx = ((__float_as_uint(m0[a]) & 127u) << 7) | (__float_as_uint(m1[b]) & 127u);
                    const float e = __builtin_amdgcn_exp2f((v - ref) * kk); if (hi == 0 && cnt < 16) meta[cnt] = (v2u){idx, __float_as_uint(e)}; sum += e; ++cnt; } }
        if (hi == 0) INVS[(size_t)t * 8 + h] = 1.0f / sum;
        LDS_WAIT(); asm volatile("" ::: "memory");
#pragma unroll
        for (int i = 0; i < 4; ++i) { const int ch = i * 64 + lane, tok = ch >> 3, c8 = ch & 7;
            const v4u val = *(const LAS v4u*)((const LAS unsigned char*)mst + tok * 128 + c8 * 16);
            *(v4u*)((unsigned char*)(META + ((size_t)(g * 32 + tok) * 8 + h) * 16) + c8 * 16) = val; }
        LDS_WAIT(); asm volatile("" ::: "memory");
    }
    __syncthreads();
}

typedef float f32x2v __attribute__((ext_vector_type(2)));
__device__ __forceinline__ void axpy16_fp4(f32x2v (&acc)[8], const v2u r, float wj) {
    const f32x2v ww = {wj, wj};
    const unsigned d0 = r.x, d1 = r.y;
    acc[0] = __builtin_amdgcn_cvt_scalef32_pk_f32_fp4(d0, 1.0f, 0) * ww + acc[0]; acc[1] = __builtin_amdgcn_cvt_scalef32_pk_f32_fp4(d0, 1.0f, 1) * ww + acc[1];
    acc[2] = __builtin_amdgcn_cvt_scalef32_pk_f32_fp4(d0, 1.0f, 2) * ww + acc[2]; acc[3] = __builtin_amdgcn_cvt_scalef32_pk_f32_fp4(d0, 1.0f, 3) * ww + acc[3];
    acc[4] = __builtin_amdgcn_cvt_scalef32_pk_f32_fp4(d1, 1.0f, 0) * ww + acc[4]; acc[5] = __builtin_amdgcn_cvt_scalef32_pk_f32_fp4(d1, 1.0f, 1) * ww + acc[5];
    acc[6] = __builtin_amdgcn_cvt_scalef32_pk_f32_fp4(d1, 1.0f, 2) * ww + acc[6]; acc[7] = __builtin_amdgcn_cvt_scalef32_pk_f32_fp4(d1, 1.0f, 3) * ww + acc[7];
}
typedef int v8i_t __attribute__((ext_vector_type(8)));

struct P6Ctx { __amdgpu_buffer_rsrc_t srdU, srdV; const f32x2v* SCL; int lane, lane8, n16, g4; };
__device__ __forceinline__ float p6_sel4(const f32x4 c, int i) { return (i & 2) ? ((i & 1) ? c[3] : c[2]) : ((i & 1) ? c[1] : c[0]); }
__device__ __forceinline__ void p6_flush(f32x2v (&acc)[8], const v2u (&prv)[16], float pw) {
#pragma unroll
    for (int j = 0; j < 16; ++j) axpy16_fp4(acc, prv[j], __uint_as_float(__builtin_amdgcn_readlane(__float_as_uint(pw), (j & 3) + 16 * (j >> 2))));
}
#define P6_ANCHOR(a) do { asm volatile("" : "+v"(a[0]), "+v"(a[1]), "+v"(a[2]), "+v"(a[3]), "+v"(a[4]), "+v"(a[5]), "+v"(a[6]), "+v"(a[7]) :: "memory"); __builtin_amdgcn_sched_barrier(0); } while (0)
#define P6_ROUND(accP, RVN, RVP, PWN, PWP, LSTK, RSTD, XSK) do { \
        const v2u le = (LSTK)[16 * p + n16p]; const unsigned lidx = le.x; const float lgate = __uint_as_float(le.y);        \
        const f32x2v scl = X.SCL[lidx]; \
        v2u ur[16];                                                        \
        _Pragma("unroll") for (int j = 0; j < 16; ++j) { const unsigned ei = __builtin_amdgcn_readlane(lidx, j); \
            ur[j] = __builtin_amdgcn_raw_buffer_load_b64(X.srdU, X.lane8, (int)(ei * EROW), 0); RVN[j] = __builtin_amdgcn_raw_buffer_load_b64(X.srdV, X.lane8, (int)(ei * EROW), 0); } \
        P6_ANCHOR(accP); \
        p6_flush(accP, RVP, PWP);                                          \
        P6_ANCHOR(accP); \
        _Pragma("unroll") for (int j = 0; j < 16; ++j) *(LAS v2u*)(ub + 528 * j + X.lane8) = ur[j];        \
        LDS_WAIT(); asm volatile("" ::: "memory"); \
        f32x4 ca = (f32x4){0.f, 0.f, 0.f, 0.f}, cb = (f32x4){0.f, 0.f, 0.f, 0.f}; \
        _Pragma("unroll") for (int s2 = 0; s2 < 8; ++s2) { const LAS v4u* bp = (const LAS v4u*)((XSK) + 128 * s2 + 16 * X.g4); const v4u b0 = bp[0], b1 = bp[4]; \
            const v4u av = *(const LAS v4u*)(ub + 528 * X.n16 + 64 * s2 + 16 * X.g4);                        \
            const v8i_t b8 = {(int)b0.x, (int)b0.y, (int)b0.z, (int)b0.w, (int)b1.x, (int)b1.y, (int)b1.z, (int)b1.w}; \
            const v8i_t a8 = {(int)av.x, (int)av.y, (int)av.z, (int)av.w, 0, 0, 0, 0}; \
            if (s2 & 1) cb = __builtin_amdgcn_mfma_scale_f32_16x16x128_f8f6f4(a8, b8, cb, 4  , 0  , 0, 0x7F7F7F7F, 0, 0x7F7F7F7F); \
            else        ca = __builtin_amdgcn_mfma_scale_f32_16x16x128_f8f6f4(a8, b8, ca, 4, 0, 0, 0x7F7F7F7F, 0, 0x7F7F7F7F); } \
        ca = ca + cb; \
        const int jL = 4 * X.g4 + (X.n16 & 3); \
        const float d = p6_sel4(ca, X.n16 & 3); \
        const float su = __uint_as_float((unsigned)__builtin_amdgcn_ds_bpermute(4 * jL, (int)__float_as_uint(scl.x))), sv = __uint_as_float((unsigned)__builtin_amdgcn_ds_bpermute(4 * jL, (int)__float_as_uint(scl.y))); \
        const float gt = __uint_as_float((unsigned)__builtin_amdgcn_ds_bpermute(4 * jL, (int)__float_as_uint(lgate))); \
        const float z = d * (RSTD) * su; \
        PWN = gt * (0.5f * z * (1.0f + erff(z * 0.70710678118654752f))) * sv; \
        asm volatile("" : "+v"(PWN) :: "memory"); __builtin_amdgcn_sched_barrier(0); \
    } while (0)
__device__ __forceinline__ void p6_experts(Frame& F, const Args& A) {
    unsigned char* ws = A.ws;
    const bf16* H1B = (const bf16*)(ws + WS_XN);
    const float* SSQ = (const float*)(ws + WS_SSQ); const v2u* META = (const v2u*)(ws + WS_META); const float* INVS = (const float*)(ws + WS_INVS);
    const float* gfin = A.in[16]; float* out = A.out;
    const int lane = F.lane;
    P6Ctx X;
    X.srdU = __builtin_amdgcn_make_buffer_rsrc((void*)(ws + WS_UV8), (short)0, (int)(NEXP * EROW), 0x00020000);
    X.srdV = __builtin_amdgcn_make_buffer_rsrc((void*)(ws + WS_UV8 + V4_OFF), (short)0, (int)(NEXP * EROW), 0x00020000);
    X.SCL = (const f32x2v*)(ws + WS_SCL); X.lane = lane; X.lane8 = lane * 8; X.n16 = lane & 15; X.g4 = lane >> 4;
    LAS unsigned char* xs = F.lds + RING_OFF + F.wave * 16640;
    LAS unsigned char* ub = xs + 8192;
    LAS v2u* lst = (LAS v2u*)(xs + 4096);
    LAS float* rsl = (LAS float*)(F.lds + RING_OFF + NWAVES * 16640 + F.wave * 16);
    const int gw = F.vcu * NWAVES + F.wave, NGW = F.G * NWAVES;
#pragma clang loop unroll(disable)
    for (int t0 = gw; t0 < M; t0 += 4 * NGW) {
        f32x2v acc[4][8];
#define P6_TOKLOAD(kk) do { const int t_ = t0 + (kk) * NGW; const int tc_ = t_ < M ? t_ : t0; int lp_ = lane; asm volatile("" : "+v"(lp_)); \
            n_ma = META[(size_t)tc_ * 128 + lp_]; n_mb = META[(size_t)tc_ * 128 + 64 + lp_]; n_ia = INVS[(size_t)tc_ * 8 + (lp_ >> 4)]; n_ib = INVS[(size_t)tc_ * 8 + 4 + (lp_ >> 4)]; \
            n_ssl = lp_ < 16 ? SSQ[(size_t)lp_ * M + tc_] : 0.f; { const v4u* xr_ = (const v4u*)(H1B + (size_t)tc_ * DM) + 2 * lp_; n_x0 = xr_[0]; n_x1 = xr_[1]; } } while (0)
        v2u n_ma, n_mb; float n_ia, n_ib, n_ssl; v4u n_x0, n_x1;
        P6_TOKLOAD(0);
#pragma clang loop unroll(disable)
        for (int k = 0; k < 4; ++k) {
            const bool tv = t0 + k * NGW < M;
            const v2u ma = n_ma, mb = n_mb; const float ia = n_ia, ib = n_ib, ssl = n_ssl; const v4u r0 = n_x0, r1 = n_x1;
            P6_TOKLOAD(k < 3 ? k + 1 : 3);
            int lane_p = lane; asm volatile("" : "+v"(lane_p));
            { const unsigned ba = ma.x >> 11, bb = mb.x >> 11; int ra = 0, rb = 0, off = 0;
#pragma unroll
              for (int sb = 0; sb < 8; ++sb) { const unsigned long long m0 = __ballot(ba == (unsigned)sb), m1 = __ballot(bb == (unsigned)sb);
                  const int c0 = __builtin_amdgcn_readfirstlane(__popcll(m0)), c1 = __builtin_amdgcn_readfirstlane(__popcll(m1));
                  const int w0 = off + (int)__builtin_amdgcn_mbcnt_hi((unsigned)(m0 >> 32), __builtin_amdgcn_mbcnt_lo((unsigned)m0, 0u));
                  const int w1 = off + c0 + (int)__builtin_amdgcn_mbcnt_hi((unsigned)(m1 >> 32), __builtin_amdgcn_mbcnt_lo((unsigned)m1, 0u));
                  ra = (ba == (unsigned)sb) ? w0 : ra; rb = (bb == (unsigned)sb) ? w1 : rb; off += c0 + c1; }
              lst[128 * k + ra] = (v2u){ma.x, __float_as_uint(tv ? __uint_as_float(ma.y) * ia : 0.f)};
              lst[128 * k + rb] = (v2u){mb.x, __float_as_uint(tv ? __uint_as_float(mb.y) * ib : 0.f)}; }
            { const float r_ = __builtin_amdgcn_rsqf(wave_sum(ssl) * (1.f / DM) + NORM_EPS); if (lane_p == 0) rsl[k] = r_; }
            { const unsigned xw[8] = {r0.x, r0.y, r0.z, r0.w, r1.x, r1.y, r1.z, r1.w}; v4u xq;
#pragma unroll
              for (int cc = 0; cc < 4; ++cc) { int pk = __builtin_amdgcn_cvt_pk_fp8_f32(__uint_as_float(xw[2 * cc] << 16), __uint_as_float(xw[2 * cc] & 0xffff0000u), 0, false);
                  pk = __builtin_amdgcn_cvt_pk_fp8_f32(__uint_as_float(xw[2 * cc + 1] << 16), __uint_as_float(xw[2 * cc + 1] & 0xffff0000u), pk, true); xq[cc] = (unsigned)pk; }
              *(LAS v4u*)(xs + 1024 * k + 16 * lane_p) = xq; }
        }
#undef P6_TOKLOAD
#pragma unroll
        for (int k = 0; k < 4; ++k)
#pragma unroll
            for (int i = 0; i < 8; ++i) acc[k][i] = (f32x2v){0.f, 0.f};
        LDS_WAIT(); asm volatile("" ::: "memory");
        v2u rvA[16], rvB[16]; float pwA = 0.f, pwB = 0.f;
#pragma unroll
        for (int j = 0; j < 16; ++j) rvB[j] = (v2u){0u, 0u};
#pragma clang loop unroll(disable)
        for (int p = 0; p < 8; ++p) {
            int n16p = X.n16; asm volatile("" : "+v"(n16p));
            P6_ROUND(acc[3], rvA, rvB, pwA, pwB, lst,       rsl[0], xs);
            P6_ROUND(acc[0], rvB, rvA, pwB, pwA, lst + 128, rsl[1], xs + 1024);
            P6_ROUND(acc[1], rvA, rvB, pwA, pwB, lst + 256, rsl[2], xs + 2048);
            P6_ROUND(acc[2], rvB, rvA, pwB, pwA, lst + 384, rsl[3], xs + 3072);
        }
        v4u ex0[4], ex1[4];
        { int lane_x = lane; asm volatile("" : "+v"(lane_x));
#pragma unroll
          for (int k = 0; k < 4; ++k) { const int t_ = t0 + k * NGW; const int tc_ = t_ < M ? t_ : t0; const v4u* xr = (const v4u*)(H1B + (size_t)tc_ * DM) + 2 * lane_x; ex0[k] = xr[0]; ex1[k] = xr[1]; } }
        P6_ANCHOR(acc[3]);
        p6_flush(acc[3], rvB, pwB);
        P6_ANCHOR(acc[3]);
        int lane_e = lane; asm volatile("" : "+v"(lane_e));
#pragma unroll
        for (int k = 0; k < 4; ++k) {
            const int t = t0 + k * NGW;
            if (t < M) {
                const v4u r0 = ex0[k], r1 = ex1[k];
                const unsigned xw[8] = {r0.x, r0.y, r0.z, r0.w, r1.x, r1.y, r1.z, r1.w};
                float* hrow = out + (size_t)t * DM + 16 * lane_e;
                f32x4 h[4]; float s2 = 0.f;
#pragma unroll
                for (int i = 0; i < 4; ++i) { h[i] = (f32x4){__uint_as_float(xw[2 * i] << 16), __uint_as_float(xw[2 * i] & 0xffff0000u), __uint_as_float(xw[2 * i + 1] << 16), __uint_as_float(xw[2 * i + 1] & 0xffff0000u)}
                                                   + (f32x4){acc[k][2 * i].x, acc[k][2 * i].y, acc[k][2 * i + 1].x, acc[k][2 * i + 1].y};
                    s2 += (h[i].x * h[i].x + h[i].y * h[i].y) + (h[i].z * h[i].z + h[i].w * h[i].w); }
                const float rf = __builtin_amdgcn_rsqf(wave_sum(s2) * (1.f / DM) + NORM_EPS);
#pragma unroll
                for (int i = 0; i < 4; ++i) *(f32x4*)(hrow + 4 * i) = h[i] * rf * *(const f32x4*)(gfin + 16 * lane_e + 4 * i);
            }
        }
        LDS_WAIT(); asm volatile("" ::: "memory");
    }
}
#undef P6_ROUND
#undef P6_ANCHOR

__global__ void __launch_bounds__(NWAVES * 64, 2) fwd_kernel(Args args) {
    extern __shared__ __attribute__((aligned(16))) unsigned char lds[];
    Frame F;
    F.lds = (LAS unsigned char*)lds;
    F.MISC = (volatile LAS unsigned*)(F.lds + MISC_OFF);
    F.tid = threadIdx.x; F.lane = F.tid & 63; F.wave = __builtin_amdgcn_readfirstlane(F.tid >> 6);
    F.G = gridDim.x; { const int bx = blockIdx.x; F.vcu = (F.G % 8 == 0) ? (bx % 8) * (F.G / 8) + bx / 8 : bx; }
    unsigned char* ws = args.ws;
    F.ctl = (gu32*)(ws + WS_CTL);
    for (int u = F.tid; u < (LDS_BYTES - LDSCTL_OFF) / 4; u += NWAVES * 64) ((LAS unsigned*)(F.lds + LDSCTL_OFF))[u] = 0u;
    __syncthreads();
    XcdBarrier bar; bar.bar = (unsigned*)(F.ctl + CW_BAR); bar.x = 0; bar.st = nullptr;
    if (N_LAUNCHES != PER_PHASE) bar = xcd_barrier_post((unsigned*)(F.ctl + CW_BAR), F.MISC + 8);
#define GRID_BAR() do { if (N_LAUNCHES != PER_PHASE) xcd_barrier(bar); } while (0)
    const int lo = args.ph_lo, hi = args.ph_hi;
#ifndef PH_MASK
#define PH_MASK 0x7f
#endif
#define IN(k) (((PH_MASK >> (k)) & 1) && lo <= (k) && (k) < hi)
#define BOTH(k) (IN(k) && IN((k) + 1))

    if (IN(0)) { p0_prologue(F, args); if (BOTH(0)) GRID_BAR(); }

    if (IN(1)) {
        pg8::Gemm g{(const pg8::bf16_t*)(ws + WS_XN), (const pg8::bf16_t*)(ws + WS_WIN), M, NIN, DM}; pg8::StaticOrder S; S.init(M, NIN, F.G, (int)blockIdx.x);
        pg8::EpiInProj E{(pg8::bf16_t*)(ws + WS_QKV), args.in[3], args.in[4], (const float*)(ws + WS_TROW), (const float*)(ws + WS_TCOL), (const float*)(ws + WS_TPOS), C2, (unsigned*)(ws + WS_CTL) + 65536};
        pg8::gemm_phase<pg8::EpiInProj, pg8::StaticOrder, true, true>(F.lds + RING_OFF, g, S, E);
        { const int nfull = (M / 256) * (NIN / 256) % F.G;
          if (nfull == 0) p0_lazy(F, args, F.vcu * NWAVES + F.wave, F.G * NWAVES);
          else if ((int)blockIdx.x >= nfull) p0_lazy(F, args, ((int)blockIdx.x - nfull) * NWAVES + F.wave, (F.G - nfull) * NWAVES); }
        if (BOTH(1)) GRID_BAR();
    }

    if (IN(2)) {
        using abf = attn_body::bf16;
        const abf* planes = (const abf*)(ws + WS_QKV); abf* AO = (abf*)(ws + WS_AO);
        constexpr size_t PL = (size_t)M * 64;
        const __amdgpu_buffer_rsrc_t srd = __builtin_amdgcn_make_buffer_rsrc((void*)(ws + WS_QKV), (short)0, (int)(36 * PL * 2), 0x00020000);
#ifndef NO_A
        const float mub = C2 * 64.0f * 1.15f * wave_max(__builtin_fabsf(args.in[3][F.lane])) * wave_max(__builtin_fabsf(args.in[4][F.lane]));
        const bool sbound = mub < 60.0f;
        for (int ua = F.vcu * 2; ua < 512; ua += F.G * 2)
            for (int k = 0; k < 2; ++k) { const int hA = (ua + k) >> 6, qb = (ua + k) & 63;
                if (sbound) attn_body::attn_unit_a_sb(qb, planes + (size_t)hA * PL, srd, (unsigned)((8 + (hA >> 2)) * PL * 2), (unsigned)((10 + (hA >> 2)) * PL * 2), AO + hA * 64, (char*)lds + RING_OFF);
                else attn_body::attn_unit_a<8>(qb, planes + (size_t)hA * PL, srd, (unsigned)((8 + (hA >> 2)) * PL * 2), (unsigned)((10 + (hA >> 2)) * PL * 2), AO + hA * 64, (char*)lds + RING_OFF, 0.f, false); }
#endif
        const float d1 = wave_sum(args.in[5][F.lane] * args.in[6][F.lane]), d2 = wave_sum(args.in[7][F.lane] * args.in[8][F.lane]);
        const float lam = __expf(d1) - __expf(d2) + 0.2f;
        float* sc = (float*)(ws + WS_XN) + (size_t)F.vcu * (NWAVES * 4096);
#ifndef NO_B
        for (int ub = F.vcu; ub < 256; ub += F.G) { const int hB = ub >> 6, qb = ub & 63;
            for (int comp = 0; comp < 2; ++comp) {
                const unsigned* nmax = (const unsigned*)(ws + WS_CTL) + 65536;
                const float mb = 1.15f * __builtin_sqrtf(__uint_as_float(nmax[12 + 2 * hB + comp]) * __uint_as_float(nmax[20 + 2 * hB + comp]));
                const bool sb = mb < 60.0f;
                attn_body::attn_unit_b<8>(qb, comp, planes + (size_t)(12 + 2 * hB + comp) * PL, srd, (unsigned)((20 + 2 * hB + comp) * PL * 2), (unsigned)((28 + 2 * hB) * PL * 2),
                                          sc, lam, args.in[9], AO + 512 + hB * 128, (char*)lds + RING_OFF, sb ? mb : 0.f, sb); } }
#endif
        if (BOTH(2)) GRID_BAR();
    }

    if (IN(3)) {
        pg8::Gemm g{(const pg8::bf16_t*)(ws + WS_AO), (const pg8::bf16_t*)(ws + WS_WOUT), M, DM, DM}; pg8::StaticOrder S; S.init(M, DM, F.G, (int)blockIdx.x);
        pg8::EpiOutProj E{args.in[0], args.out, (pg8::bf16_t*)(ws + WS_XN), (float*)(ws + WS_SSQ)};
        pg8::gemm_phase<pg8::EpiOutProj, pg8::StaticOrder, true, true>(F.lds + RING_OFF, g, S, E);
        if (BOTH(3)) GRID_BAR();
    }

    if (IN(4)) {
        pg8::Gemm g{(const pg8::bf16_t*)(ws + WS_XN), (const pg8::bf16_t*)(ws + WS_WQ), M, NQ, DM}; pg8::StaticOrder S; S.init(M, NQ, F.G, (int)blockIdx.x);
        pg8::EpiBf16 E{(pg8::bf16_t*)(ws + WS_QKV), NQ};
        pg8::gemm_phase<pg8::EpiBf16, pg8::StaticOrder, true, true>(F.lds + RING_OFF, g, S, E);
        if (BOTH(4)) GRID_BAR();
    }

    if (IN(5)) { p5_topk(F, args); if (BOTH(5)) GRID_BAR(); }

    if (IN(6)) { p6_experts(F, args); }
#undef IN
#undef BOTH
#undef GRID_BAR
}

extern "C" void kernel_launch(void* const* d_in, const int* in_sizes, int n_in, void* d_out, int out_size, void* d_ws, size_t ws_size, hipStream_t stream) {
    static int grid = 0;
    if (grid == 0) {
        if (n_in != 17 || in_sizes[0] != M * DM || out_size != M * DM || ws_size < WS_END) { fprintf(stderr, "kernel_launch: unexpected shapes (n_in %d, in0 %d, out %d, ws %zu); nothing launched\n", n_in, n_in > 0 ? in_sizes[0] : -1, out_size, ws_size); grid = -1; return; }
        int dev = 0, cus = 0, per_cu = 0;
        if (hipGetDevice(&dev) != hipSuccess || hipDeviceGetAttribute(&cus, hipDeviceAttributeMultiprocessorCount, dev) != hipSuccess) { fprintf(stderr, "kernel_launch: device query failed\n"); grid = -1; return; }
        if (hipFuncSetAttribute((const void*)fwd_kernel, hipFuncAttributeMaxDynamicSharedMemorySize, LDS_BYTES) != hipSuccess) { fprintf(stderr, "kernel_launch: hipFuncSetAttribute failed\n"); grid = -1; return; }
        if (hipOccupancyMaxActiveBlocksPerMultiprocessor(&per_cu, (const void*)fwd_kernel, NWAVES * 64, LDS_BYTES) != hipSuccess || per_cu < 1)
            fprintf(stderr, "kernel_launch: note: occupancy query reports %d workgroups per CU\n", per_cu);
        (void)hipGetLastError();
        grid = cus;
        if (grid != 256) { fprintf(stderr, "kernel_launch: built for a 256-CU device, found %d CUs; nothing launched\n", cus); grid = -1; return; }
    }
    if (grid < 0) return;
    if (hipMemsetAsync((char*)d_ws + WS_CTL, 0, CTL_ZERO_BYTES, stream) != hipSuccess) { fprintf(stderr, "kernel_launch: hipMemsetAsync failed\n"); return; }
    Args a{};
    for (int i = 0; i < 17; ++i) a.in[i] = (const float*)d_in[i];
    a.out = (float*)d_out; a.ws = (unsigned char*)d_ws;
    for (int i = 0; i < 16; ++i) a.inv_ax[i] = pow(10000.0, -(2.0 * i) / 32.0);
    for (int i = 0; i < 8; ++i) a.inv_p[i] = pow(500000.0, -(2.0 * i) / 16.0);
#ifdef PHASE_LIST
    static const int plist[] = {PHASE_LIST}; constexpr int NL = sizeof(plist) / sizeof(int);
#else
    constexpr int NL = N_LAUNCHES;
#endif
    for (int li = 0; li < NL; ++li) {
#ifdef PHASE_LIST
        a.ph_lo = plist[li]; a.ph_hi = plist[li] + 1; a.li = li;
#else
        a.ph_lo = (N_LAUNCHES == PER_PHASE) ? li : 0; a.ph_hi = (N_LAUNCHES == PER_PHASE) ? li + 1 : PER_PHASE; a.li = li;
#endif
        hipLaunchKernelGGL(fwd_kernel, dim3(grid), dim3(NWAVES * 64), LDS_BYTES, stream, a);
        const hipError_t le = hipPeekAtLastError();
        if (le != hipSuccess) { fprintf(stderr, "kernel_launch: launch %d failed: %s\n", li, hipGetErrorName(le)); break; }
    }
}
```
